# Optimizing an MI355X kernel written in HIP

```python
import math
import jax, jax.numpy as jnp
from jax import lax
import numpy as np


D_MODEL = 2048
BATCH = 4
SEQ = 4096
DEPTH = 1

HG_HEADS = 8
HG_DK = 128
HG_DV = 128
HG_CHUNK = 64
HG_WIDTH = HG_HEADS * HG_DV
DA_HEADS = 8
DA_DH = 64
DA_DV = 2 * DA_DH
DA_QBLOCK = 128
DA_WIDTH = DA_HEADS * DA_DV
RP_BUCKETS = 32
RP_MAX_EXACT = 16
RP_MAX_DIST = 128
IN_SPLITS = [HG_HEADS * HG_DK, HG_HEADS * HG_DK, HG_WIDTH, HG_WIDTH,
             DA_HEADS * 2 * DA_DH, DA_HEADS * 2 * DA_DH, DA_WIDTH, D_MODEL, D_MODEL]
IN_COLS = sum(IN_SPLITS)
N_EXPERTS = 64
N_GROUPS = 8
TOPK_GROUPS = 4
TOP_K = 8
D_EXPERT = 512
ROUTE_SCALE = 2.5
MOE_BLOCK = 256
EPS = 1e-6

kernel_name = 'hybrid_hgrn2_diffattn_moe_block'

F32 = jnp.float32


def rms_norm(x, g):
    xf = x.astype(F32)
    return xf * lax.rsqrt(jnp.mean(xf * xf, axis=-1, keepdims=True) + EPS) * g.astype(F32)


def modulate(hn, shift, scale):
    return hn * (1.0 + scale[:, None, :].astype(F32)) + shift[:, None, :].astype(F32)


def t5_bucket(n):
    nf = jnp.maximum(n, 1).astype(F32)
    large = RP_MAX_EXACT + (jnp.log(nf / RP_MAX_EXACT) / math.log(RP_MAX_DIST / RP_MAX_EXACT)
                            * (RP_BUCKETS - RP_MAX_EXACT)).astype(jnp.int32)
    large = jnp.minimum(large, RP_BUCKETS - 1)
    return jnp.where(n < RP_MAX_EXACT, n, large)


def hgrn2_branch(q, f_logit, i, g, lb, norm_g):
    bsz, seq, _ = q.shape
    n_chunks = seq // HG_CHUNK
    qs = jax.nn.silu(q.astype(F32)) * HG_DK ** -0.5
    fgate = lb + (1.0 - lb) * jax.nn.sigmoid(f_logit.astype(F32))
    k = 1.0 - fgate
    log_f = jnp.log(fgate)

    def to_chunks(t, d):
        return t.reshape(bsz, n_chunks, HG_CHUNK, HG_HEADS, d).transpose(1, 0, 3, 2, 4)

    qc, kc, gc = to_chunks(qs, HG_DK), to_chunks(k, HG_DK), to_chunks(log_f, HG_DK)
    vc = to_chunks(i.astype(F32), HG_DV)
    causal = jnp.tril(jnp.ones((HG_CHUNK, HG_CHUNK), bool))[:, :, None]

    def step(state, xs):
        qb, kb, vb, gb = xs
        b = jnp.cumsum(gb, axis=2)
        rel = b[:, :, :, None, :] - b[:, :, None, :, :]
        decay = jnp.exp(jnp.where(causal, rel, -jnp.inf))
        scores = jnp.einsum('bhtk,bhtsk,bhsk->bhts', qb, decay, kb)
        o = (jnp.einsum('bhts,bhsv->bhtv', scores, vb)
             + jnp.einsum('bhtk,bhkv->bhtv', qb * jnp.exp(b), state))
        b_last = b[:, :, -1:, :]
        state = (jnp.exp(b_last[:, :, 0, :, None]) * state
                 + jnp.einsum('bhsk,bhsv->bhkv', kb * jnp.exp(b_last - b), vb))
        return state, o

    state0 = jnp.zeros((bsz, HG_HEADS, HG_DK, HG_DV), F32)
    _, o = lax.scan(step, state0, (qc, kc, vc, gc))
    o = o.transpose(1, 0, 3, 2, 4).reshape(bsz, seq, HG_HEADS, HG_DV)
    gate = jax.nn.silu(g.astype(F32)).reshape(bsz, seq, HG_HEADS, HG_DV)
    return (rms_norm(o, norm_g) * gate).reshape(bsz, seq, HG_WIDTH)


def diff_attention_branch(q, k, v, q_g, k_g, lq1, lk1, lq2, lk2, norm_g, rel_table, lambda_init):
    bsz, seq, _ = q.shape

    def heads(t):
        return t.reshape(bsz, seq, DA_HEADS, 2, DA_DH).transpose(0, 2, 3, 1, 4)

    qh = rms_norm(heads(q), q_g) * DA_DH ** -0.5
    kh = rms_norm(heads(k), k_g)
    vh = v.reshape(bsz, seq, DA_HEADS, DA_DV).transpose(0, 2, 1, 3).astype(F32)
    lam = (jnp.exp(jnp.sum(lq1.astype(F32) * lk1.astype(F32)))
           - jnp.exp(jnp.sum(lq2.astype(F32) * lk2.astype(F32))) + lambda_init)
    n_blocks = seq // DA_QBLOCK
    q_blocks = qh.reshape(bsz, DA_HEADS, 2, n_blocks, DA_QBLOCK, DA_DH).transpose(3, 0, 1, 2, 4, 5)
    k_pos = jnp.arange(seq)
    table = rel_table.astype(F32)

    def attend(args):
        qb, blk = args
        q_pos = blk * DA_QBLOCK + jnp.arange(DA_QBLOCK)
        dist = q_pos[:, None] - k_pos[None, :]
        bias = table[t5_bucket(jnp.maximum(dist, 0))].transpose(2, 0, 1)
        logits = jnp.einsum('bhcqd,bhckd->bhcqk', qb, kh) + bias[None, :, None]
        logits = jnp.where(dist >= 0, logits, -jnp.inf)
        p = jax.nn.softmax(logits, axis=-1)
        a = p[:, :, 0] - lam * p[:, :, 1]
        return jnp.einsum('bhqk,bhkv->bhqv', a, vh)

    o = lax.map(attend, (q_blocks, jnp.arange(n_blocks)))
    o = o.transpose(1, 0, 3, 2, 4).reshape(bsz, seq, DA_HEADS, DA_DV)
    o = rms_norm(o, norm_g) * (1.0 - lambda_init)
    return o.reshape(bsz, seq, DA_WIDTH)


def hybrid_mixer(h, w_in, lb, hg_norm_g, q_g, k_g, lq1, lk1, lq2, lk2, da_norm_g, rel_table,
                 w_branch_a, w_branch_b, w_out, lambda_init):
    proj = jnp.einsum('bsd,dn->bsn', h, w_in)
    split_at = np.cumsum(IN_SPLITS)[:-1].tolist()
    hq, hf, hi, hg, dq, dk, dv, ga, gb = jnp.split(proj, split_at, axis=-1)
    ya = jnp.einsum('bsn,nd->bsd', hgrn2_branch(hq, hf, hi, hg, lb, hg_norm_g).astype(h.dtype), w_branch_a)
    yb = jnp.einsum('bsn,nd->bsd', diff_attention_branch(dq, dk, dv, q_g, k_g, lq1, lk1, lq2, lk2,
                                                        da_norm_g, rel_table, lambda_init).astype(h.dtype),
                    w_branch_b)
    merged = (jax.nn.sigmoid(ga.astype(F32)) * ya.astype(F32)
              + jax.nn.sigmoid(gb.astype(F32)) * yb.astype(F32)).astype(h.dtype)
    return jnp.einsum('bsd,de->bse', merged, w_out)


def swiglu(x, wg, wu, wd):
    return (jax.nn.silu(x @ wg) * (x @ wu)) @ wd


def routed_experts(hf, top_e, gate_w, eg, eu, ed):
    n_tok, d = hf.shape
    n_assign = n_tok * TOP_K
    n_blocks = n_assign // MOE_BLOCK + N_EXPERTS + 1
    n_slots = n_blocks * MOE_BLOCK
    flat_e = top_e.reshape(-1)
    flat_tok = jnp.repeat(jnp.arange(n_tok, dtype=jnp.int32), TOP_K)
    flat_w = gate_w.reshape(-1)
    order = jnp.argsort(flat_e, stable=True)
    e_sorted = flat_e[order]
    counts = jnp.bincount(flat_e, length=N_EXPERTS)
    padded = (counts + MOE_BLOCK - 1) // MOE_BLOCK * MOE_BLOCK
    pad_end = jnp.cumsum(padded)
    pad_start = pad_end - padded
    first = jnp.cumsum(counts) - counts
    dest = pad_start[e_sorted] + jnp.arange(n_assign, dtype=jnp.int32) - first[e_sorted]
    slot_tok = jnp.full((n_slots,), n_tok, jnp.int32).at[dest].set(flat_tok[order])
    slot_w = jnp.zeros((n_slots,), F32).at[dest].set(flat_w[order])
    block_e = jnp.minimum(jnp.searchsorted(pad_end, jnp.arange(n_blocks) * MOE_BLOCK, side='right'),
                          N_EXPERTS - 1)
    h_pad = jnp.concatenate([hf, jnp.zeros((1, d), hf.dtype)], axis=0)

    def block(acc, xs):
        e, tok, w = xs
        y = swiglu(h_pad[tok], eg[e], eu[e], ed[e])
        return acc.at[tok].add(y.astype(F32) * w[:, None]), None

    acc, _ = lax.scan(block, jnp.zeros((n_tok + 1, d), F32),
                      (block_e, slot_tok.reshape(n_blocks, MOE_BLOCK), slot_w.reshape(n_blocks, MOE_BLOCK)))
    return acc[:n_tok]


def moe_ffn(h, w_r, b_r, eg, eu, ed, sg, su, sd):
    bsz, seq, d = h.shape
    n_tok = bsz * seq
    hf = h.reshape(n_tok, d)
    scores = jax.nn.sigmoid(jnp.einsum('td,de->te', hf.astype(F32), w_r.astype(F32)))
    sel = scores + b_r.astype(F32)
    group_score = lax.top_k(sel.reshape(n_tok, N_GROUPS, N_EXPERTS // N_GROUPS), 2)[0].sum(-1)
    _, top_groups = lax.top_k(group_score, TOPK_GROUPS)
    group_mask = jax.nn.one_hot(top_groups, N_GROUPS, dtype=F32).sum(1) > 0
    expert_mask = jnp.repeat(group_mask, N_EXPERTS // N_GROUPS, axis=1)
    _, top_e = lax.top_k(jnp.where(expert_mask, sel, -jnp.inf), TOP_K)
    gate_w = jnp.take_along_axis(scores, top_e, axis=1)
    gate_w = gate_w / jnp.sum(gate_w, axis=-1, keepdims=True) * ROUTE_SCALE
    routed = routed_experts(hf, top_e, gate_w, eg, eu, ed)
    out = swiglu(hf, sg, su, sd).astype(F32) + routed
    return out.reshape(bsz, seq, d)


def setup_inputs(seed: int = 0) -> dict:
    key = jax.random.key(seed)
    ks = jax.random.split(key, 32)
    L, D = DEPTH, D_MODEL
    nrm = lambda k, shape, s: jax.random.normal(k, shape, F32) * s
    return {
        'x': nrm(ks[0], (BATCH, SEQ, D), 1.0),
        'c': nrm(ks[1], (BATCH, D), 1.0),
        'ada_w': nrm(ks[2], (L, D, 6 * D), 0.5 * D ** -0.5),
        'ada_b': nrm(ks[3], (L, 6 * D), 0.02),
        'norm1_g': 1.0 + nrm(ks[4], (L, D), 0.02),
        'w_in': nrm(ks[5], (L, D, IN_COLS), D ** -0.5),
        'lb_logits': nrm(ks[6], (L + 1, HG_HEADS * HG_DK), 1.0),
        'hg_norm_g': 1.0 + nrm(ks[7], (L, HG_DV), 0.02),
        'q_norm_g': 1.0 + nrm(ks[8], (L, DA_DH), 0.02),
        'k_norm_g': 1.0 + nrm(ks[9], (L, DA_DH), 0.02),
        'lambda_q1': nrm(ks[10], (L, DA_DH), 0.1),
        'lambda_k1': nrm(ks[11], (L, DA_DH), 0.1),
        'lambda_q2': nrm(ks[12], (L, DA_DH), 0.1),
        'lambda_k2': nrm(ks[13], (L, DA_DH), 0.1),
        'da_norm_g': 1.0 + nrm(ks[14], (L, DA_DV), 0.02),
        'rel_bias': nrm(ks[15], (RP_BUCKETS, DA_HEADS), 0.5),
        'w_branch_a': nrm(ks[16], (L, HG_WIDTH, D), HG_WIDTH ** -0.5),
        'w_branch_b': nrm(ks[17], (L, DA_WIDTH, D), DA_WIDTH ** -0.5),
        'w_out': nrm(ks[18], (L, D, D), D ** -0.5),
        'norm2_g': 1.0 + nrm(ks[19], (L, D), 0.02),
        'router_w': nrm(ks[20], (L, D, N_EXPERTS), D ** -0.5),
        'router_bias': nrm(ks[21], (L, N_EXPERTS), 0.01),
        'w_exp_gate': nrm(ks[22], (L, N_EXPERTS, D, D_EXPERT), D ** -0.5),
        'w_exp_up': nrm(ks[23], (L, N_EXPERTS, D, D_EXPERT), D ** -0.5),
        'w_exp_down': nrm(ks[24], (L, N_EXPERTS, D_EXPERT, D), D_EXPERT ** -0.5),
        'w_sh_gate': nrm(ks[25], (L, D, D_EXPERT), D ** -0.5),
        'w_sh_up': nrm(ks[26], (L, D, D_EXPERT), D ** -0.5),
        'w_sh_down': nrm(ks[27], (L, D_EXPERT, D), D_EXPERT ** -0.5),
    }


def reference(x, c, ada_w, ada_b, norm1_g, w_in, lb_logits, hg_norm_g, q_norm_g, k_norm_g,
              lambda_q1, lambda_k1, lambda_q2, lambda_k2, da_norm_g, rel_bias, w_branch_a,
              w_branch_b, w_out, norm2_g, router_w, router_bias, w_exp_gate, w_exp_up,
              w_exp_down, w_sh_gate, w_sh_up, w_sh_down):
    lower_bounds = jnp.cumsum(jax.nn.softmax(lb_logits.astype(F32), axis=0), axis=0)
    c_act = jax.nn.silu(c)
    for l in range(DEPTH):
        lambda_init = 0.8 - 0.6 * math.exp(-0.3 * l)
        mod = jnp.einsum('bd,dn->bn', c_act, ada_w[l]) + ada_b[l]
        shift1, scale1, gate1, shift2, scale2, gate2 = jnp.split(mod, 6, axis=-1)
        h = modulate(rms_norm(x, norm1_g[l]), shift1, scale1).astype(x.dtype)
        y = hybrid_mixer(h, w_in[l], lower_bounds[l], hg_norm_g[l], q_norm_g[l], k_norm_g[l],
                         lambda_q1[l], lambda_k1[l], lambda_q2[l], lambda_k2[l], da_norm_g[l],
                         rel_bias, w_branch_a[l], w_branch_b[l], w_out[l], lambda_init)
        x = (x.astype(F32) + gate1[:, None, :].astype(F32) * y.astype(F32)).astype(x.dtype)
        h = modulate(rms_norm(x, norm2_g[l]), shift2, scale2).astype(x.dtype)
        y = moe_ffn(h, router_w[l], router_bias[l], w_exp_gate[l], w_exp_up[l], w_exp_down[l],
                    w_sh_gate[l], w_sh_up[l], w_sh_down[l])
        x = (x.astype(F32) + gate2[:, None, :].astype(F32) * y).astype(x.dtype)
    return x
```

```cpp
#include <hip/hip_runtime.h>
#include <cstdio>
#include <cstdint>

#define GAS __attribute__((address_space(1)))
#define LAS __attribute__((address_space(3)))
typedef unsigned short bf16;
typedef unsigned v4u __attribute__((ext_vector_type(4)));
typedef unsigned v2u __attribute__((ext_vector_type(2)));
typedef float f32x4 __attribute__((ext_vector_type(4)));
typedef float f32x16 __attribute__((ext_vector_type(16)));
typedef short bf16x8 __attribute__((ext_vector_type(8)));
typedef short s16x4 __attribute__((ext_vector_type(4)));
typedef int i32x4 __attribute__((ext_vector_type(4)));
typedef int i32x8 __attribute__((ext_vector_type(8)));

#ifndef STAGE_MAX
#define STAGE_MAX 99
#endif

constexpr int D = 2048, BATCH = 4, SEQ = 4096, T = BATCH * SEQ;
constexpr int HGH = 8, HGD = 128, CHUNK = 64, NCHUNK = SEQ / CHUNK;
constexpr int NCH_UNITS = BATCH * HGH * NCHUNK;
constexpr int DAH = 8, DADH = 64, DADV = 128;
constexpr int INCOLS = 11264;
constexpr int NEXP = 64, TOPK = 8, DEXP = 512;
constexpr float EPS = 1e-6f;
constexpr float LOG2E = 1.4426950408889634f;
constexpr float LAMBDA_INIT = 0.2f;
constexpr int NWAVES = 8, NTHREADS = NWAVES * 64;
constexpr int LDS_BYTES = 147456;
constexpr int MISC_OFF = 131072;

constexpr size_t MiB = 1u << 20;
constexpr size_t WS_CTL = 0, CTL_ZERO_BYTES = 1 * MiB;
constexpr size_t WS_VEC = 1 * MiB;
constexpr size_t WS_LTOK = 2 * MiB, WS_LW = 6 * MiB;
constexpr size_t WS_WSH = 10 * MiB;
constexpr size_t WS_WIN = 16 * MiB;
constexpr size_t WS_WIN8 = 40 * MiB;
constexpr size_t WS_H8 = 848 * MiB;
constexpr size_t WS_WA = 60 * MiB, WS_WB = 64 * MiB;
constexpr size_t WS_WOUT = 68 * MiB;
constexpr size_t WS_H = 76 * MiB;
constexpr size_t WS_PROJ = 140 * MiB;
constexpr size_t WS_HQ = WS_PROJ, WS_HF = WS_PROJ + 32 * MiB, WS_HI = WS_PROJ + 64 * MiB, WS_HG = WS_PROJ + 96 * MiB;
constexpr size_t WS_DQ = WS_PROJ + 128 * MiB, WS_DK = WS_PROJ + 160 * MiB, WS_DV = WS_PROJ + 192 * MiB;
constexpr size_t WS_GA = WS_PROJ + 224 * MiB, WS_GB = WS_PROJ + 288 * MiB;
constexpr size_t WS_ST = 492 * MiB;
constexpr size_t WS_DEC = 556 * MiB;
constexpr size_t WS_OI = 560 * MiB;
constexpr size_t WS_BR = 624 * MiB;
constexpr size_t WS_MERGED = 688 * MiB;
constexpr size_t WS_QT = 752 * MiB;
constexpr size_t WS_DQN = 784 * MiB, WS_DKN = 816 * MiB;
constexpr size_t WS_WDOWN = 882 * MiB;
constexpr size_t WS_ACT = 144 * MiB;
constexpr size_t WS_WG = 946 * MiB, WS_WU = 1010 * MiB;
constexpr size_t WS_H2 = 546 * MiB;
constexpr size_t WS_Y = 290 * MiB;
constexpr float Y8_SCALE = 32.0f;
constexpr size_t WS_X1B = WS_H;
constexpr size_t WS_YSH = WS_BR;
constexpr size_t WS_INV = 15 * MiB;
constexpr size_t WS_NEED = 1074 * MiB;

constexpr int CW_BAR = 4096;
constexpr int CW_CNT = 8192;
constexpr int CW_MOD = 16384;
constexpr int VW_LB = 0;
constexpr int VW_LAM = 1024, VW_M2 = 1025;
constexpr int VW_TBL = 2048;
constexpr size_t WS_RWT_HI = WS_VEC + 65536, WS_RWT_LO = WS_VEC + 65536 + 262144;

#define RLX_AGENT __ATOMIC_RELAXED, __HIP_MEMORY_SCOPE_AGENT
#define LDS_WAIT() asm volatile("s_waitcnt lgkmcnt(0)" ::: "memory")
#define VM_WAIT() asm volatile("s_waitcnt vmcnt(0)" ::: "memory")
__device__ __forceinline__ unsigned f2bf(float f) { unsigned u = __builtin_bit_cast(unsigned, f); return (u + 0x7fffu + ((u >> 16) & 1u)) >> 16; }
__device__ __forceinline__ unsigned pk2(float lo, float hi) { return f2bf(lo) | (f2bf(hi) << 16); }
__device__ __forceinline__ float bf2f(unsigned b) { return __builtin_bit_cast(float, b << 16); }
__device__ __forceinline__ float bflo(unsigned w) { return __builtin_bit_cast(float, w << 16); }
__device__ __forceinline__ float bfhi(unsigned w) { return __builtin_bit_cast(float, w & 0xffff0000u); }
__device__ __forceinline__ float fsigmoid(float x) { return __builtin_amdgcn_rcpf(1.0f + __expf(-x)); }
__device__ __forceinline__ float wave_sum(float v) {
#pragma unroll
    for (int o = 1; o < 64; o <<= 1) v += __shfl_xor(v, o);
    return v;
}

#define XB_TMO      128
#define XB_XCNT(j)  (256  + 64 * (j))
#define XB_XSUB(j)  (1280 + 64 * (j))
#define XB_XGEN(j)  (2304 + 64 * (j))
#define XB_TOP      3328
#define XB_TOPGEN   3392
#define XCD_BAR_WORDS 3456
#define XB_SPIN_CAP (1u << 18)
__device__ __forceinline__ unsigned xb_ld(unsigned* p)              { return __hip_atomic_load(p, __ATOMIC_RELAXED, __HIP_MEMORY_SCOPE_AGENT); }
__device__ __forceinline__ unsigned xb_add(unsigned* p, unsigned v) { return __hip_atomic_fetch_add(p, v, __ATOMIC_RELAXED, __HIP_MEMORY_SCOPE_AGENT); }
__device__ __forceinline__ unsigned xb_xcc_id() { return (unsigned)__builtin_amdgcn_s_getreg((3 << 11) | 20) & 0xFu; }
#define XB_SPIN(cond, bar) do { unsigned _sp = 0; while (cond) { __builtin_amdgcn_s_sleep(1); \
    if ((++_sp & 255u) == 0u) { if (xb_ld(&(bar)[XB_TMO])) break; if (_sp > XB_SPIN_CAP) { atomicAdd(&(bar)[XB_TMO], 1u); break; } } } } while (0)
struct XcdBarrier { unsigned* bar; unsigned x; volatile LAS unsigned* st; };
__device__ __forceinline__ XcdBarrier xcd_barrier_post(unsigned* bar, volatile LAS unsigned* st) {
    XcdBarrier b; b.bar = bar; b.x = xb_xcc_id(); b.st = st;
    if (threadIdx.x == 0) (void)xb_add(&bar[XB_XCNT(b.x)], 1u);
    return b;
}
__device__ __forceinline__ void xcd_barrier_complete(unsigned* bar, unsigned x, unsigned& nloc, unsigned& nx) {
    const unsigned G = gridDim.x * gridDim.y * gridDim.z;
    unsigned sum, cnt, mine, sp = 0u;
    for (;;) {
        sum = 0u; cnt = 0u; mine = 0u;
#pragma unroll
        for (unsigned j = 0; j < 16; ++j) { const unsigned c = xb_ld(&bar[XB_XCNT(j)]); sum += c; cnt += (c > 0u) ? 1u : 0u; mine = (j == x) ? c : mine; }
        if (sum == G) break;
        __builtin_amdgcn_s_sleep(1);
        if ((++sp & 255u) == 0u) { if (xb_ld(&bar[XB_TMO])) break; if (sp > XB_SPIN_CAP) { atomicAdd(&bar[XB_TMO], 1u); break; } }
    }
    nloc = mine > 0u ? mine : 1u; nx = cnt > 0u ? cnt : 1u;
}
__device__ __forceinline__ void xcd_barrier(const XcdBarrier& b) {
    asm volatile("s_waitcnt vmcnt(0)" ::: "memory");
    __syncthreads();
    if (threadIdx.x == 0) {
        unsigned* bar = b.bar;
        __builtin_amdgcn_s_waitcnt(0);
        unsigned nloc = b.st[0], nx = b.st[1];
        if (nloc == 0u) { xcd_barrier_complete(bar, b.x, nloc, nx); b.st[0] = nloc; b.st[1] = nx; }
        const unsigned old = xb_add(&bar[XB_XSUB(b.x)], 1u);
        const unsigned gen = old / nloc;
        if (old + 1u == (gen + 1u) * nloc) {
            __builtin_amdgcn_fence(__ATOMIC_RELEASE, "agent");
            asm volatile("s_waitcnt vmcnt(0)" ::: "memory");
            const unsigned og = xb_add(&bar[XB_TOP], 1u);
            const unsigned tg = og / nx;
            if (og + 1u == (tg + 1u) * nx) xb_add(&bar[XB_TOPGEN], 1u);
            else XB_SPIN(xb_ld(&bar[XB_TOPGEN]) == tg, bar);
            __builtin_amdgcn_fence(__ATOMIC_ACQUIRE, "agent");
            xb_add(&bar[XB_XGEN(b.x)], 1u);
            asm volatile("s_waitcnt vmcnt(0)" ::: "memory");
        } else {
            XB_SPIN(xb_ld(&bar[XB_XGEN(b.x)]) == gen, bar);
            __builtin_amdgcn_fence(__ATOMIC_ACQUIRE, "agent");
            asm volatile("s_waitcnt vmcnt(0)" ::: "memory");
        }
    }
    __syncthreads();
}

namespace pg8 {
constexpr int BM = 256, BK = 64, HALF = 128, HTB = HALF * BK * 2, STAGE_BYTES = 8 * HTB, NXCD = 8, WGM = 8;
__host__ __device__ __forceinline__ int lds_byte(int r, int c) { const int st = (r >> 4) * 2 + (c >> 5), rr = r & 15, cc = c & 31, ob = rr * 64 + cc * 2; return st * 1024 + (ob ^ (((ob >> 9) & 1) << 5)); }
__host__ __device__ __forceinline__ void stage_rc(int b, int& R, int& C) { const int st = b / 1024, sb = b % 1024, swz = sb ^ (((sb >> 9) & 1) << 5); R = (st >> 1) * 16 + swz / 64; C = (st & 1) * 32 + (swz % 64) / 2; }
__host__ __device__ __forceinline__ int perm32(int rho) { const int n = rho >> 4, i = rho & 15; return 8 * (i >> 2) + 4 * n + (i & 3); }
__device__ __forceinline__ unsigned cvt_pk_bf16(float lo, float hi) { unsigned r; asm volatile("v_cvt_pk_bf16_f32 %0, %1, %2" : "=v"(r) : "v"(lo), "v"(hi)); return r; }

struct Unit { int pm, pn, e, cnt; };

struct DenseOrder {
    int nM, nN, nwg, G, c;
    __device__ void init(int M, int N, int G_, int c_) { nM = M / BM; nN = N / BM; nwg = nM * nN; G = G_; c = c_; }
    __device__ bool next(int i, Unit& u) const {
        const long L = (long)i * G + c; if (L >= nwg) return false;
        int wgid = (int)L; { const int q = nwg / NXCD, r = nwg % NXCD, xcd = wgid % NXCD, off = wgid / NXCD; wgid = (xcd < r ? xcd * (q + 1) : r * (q + 1) + (xcd - r) * q) + off; }
        const int nig = WGM * nN, gid = wgid / nig, fm = gid * WGM, gsz = (nM - fm) < WGM ? (nM - fm) : WGM;
        u.pm = fm + ((wgid % nig) % gsz); u.pn = (wgid % nig) / gsz; u.e = 0; u.cnt = 256; return true;
    }
};

template <class P, class Epi, bool FP8 = false>
__device__ __forceinline__ void gemm_phase(LAS unsigned char* lds, const P& S, const Epi& E) {
    int tid_ = threadIdx.x; asm volatile("" : "+v"(tid_));
    const int tid = tid_, wid = __builtin_amdgcn_readfirstlane(tid >> 6), lane = tid & 63, wr = wid >> 2, wc = wid & 3, fr = lane & 15, fq = lane >> 4;
    const int nt = S.nt;
    unsigned voffA[2], voffB[2];
    { int R0, C0, R1, C1; stage_rc(tid * 16, R0, C0); stage_rc(tid * 16 + 8192, R1, C1);
      const int Rb0 = Epi::PERM ? ((R0 & ~31) + perm32(R0 & 31)) : R0, Rb1 = Epi::PERM ? ((R1 & ~31) + perm32(R1 & 31)) : R1;
      voffB[0] = (unsigned)Rb0 * S.ldb2 + (unsigned)C0 * 2u; voffB[1] = (unsigned)Rb1 * S.ldb2 + (unsigned)C1 * 2u;
      if constexpr (!P::GATHER) { voffA[0] = (unsigned)R0 * S.lda2 + (unsigned)C0 * 2u; voffA[1] = (unsigned)R1 * S.lda2 + (unsigned)C1 * 2u; } else { voffA[0] = 0u; voffA[1] = 0u; } }
    const unsigned ldsw = (unsigned)wid * 1024u;
    const int aoff = lds_byte(wr * 64 + fr, fq * 8), boff = lds_byte(wc * 32 + fr, fq * 8);
#define PG8_SA(b, h) (((b) * 2 + (h)) * HTB)
#define PG8_SB(b, h) ((4 + (b) * 2 + (h)) * HTB)
#define PG8_STAGE_A(bufoff, aptr, koff, h) do { _Pragma("unroll") for (int _i = 0; _i < 2; ++_i) { \
        const char* _src; if constexpr (P::GATHER) _src = (aptr) + (size_t)ga[h][_i] + (size_t)(koff); else _src = (aptr) + (size_t)(h) * hstepA + (size_t)voffA[_i] + (size_t)(koff); \
        __builtin_amdgcn_global_load_lds((const unsigned*)_src, (LAS unsigned*)(lds + (bufoff) + ldsw + _i * 8192), 16, 0, 0); } } while (0)
#define PG8_STAGE_B(bufoff, bptr) do { _Pragma("unroll") for (int _i = 0; _i < 2; ++_i) \
        __builtin_amdgcn_global_load_lds((const unsigned*)((bptr) + voffB[_i]), (LAS unsigned*)(lds + (bufoff) + ldsw + _i * 8192), 16, 0, 0); } while (0)
#define PG8_LD16(off) (*(const LAS i32x4*)(lds + (off)))
#define PG8_LDA(dst, b, h) do { _Pragma("unroll") for (int m = 0; m < 4; ++m) { \
        if constexpr (FP8) { const i32x4 _l = PG8_LD16(PG8_SA(b, h) + aoff + m * 2048), _h = PG8_LD16(PG8_SA(b, h) + aoff + m * 2048 + 1024); dst[m] = __builtin_shufflevector(_l, _h, 0, 1, 2, 3, 4, 5, 6, 7); } \
        else { dst##16[m][0] = *(const LAS bf16x8*)(lds + PG8_SA(b, h) + aoff + m * 2048); dst##16[m][1] = *(const LAS bf16x8*)(lds + PG8_SA(b, h) + aoff + m * 2048 + 1024); } } } while (0)
#define PG8_LDB(dst, b, h) do { _Pragma("unroll") for (int n = 0; n < 2; ++n) { \
        if constexpr (FP8) { const i32x4 _l = PG8_LD16(PG8_SB(b, h) + boff + n * 2048), _h = PG8_LD16(PG8_SB(b, h) + boff + n * 2048 + 1024); dst[n] = __builtin_shufflevector(_l, _h, 0, 1, 2, 3, 4, 5, 6, 7); } \
        else { dst##16[n][0] = *(const LAS bf16x8*)(lds + PG8_SB(b, h) + boff + n * 2048); dst##16[n][1] = *(const LAS bf16x8*)(lds + PG8_SB(b, h) + boff + n * 2048 + 1024); } } } while (0)
#define PG8_MMA(ai, bj, At, Bt) do { __builtin_amdgcn_s_setprio(1); _Pragma("unroll") for (int m = 0; m < 4; ++m) _Pragma("unroll") for (int n = 0; n < 2; ++n) { \
        if constexpr (FP8) {   \
            asm volatile("v_mfma_scale_f32_16x16x128_f8f6f4 %0, %1, %2, %0, %3, %4 op_sel_hi:[0,0,0]" : "+v"(acc[ai][bj][m][n]) : "v"(Bt[n]), "v"(At[m]), "v"(scw), "v"(scx)); \
        } else { _Pragma("unroll") for (int k = 0; k < 2; ++k) \
            acc[ai][bj][m][n] = __builtin_amdgcn_mfma_f32_16x16x32_bf16(Bt##16[n][k], At##16[m][k], acc[ai][bj][m][n], 0, 0, 0); } } \
        __builtin_amdgcn_s_setprio(0); } while (0)
#define PG8_WAIT_V(n) asm volatile("s_waitcnt vmcnt(" #n ")" ::: "memory")
#define PG8_WAIT_L(n) asm volatile("s_waitcnt lgkmcnt(" #n ")" ::: "memory")
#define PG8_BAR __builtin_amdgcn_s_barrier()
#define PG8_SCHED __builtin_amdgcn_sched_barrier(0)
    Unit cur, nxt; int ui = 0;
    if (!S.next(0, cur)) return;
    f32x4 acc[2][2][4][2];
#pragma unroll
    for (int a = 0; a < 2; ++a)
#pragma unroll
        for (int b = 0; b < 2; ++b)
#pragma unroll
            for (int m = 0; m < 4; ++m)
#pragma unroll
                for (int n = 0; n < 2; ++n) acc[a][b][m][n] = (f32x4){0.f, 0.f, 0.f, 0.f};
    const int scw = 0x7a7a7a7a, scx = 0x7f7f7f7f;
    i32x8 At[4], B0[2], B1[2]; bf16x8 At16[4][2], B016[2][2], B116[2][2];
    unsigned ga[2][2] = {{0u, 0u}, {0u, 0u}};
    const size_t hstepA = P::GATHER ? (size_t)0 : (size_t)128 * S.lda2;
    const char *cA, *nA, *cB0, *cB1, *nB0, *nB1;
    cA = S.aptr(cur); if constexpr (P::GATHER) S.aoffs(cur, tid, ga);
    S.bptrs(cur, cB0, cB1);
    const size_t kstep = (size_t)(BK * 2);
    PG8_STAGE_B(PG8_SB(0, 0), cB0); PG8_STAGE_B(PG8_SB(0, 1), cB1); PG8_STAGE_A(PG8_SA(0, 0), cA, 0, 0); PG8_STAGE_A(PG8_SA(0, 1), cA, 0, 1);
    if (wr == 1) PG8_BAR;
    PG8_WAIT_V(2); PG8_BAR;
    PG8_STAGE_B(PG8_SB(1, 0), cB0 + kstep); PG8_STAGE_A(PG8_SA(1, 0), cA, kstep, 0); PG8_STAGE_B(PG8_SB(1, 1), cB1 + kstep);
    PG8_WAIT_V(6); PG8_BAR;
    for (;;) {
        const bool has_next = S.next(ui + 1, nxt);
        if (has_next) { nA = S.aptr(nxt); S.bptrs(nxt, nB0, nB1); } else { nxt = cur; nA = cA; nB0 = cB0; nB1 = cB1; }
        for (int t = 0; t < nt; t += 2) {
            if constexpr (Epi::MIDK) { if (t == (nt >> 1)) E.mid(acc, cur, wr, wc, fr, fq); }
            const bool last = (t == nt - 2);
            const size_t k1 = (size_t)(t + 1) * kstep;
            const size_t k2 = last ? (size_t)0 : (size_t)(t + 2) * kstep, k3 = k2 + kstep;
            const char* a2 = last ? nA : cA;
            const char* b20 = (last ? nB0 : cB0) + k2; const char* b21 = (last ? nB1 : cB1) + k2;
            const char* b30 = b20 + kstep; const char* b31 = b21 + kstep;
            PG8_LDB(B0, 0, 0); PG8_LDB(B1, 0, 1); PG8_SCHED; PG8_LDA(At, 0, 0); PG8_STAGE_A(PG8_SA(1, 1), cA, k1, 1);
            if constexpr (P::GATHER) { if (last && has_next) S.aoffs(nxt, tid, ga); }
            PG8_WAIT_V(8); PG8_WAIT_L(0); PG8_BAR; PG8_MMA(0, 0, At, B0); PG8_MMA(0, 1, At, B1); PG8_BAR; PG8_SCHED;
            PG8_LDA(At, 0, 1); PG8_STAGE_B(PG8_SB(0, 0), b20); PG8_STAGE_B(PG8_SB(0, 1), b21); PG8_STAGE_A(PG8_SA(0, 0), a2, k2, 0);
            PG8_WAIT_V(8); PG8_WAIT_L(0); PG8_BAR; PG8_MMA(1, 0, At, B0); PG8_MMA(1, 1, At, B1); PG8_BAR; PG8_SCHED;
            PG8_LDB(B0, 1, 0); PG8_LDB(B1, 1, 1); PG8_SCHED; PG8_LDA(At, 1, 0); PG8_STAGE_A(PG8_SA(0, 1), a2, k2, 1);
            PG8_WAIT_V(8); PG8_WAIT_L(0); PG8_BAR; PG8_MMA(0, 0, At, B0); PG8_MMA(0, 1, At, B1); PG8_BAR; PG8_SCHED;
            PG8_LDA(At, 1, 1); PG8_STAGE_B(PG8_SB(1, 0), b30); PG8_STAGE_B(PG8_SB(1, 1), b31); PG8_STAGE_A(PG8_SA(1, 0), a2, k3, 0);
            PG8_WAIT_V(8); PG8_WAIT_L(0); PG8_BAR; PG8_MMA(1, 0, At, B0); PG8_MMA(1, 1, At, B1); PG8_BAR; PG8_SCHED;
        }
        if (wr == 0) PG8_BAR;
        if constexpr (FP8) asm volatile("s_nop 15\n\ts_nop 15" ::: "memory");
        E(acc, cur, wr, wc, fr, fq);
        if (!has_next) break;
#pragma unroll
        for (int a = 0; a < 2; ++a)
#pragma unroll
            for (int b = 0; b < 2; ++b)
#pragma unroll
                for (int m = 0; m < 4; ++m)
#pragma unroll
                    for (int n = 0; n < 2; ++n) acc[a][b][m][n] = (f32x4){0.f, 0.f, 0.f, 0.f};
        cur = nxt; cA = nA; cB0 = nB0; cB1 = nB1; ++ui;
        if (wr == 1) PG8_BAR;
    }
    PG8_WAIT_V(0);
    PG8_BAR;
#undef PG8_SA
#undef PG8_SB
#undef PG8_STAGE_A
#undef PG8_STAGE_B
#undef PG8_LD16
#undef PG8_LDA
#undef PG8_LDB
#undef PG8_MMA
#undef PG8_WAIT_V
#undef PG8_WAIT_L
#undef PG8_BAR
#undef PG8_SCHED
}
}

struct Args { const float* in[28]; float* out; unsigned char* ws; int ph_lo, ph_hi; };
enum { IN_X = 0, IN_C, IN_ADAW, IN_ADAB, IN_N1G, IN_WIN, IN_LBL, IN_HGNG, IN_QNG, IN_KNG, IN_LQ1, IN_LK1, IN_LQ2, IN_LK2, IN_DANG, IN_RELB, IN_WA, IN_WB, IN_WOUT,
       IN_N2G, IN_RW, IN_RB, IN_EG, IN_EU, IN_ED, IN_SG, IN_SU, IN_SD };

struct Frame {
    LAS unsigned char* lds;
    volatile LAS unsigned* MISC;
    unsigned* ctl; float* vec;
    int tid, lane, wave, vcu, G;
    unsigned char* ws;
};


__device__ __forceinline__ unsigned pk4_fp8(float a, float b, float c, float d) { int p = 0; p = __builtin_amdgcn_cvt_pk_fp8_f32(a, b, p, false); p = __builtin_amdgcn_cvt_pk_fp8_f32(c, d, p, true); return (unsigned)p; }
constexpr float W8_SCALE = 32.0f;
#define OPAQUE_V(x) asm volatile("" : "+v"(x))
#define PHASE_IDS() int tid_ = threadIdx.x; asm volatile("" : "+v"(tid_)); const int tid = tid_, lane = tid & 63, wid = __builtin_amdgcn_readfirstlane(tid >> 6); (void)lane; (void)wid
struct TrItem { const float* src; int N; unsigned char* dst; int ldb; int fp8; };
__device__ __forceinline__ void tr_load(const TrItem& it, int lane, f32x4 (&v)[8]) {
#pragma unroll
    for (int i = 0; i < 8; ++i) v[i] = *(const GAS f32x4*)(it.src + (size_t)(8 * i + (lane >> 3)) * it.N + 4 * (lane & 7));
}
__device__ __forceinline__ void tr_finish(const TrItem& it, int lane, LAS float* scr, const f32x4 (&v)[8]) {
    const int q = lane & 7;
#pragma unroll
    for (int i = 0; i < 8; ++i) { const int kk = 8 * i + (lane >> 3);
        scr[(4 * q + 0) * 68 + kk] = v[i].x; scr[(4 * q + 1) * 68 + kk] = v[i].y; scr[(4 * q + 2) * 68 + kk] = v[i].z; scr[(4 * q + 3) * 68 + kk] = v[i].w; }
    LDS_WAIT(); asm volatile("" ::: "memory");
    const int n = lane >> 1, kh = lane & 1; const LAS float* s = scr + n * 68 + 32 * kh;
    f32x4 x[8];
#pragma unroll
    for (int j = 0; j < 8; ++j) x[j] = *(const LAS f32x4*)(s + 4 * j);
    if (it.fp8) {
        unsigned o[8];
#pragma unroll
        for (int j = 0; j < 8; ++j) o[j] = pk4_fp8(x[j].x * W8_SCALE, x[j].y * W8_SCALE, x[j].z * W8_SCALE, x[j].w * W8_SCALE);
        GAS v4u* d = (GAS v4u*)(it.dst + (size_t)n * it.ldb + 32 * kh);
        d[0] = (v4u){o[0], o[1], o[2], o[3]}; d[1] = (v4u){o[4], o[5], o[6], o[7]};
    } else {
        unsigned o[16];
#pragma unroll
        for (int j = 0; j < 8; ++j) { o[2 * j] = pk2(x[j].x, x[j].y); o[2 * j + 1] = pk2(x[j].z, x[j].w); }
        GAS v4u* d = (GAS v4u*)(it.dst + (size_t)n * it.ldb + 64 * kh);
#pragma unroll
        for (int j = 0; j < 4; ++j) d[j] = (v4u){o[4 * j], o[4 * j + 1], o[4 * j + 2], o[4 * j + 3]};
    }
    LDS_WAIT(); asm volatile("" ::: "memory");
}
#define TR_PAIR(itA, hasB, itB, lane, scr) do { f32x4 _va[8], _vb[8]; tr_load(itA, lane, _va); if (hasB) tr_load(itB, lane, _vb); tr_finish(itA, lane, scr, _va); if (hasB) tr_finish(itB, lane, scr, _vb); } while (0)

__device__ __forceinline__ void transpose_item(const float* W, int N, bf16* WT, int ldt, int koff, int row_off, LAS float* scr, int item, int lane) {
    const int nblk = N / 32, kb = item / nblk, nb = item % nblk, k0 = 64 * kb, n0 = 32 * nb;
#pragma unroll 8
    for (int i = 0; i < 32; ++i) { const int kk = 2 * i + (lane >> 5); scr[kk * 33 + (lane & 31)] = W[(size_t)(k0 + kk) * N + n0 + (lane & 31)]; }
    LDS_WAIT(); asm volatile("" ::: "memory");
    const int c = lane & 7;
#pragma unroll
    for (int j = 0; j < 4; ++j) { const int n = (lane >> 3) + 8 * j; const LAS float* s = scr + (8 * c) * 33 + n;
        v4u o; o.x = pk2(s[0 * 33], s[1 * 33]); o.y = pk2(s[2 * 33], s[3 * 33]); o.z = pk2(s[4 * 33], s[5 * 33]); o.w = pk2(s[6 * 33], s[7 * 33]);
        *(GAS v4u*)(WT + (size_t)(row_off + n0 + n) * ldt + koff + k0 + 8 * c) = o; }
    LDS_WAIT(); asm volatile("" ::: "memory");
}

__device__ __forceinline__ void transpose_item_fp8(const float* W, int N, unsigned char* WT, int ldt, LAS float* scr, int kb, int nb, int lane) {
    const int k0 = 64 * kb, n0 = 32 * nb;
#pragma unroll 8
    for (int i = 0; i < 32; ++i) { const int kk = 2 * i + (lane >> 5); scr[kk * 33 + (lane & 31)] = W[(size_t)(k0 + kk) * N + n0 + (lane & 31)]; }
    LDS_WAIT(); asm volatile("" ::: "memory");
    const int n = lane >> 1, kh = lane & 1; const LAS float* s = scr + (32 * kh) * 33 + n;
    unsigned o[8];
#pragma unroll
    for (int q = 0; q < 8; ++q) o[q] = pk4_fp8(s[(4 * q) * 33] * W8_SCALE, s[(4 * q + 1) * 33] * W8_SCALE, s[(4 * q + 2) * 33] * W8_SCALE, s[(4 * q + 3) * 33] * W8_SCALE);
    GAS v4u* dst = (GAS v4u*)(WT + (size_t)(n0 + n) * ldt + k0 + 32 * kh);
    dst[0] = (v4u){o[0], o[1], o[2], o[3]}; dst[1] = (v4u){o[4], o[5], o[6], o[7]};
    LDS_WAIT(); asm volatile("" ::: "memory");
}

__device__ __forceinline__ void phase_mod(Frame& F, const Args& a) {
    const float* c = a.in[IN_C]; const float* W = a.in[IN_ADAW]; const float* bia = a.in[IN_ADAB];
    PHASE_IDS();
    LAS float* cact = (LAS float*)F.lds;
    for (int i = tid; i < 4 * D; i += NTHREADS) { const float v = c[i]; cact[i] = v * fsigmoid(v); }
    __syncthreads();
    float* mod = (float*)(F.ctl + CW_MOD);
    LAS float* RED = (LAS float*)(F.lds + 32768);
    for (int cg = blockIdx.x; cg < 256; cg += F.G) {
        const int cq = tid % 12, dg = tid / 12, n = cg * 48 + cq * 4;
        if (dg < 42) {
            f32x4 acc[4];
#pragma unroll
            for (int b = 0; b < 4; ++b) acc[b] = (f32x4){0.f, 0.f, 0.f, 0.f};
            for (int d = dg; d < D; d += 42) {
                const f32x4 w = *(const GAS f32x4*)(W + (size_t)d * 12288 + n);
#pragma unroll
                for (int b = 0; b < 4; ++b) { const float cv = cact[b * D + d]; acc[b] += w * cv; }
            }
#pragma unroll
            for (int b = 0; b < 4; ++b) *(LAS f32x4*)(RED + (dg * 4 + b) * 48 + cq * 4) = acc[b];
        }
        __syncthreads();
        if (tid < 192) {
            const int b = tid / 48, cc = tid % 48;
            float s = bia[cg * 48 + cc];
            for (int g2 = 0; g2 < 42; ++g2) s += RED[(g2 * 4 + b) * 48 + cc];
            mod[b * 12288 + cg * 48 + cc] = s;
        }
        __syncthreads();
    }
    if (blockIdx.x == 0) {
        const float* lbl = a.in[IN_LBL];
        for (int k = tid; k < 1024; k += NTHREADS) { const float l0 = lbl[k], l1 = lbl[1024 + k]; const float m = fmaxf(l0, l1); const float e0 = __expf(l0 - m), e1 = __expf(l1 - m); F.vec[VW_LB + k] = e0 / (e0 + e1); }
        if (tid < 64) {
            const int l = tid;
            float s1 = a.in[IN_LQ1][l] * a.in[IN_LK1][l], s2 = a.in[IN_LQ2][l] * a.in[IN_LK2][l];
            s1 = wave_sum(s1); s2 = wave_sum(s2);
            float qg = fabsf(a.in[IN_QNG][l]), kg = fabsf(a.in[IN_KNG][l]);
#pragma unroll
            for (int o = 1; o < 64; o <<= 1) { qg = fmaxf(qg, __shfl_xor(qg, o)); kg = fmaxf(kg, __shfl_xor(kg, o)); }
            float mb = -1e30f;
            for (int i = l; i < 256; i += 64) mb = fmaxf(mb, a.in[IN_RELB][i]);
#pragma unroll
            for (int o = 1; o < 64; o <<= 1) mb = fmaxf(mb, __shfl_xor(mb, o));
            if (l == 0) { F.vec[VW_LAM] = __expf(s1) - __expf(s2) + LAMBDA_INIT; F.vec[VW_M2] = (8.0f * qg * kg * 1.01f + fmaxf(mb, 0.f)) * LOG2E; }
        }
        for (int i = tid; i < 8 * 256; i += NTHREADS) {
            const int h = i >> 8, dist = i & 255;
            int bucket;
            if (dist < 16) bucket = dist; else { const double v = log((double)dist / 16.0) / log(8.0) * 16.0; int lg = 16 + (int)v; bucket = lg < 31 ? lg : 31; }
            F.vec[VW_TBL + i] = a.in[IN_RELB][bucket * 8 + h] * LOG2E;
        }
    }
}

__device__ __forceinline__ void norm_mod_row(const float* xrow, const float* g, const float* shift, const float* scale, bf16* orow, unsigned char* orow8, int lane) {
    const GAS f32x4* xr = (const GAS f32x4*)xrow + lane;
    f32x4 v[8]; float s = 0.f;
#pragma unroll
    for (int j = 0; j < 8; ++j) { v[j] = xr[64 * j]; s += (v[j].x * v[j].x + v[j].y * v[j].y) + (v[j].z * v[j].z + v[j].w * v[j].w); }
    const float rstd = 1.f / sqrtf(wave_sum(s) * (1.f / D) + EPS);
    GAS v2u* o8 = (GAS v2u*)orow + lane;
#pragma unroll
    for (int j = 0; j < 8; ++j) {
        const int d = 4 * lane + 256 * j;
        const f32x4 gg = *(const f32x4*)(g + d), sh = *(const f32x4*)(shift + d), sc = *(const f32x4*)(scale + d);
        const f32x4 y = v[j] * rstd * gg * (sc + 1.0f) + sh;
        v2u o; o.x = pk2(y.x, y.y); o.y = pk2(y.z, y.w); o8[64 * j] = o;
        ((GAS unsigned*)orow8)[lane + 64 * j] = pk4_fp8(y.x, y.y, y.z, y.w);
    }
}
__device__ __forceinline__ void phase_prep1(Frame& F, const Args& a) {
    PHASE_IDS();
    LAS float* scr = (LAS float*)(F.lds + wid * 16384);
    const int gw = F.vcu * NWAVES + wid, NGW = F.G * NWAVES;
    constexpr int I_IN = (D / 64) * (INCOLS / 32), I_A = (1024 / 64) * (D / 32), I_O = (D / 64) * (D / 32), I_SG = (D / 64) * (DEXP / 32), I_SD = (DEXP / 64) * (D / 32);
    constexpr int NITEMS = I_IN + 2 * I_A + I_O + 2 * I_SG + I_SD;
    unsigned char* ws = F.ws;
#define PREP_DECODE(IT, idx) do { int r_ = (idx); \
        if (r_ < I_IN) { const int nblk = INCOLS / 32, kb = r_ / nblk, n0 = (r_ % nblk) * 32, k0 = 64 * kb; IT.src = a.in[IN_WIN] + (size_t)k0 * INCOLS + n0; IT.N = INCOLS; \
            if (n0 < 3072)      { IT.fp8 = 0; IT.ldb = D * 2; IT.dst = ws + WS_WIN + ((size_t)n0 * D + k0) * 2; }                         \
            else if (n0 < 4096) { IT.fp8 = 1; IT.ldb = D;     IT.dst = ws + WS_WIN8 + (size_t)(n0 - 3072) * D + k0; }                       \
            else if (n0 < 7168) { IT.fp8 = 0; IT.ldb = D * 2; IT.dst = ws + WS_WIN + ((size_t)(n0 - 1024) * D + k0) * 2; }                  \
            else                { IT.fp8 = 1; IT.ldb = D;     IT.dst = ws + WS_WIN8 + (size_t)(n0 - 7168 + 1024) * D + k0; } }              \
        else { r_ -= I_IN; \
        if (r_ < I_A) { const int kb = r_ / (D / 32), n0 = (r_ % (D / 32)) * 32, k0 = 64 * kb; IT.src = a.in[IN_WA] + (size_t)k0 * D + n0; IT.N = D; IT.fp8 = 0; IT.ldb = D * 2; IT.dst = ws + WS_WA + ((size_t)n0 * D + k0) * 2; } \
        else { r_ -= I_A; \
        if (r_ < I_A) { const int kb = r_ / (D / 32), n0 = (r_ % (D / 32)) * 32, k0 = 64 * kb; IT.src = a.in[IN_WB] + (size_t)k0 * D + n0; IT.N = D; IT.fp8 = 0; IT.ldb = D * 2; IT.dst = ws + WS_WA + ((size_t)n0 * D + 1024 + k0) * 2; } \
        else { r_ -= I_A; \
        if (r_ < I_O) { const int kb = r_ / (D / 32), n0 = (r_ % (D / 32)) * 32, k0 = 64 * kb; IT.src = a.in[IN_WOUT] + (size_t)k0 * D + n0; IT.N = D; IT.fp8 = 0; IT.ldb = D * 2; IT.dst = ws + WS_WOUT + ((size_t)n0 * D + k0) * 2; } \
        else { r_ -= I_O; \
        if (r_ < I_SG) { const int kb = r_ / (DEXP / 32), n0 = (r_ % (DEXP / 32)) * 32, k0 = 64 * kb; IT.src = a.in[IN_SG] + (size_t)k0 * DEXP + n0; IT.N = DEXP; IT.fp8 = 1; IT.ldb = D; IT.dst = ws + WS_WSH + (size_t)n0 * D + k0; } \
        else { r_ -= I_SG; \
        if (r_ < I_SG) { const int kb = r_ / (DEXP / 32), n0 = (r_ % (DEXP / 32)) * 32, k0 = 64 * kb; IT.src = a.in[IN_SU] + (size_t)k0 * DEXP + n0; IT.N = DEXP; IT.fp8 = 1; IT.ldb = D; IT.dst = ws + WS_WSH + 2 * MiB + (size_t)n0 * D + k0; } \
        else { r_ -= I_SG; const int kb = r_ / (D / 32), n0 = (r_ % (D / 32)) * 32, k0 = 64 * kb; IT.src = a.in[IN_SD] + (size_t)k0 * D + n0; IT.N = D; IT.fp8 = 1; IT.ldb = DEXP; IT.dst = ws + WS_WSH + 4 * MiB + (size_t)n0 * DEXP + k0; } } } } } } } while (0)
    for (int it = gw; it < NITEMS; it += 2 * NGW) {
        TrItem A_, B_; const bool hasB = (it + NGW < NITEMS);
        PREP_DECODE(A_, it); if (hasB) PREP_DECODE(B_, it + NGW); else B_ = A_;
        TR_PAIR(A_, hasB, B_, lane, scr);
    }
#undef PREP_DECODE
    { bf16* RH = (bf16*)(ws + WS_RWT_HI); bf16* RL = (bf16*)(ws + WS_RWT_LO); const float* rw = a.in[IN_RW];
      for (int i = (F.vcu * NWAVES + wid) * 64 + lane; i < 64 * D; i += F.G * NTHREADS) { const int e = i & 63, k = i >> 6; const float w = rw[i];
          const unsigned hb = f2bf(w); RH[e * D + k] = (bf16)hb; RL[e * D + k] = (bf16)f2bf(w - bf2f(hb)); } }
}
__device__ __forceinline__ void phase_hrows(Frame& F, const Args& a) {
    PHASE_IDS();
    const int gw = F.vcu * NWAVES + wid, NGW = F.G * NWAVES;
    unsigned char* ws = F.ws;
    const float* mod = (const float*)(F.ctl + CW_MOD);
    for (int m = gw; m < T; m += NGW) { const int b = m / SEQ;
        norm_mod_row(a.in[IN_X] + (size_t)m * D, a.in[IN_N1G], mod + b * 12288, mod + b * 12288 + 2048, (bf16*)(ws + WS_H) + (size_t)m * D, ws + WS_H8 + (size_t)m * D, lane); }
}

struct DenseGemm : pg8::DenseOrder {
    static constexpr bool GATHER = false;
    const char* A; const char* Bt; unsigned lda2, ldb2; int nt;
    __device__ __forceinline__ const char* aptr(const pg8::Unit& u) const { return A + (size_t)(u.pm * 256) * lda2; }
    __device__ __forceinline__ void aoffs(const pg8::Unit&, int, unsigned (&)[2][2]) const {}
    __device__ __forceinline__ void bptrs(const pg8::Unit& u, const char*& b0, const char*& b1) const { b0 = Bt + (size_t)(u.pn * 256) * ldb2; b1 = b0 + (size_t)128 * ldb2; }
};

template <int PART>
struct EpiInProj {
    static constexpr bool PERM = true, MIDK = false;
    unsigned char* ws;
    __device__ __forceinline__ void operator()(const f32x4 (&acc)[2][2][4][2], const pg8::Unit& u, int wr, int wc, int fr, int fq) const {
        bf16* base; int ldc, colt;
        if (PART == 0) { const int idx = u.pn >> 2, slot = idx < 3 ? idx : idx + 1; base = (bf16*)(ws + WS_PROJ + (size_t)slot * 32 * MiB); ldc = 1024; colt = (u.pn & 3) * 256; }
        else if (u.pn < 4) { base = (bf16*)(ws + WS_HG); ldc = 1024; colt = u.pn * 256; }
        else { const int q = u.pn - 4; base = (bf16*)(ws + WS_GA + (size_t)(q >> 3) * 64 * MiB); ldc = 2048; colt = (q & 7) * 256; }
        const int row0 = u.pm * 256 + wr * 64 + fr, col0 = colt + wc * 32 + 8 * fq;
#pragma unroll
        for (int ai = 0; ai < 2; ++ai)
#pragma unroll
            for (int m = 0; m < 4; ++m) { bf16* rowp = base + (size_t)(row0 + ai * 128 + m * 16) * ldc + col0;
#pragma unroll
                for (int bj = 0; bj < 2; ++bj) { const f32x4 v0 = acc[ai][bj][m][0], v1 = acc[ai][bj][m][1];
                    v4u w; w.x = pg8::cvt_pk_bf16(v0[0], v0[1]); w.y = pg8::cvt_pk_bf16(v0[2], v0[3]); w.z = pg8::cvt_pk_bf16(v1[0], v1[1]); w.w = pg8::cvt_pk_bf16(v1[2], v1[3]);
                    *(v4u*)(rowp + bj * 128) = w; } }
    }
};


constexpr int H1_TS = 272, H1_TS2 = 144;
constexpr int H1_QD = 0, H1_KD = 17408, H1_KI = 34816, H1_KBT = 60928, H1_VT = 79360, H1_AT = 97792, H1_TOT = 107008;
__device__ __forceinline__ void phase_h1(Frame& F) {
    unsigned char* ws = F.ws;
    const bf16* HQ = (const bf16*)(ws + WS_HQ); bf16* QT = (bf16*)(ws + WS_QT); const bf16* HF = (const bf16*)(ws + WS_HF); const bf16* HI = (const bf16*)(ws + WS_HI);
    bf16* STg = (bf16*)(ws + WS_ST); float* DEC = (float*)(ws + WS_DEC); float* OI = (float*)(ws + WS_OI);
    LAS unsigned char* L = F.lds;
    LAS float* TOT = (LAS float*)(L + H1_TOT);
    PHASE_IDS();
    const int k = tid & 127, qd = tid >> 7, r = lane & 15, g = lane >> 4;
    for (int u = F.vcu; u < NCH_UNITS; u += F.G) {
        const int bh = u >> 6, n = u & 63, b = bh >> 3, h = bh & 7;
        const size_t row0 = (size_t)b * SEQ + (size_t)n * 64;
        const int col = h * 128 + k;
        float cs[16], kk[16], qs[16]; unsigned vv[16];
        const float lbk = F.vec[VW_LB + col];
        {
            float run = 0.f;
#pragma unroll
            for (int uu = 0; uu < 16; ++uu) {
                const size_t idx = (row0 + 16 * qd + uu) * 1024 + col;
                const float q = bf2f(HQ[idx]), f = bf2f(HF[idx]); vv[uu] = HI[idx];
                const float fg = lbk + (1.f - lbk) * fsigmoid(f);
                run += __logf(fg); cs[uu] = run; kk[uu] = 1.f - fg; qs[uu] = q * fsigmoid(q) * 0.08838834764831845f;
            }
            TOT[qd * 128 + k] = run;
        }
        __syncthreads();
        const float t0 = TOT[k], t1 = TOT[128 + k], t2 = TOT[256 + k], t3 = TOT[384 + k];
        const float r1 = t0, r2 = t0 + t1, r3 = r2 + t2, b63 = r3 + t3;
        const float rq = qd == 0 ? 0.f : (qd == 1 ? r1 : (qd == 2 ? r2 : r3));
        {
            unsigned kbp[8], vtp[8];
#pragma unroll
            for (int uu = 0; uu < 16; ++uu) {
                const int t = 16 * qd + uu; const float c = cs[uu], bt = rq + c;
                *(LAS bf16*)(L + H1_QD + t * H1_TS + 2 * k) = (bf16)f2bf(qs[uu] * __expf(c));
                *(LAS bf16*)(L + H1_KD + t * H1_TS + 2 * k) = (bf16)f2bf(kk[uu] * __expf(fminf(-c, 60.f)));
                if (qd < 1) *(LAS bf16*)(L + H1_KI + (0 + t) * H1_TS + 2 * k) = (bf16)f2bf(kk[uu] * __expf(r1 - bt));
                if (qd < 2) *(LAS bf16*)(L + H1_KI + (16 + t) * H1_TS + 2 * k) = (bf16)f2bf(kk[uu] * __expf(r2 - bt));
                if (qd < 3) *(LAS bf16*)(L + H1_KI + (48 + t) * H1_TS + 2 * k) = (bf16)f2bf(kk[uu] * __expf(r3 - bt));
                const unsigned kbv = f2bf(kk[uu] * __expf(b63 - bt));
                if (uu & 1) { kbp[uu >> 1] |= kbv << 16; vtp[uu >> 1] |= vv[uu] << 16; } else { kbp[uu >> 1] = kbv; vtp[uu >> 1] = vv[uu]; }
                QT[(row0 + t) * 1024 + col] = (bf16)f2bf(qs[uu] * __expf(bt));
            }
            *(LAS v4u*)(L + H1_KBT + k * H1_TS2 + 32 * qd) = (v4u){kbp[0], kbp[1], kbp[2], kbp[3]};
            *(LAS v4u*)(L + H1_KBT + k * H1_TS2 + 32 * qd + 16) = (v4u){kbp[4], kbp[5], kbp[6], kbp[7]};
            *(LAS v4u*)(L + H1_VT + k * H1_TS2 + 32 * qd) = (v4u){vtp[0], vtp[1], vtp[2], vtp[3]};
            *(LAS v4u*)(L + H1_VT + k * H1_TS2 + 32 * qd + 16) = (v4u){vtp[4], vtp[5], vtp[6], vtp[7]};
            if (qd == 0) DEC[(size_t)u * 128 + k] = __expf(b63);
        }
        __syncthreads();
        for (int blk = wid; blk < 10; blk += 8) {
            const int i = blk >= 6 ? 3 : (blk >= 3 ? 2 : (blk >= 1 ? 1 : 0)), j = blk - (i * (i + 1)) / 2;
            const int kib = (i == 2) ? 16 : (i == 3 ? 48 : 0);
            const int krow_off = (j == i) ? (H1_KD + (16 * j + r) * H1_TS) : (H1_KI + (kib + 16 * j + r) * H1_TS);
            f32x4 acc = (f32x4){0.f, 0.f, 0.f, 0.f};
#pragma unroll
            for (int ks = 0; ks < 4; ++ks) {
                const bf16x8 af = *(const LAS bf16x8*)(L + H1_QD + (16 * i + r) * H1_TS + (32 * ks + 8 * g) * 2);
                const bf16x8 bfv = *(const LAS bf16x8*)(L + krow_off + (32 * ks + 8 * g) * 2);
                acc = __builtin_amdgcn_mfma_f32_16x16x32_bf16(af, bfv, acc, 0, 0, 0);
            }
#pragma unroll
            for (int rg = 0; rg < 4; ++rg) {
                const int tl = 4 * g + rg; float v = acc[rg];
                if (j == i && r > tl) v = 0.f;
                *(LAS bf16*)(L + H1_AT + (16 * i + tl) * H1_TS2 + (16 * j + r) * 2) = (bf16)f2bf(v);
            }
        }
        if (wid >= 2) {
            const int zb = wid - 2, zi = zb < 3 ? 0 : (zb < 5 ? 1 : 2), zj = zb < 3 ? zb + 1 : (zb < 5 ? zb - 1 : 3);
#pragma unroll
            for (int rg = 0; rg < 4; ++rg) *(LAS bf16*)(L + H1_AT + (16 * zi + 4 * g + rg) * H1_TS2 + (16 * zj + r) * 2) = (bf16)0;
        }
        __syncthreads();
        {
            bf16x8 vf[2];
#pragma unroll
            for (int ks = 0; ks < 2; ++ks) vf[ks] = *(const LAS bf16x8*)(L + H1_VT + (16 * wid + r) * H1_TS2 + (32 * ks + 8 * g) * 2);
#pragma unroll
            for (int rb = 0; rb < 4; ++rb) {
                f32x4 acc = (f32x4){0.f, 0.f, 0.f, 0.f};
#pragma unroll
                for (int ks = 0; ks < 2; ++ks) { const bf16x8 af = *(const LAS bf16x8*)(L + H1_AT + (16 * rb + r) * H1_TS2 + (32 * ks + 8 * g) * 2);
                    acc = __builtin_amdgcn_mfma_f32_16x16x32_bf16(af, vf[ks], acc, 0, 0, 0); }
#pragma unroll
                for (int rg = 0; rg < 4; ++rg) OI[(row0 + 16 * rb + 4 * g + rg) * 1024 + h * 128 + 16 * wid + r] = acc[rg];
            }
#pragma unroll
            for (int rb = 0; rb < 8; ++rb) {
                f32x4 acc = (f32x4){0.f, 0.f, 0.f, 0.f};
#pragma unroll
                for (int ks = 0; ks < 2; ++ks) { const bf16x8 af = *(const LAS bf16x8*)(L + H1_KBT + (16 * rb + r) * H1_TS2 + (32 * ks + 8 * g) * 2);
                    acc = __builtin_amdgcn_mfma_f32_16x16x32_bf16(af, vf[ks], acc, 0, 0, 0); }
                v2u o; o.x = pk2(acc[0], acc[1]); o.y = pk2(acc[2], acc[3]);
                *(GAS v2u*)(STg + (size_t)u * 16384 + (16 * wid + r) * 128 + 16 * rb + 4 * g) = o;
            }
        }
        __syncthreads();
    }
}

__device__ __forceinline__ void phase_qkprep(Frame& F, const Args& a) {
    PHASE_IDS();
    const int gw = F.vcu * NWAVES + wid, NGW = F.G * NWAVES;
    float gq[16], gk[16];
#pragma unroll
    for (int e = 0; e < 16; ++e) { gq[e] = a.in[IN_QNG][16 * (lane & 3) + e] * (0.125f * LOG2E); gk[e] = a.in[IN_KNG][16 * (lane & 3) + e]; }
    for (int m = gw; m < T; m += NGW) {
#pragma unroll
        for (int which = 0; which < 2; ++which) {
            const bf16* p = (const bf16*)(F.ws + (which ? WS_DK : WS_DQ)) + (size_t)m * 1024 + 16 * lane;
            bf16* po = (bf16*)(F.ws + (which ? WS_DKN : WS_DQN)) + (size_t)m * 1024 + 16 * lane;
            const v4u w0 = *(const GAS v4u*)p, w1 = *(const GAS v4u*)(p + 8);
            float x[16];
            x[0] = bflo(w0.x); x[1] = bfhi(w0.x); x[2] = bflo(w0.y); x[3] = bfhi(w0.y); x[4] = bflo(w0.z); x[5] = bfhi(w0.z); x[6] = bflo(w0.w); x[7] = bfhi(w0.w);
            x[8] = bflo(w1.x); x[9] = bfhi(w1.x); x[10] = bflo(w1.y); x[11] = bfhi(w1.y); x[12] = bflo(w1.z); x[13] = bfhi(w1.z); x[14] = bflo(w1.w); x[15] = bfhi(w1.w);
            float ss = 0.f;
#pragma unroll
            for (int e = 0; e < 16; ++e) ss += x[e] * x[e];
            ss += __shfl_xor(ss, 1); ss += __shfl_xor(ss, 2);
            const float rstd = 1.f / sqrtf(ss * (1.f / 64.f) + EPS);
#pragma unroll
            for (int e = 0; e < 16; ++e) x[e] = x[e] * rstd * (which ? gk[e] : gq[e]);
            v4u o0, o1;
            o0.x = pk2(x[0], x[1]); o0.y = pk2(x[2], x[3]); o0.z = pk2(x[4], x[5]); o0.w = pk2(x[6], x[7]);
            o1.x = pk2(x[8], x[9]); o1.y = pk2(x[10], x[11]); o1.z = pk2(x[12], x[13]); o1.w = pk2(x[14], x[15]);
            *(GAS v4u*)po = o0; *(GAS v4u*)(po + 8) = o1;
        }
    }
}

__device__ __forceinline__ void phase_h2(Frame& F) {
    bf16* STg = (bf16*)(F.ws + WS_ST); const float* DEC = (const float*)(F.ws + WS_DEC);
    const int NIT = 32 * 128 * 32;
    PHASE_IDS();
    for (int it = F.vcu * NTHREADS + tid; it < NIT; it += F.G * NTHREADS) {
        const int bh = it >> 12, v = (it >> 5) & 127, kg = it & 31;
        float run0 = 0.f, run1 = 0.f, run2 = 0.f, run3 = 0.f;
        for (int n0 = 0; n0 < NCHUNK; n0 += 4) {
            v2u loc[4]; f32x4 dc[4];
#pragma unroll
            for (int j = 0; j < 4; ++j) { const size_t un = (size_t)bh * 64 + n0 + j;
                loc[j] = *(const GAS v2u*)(STg + un * 16384 + v * 128 + kg * 4); dc[j] = *(const GAS f32x4*)(DEC + un * 128 + kg * 4); }
#pragma unroll
            for (int j = 0; j < 4; ++j) { const size_t un = (size_t)bh * 64 + n0 + j;
                v2u o; o.x = pk2(run0, run1); o.y = pk2(run2, run3);
                *(GAS v2u*)(STg + un * 16384 + v * 128 + kg * 4) = o;
                run0 = dc[j].x * run0 + bflo(loc[j].x); run1 = dc[j].y * run1 + bfhi(loc[j].x); run2 = dc[j].z * run2 + bflo(loc[j].y); run3 = dc[j].w * run3 + bfhi(loc[j].y); }
        }
    }
}

__device__ __forceinline__ void phase_h3(Frame& F, const Args& a) {
    const bf16* HQ = (const bf16*)(F.ws + WS_QT); const bf16* HG = (const bf16*)(F.ws + WS_HG); const bf16* STg = (const bf16*)(F.ws + WS_ST);
    const float* OI = (const float*)(F.ws + WS_OI); bf16* BR = (bf16*)(F.ws + WS_BR);
    PHASE_IDS();
    const int r = lane & 15, g = lane >> 4, sub = wid >> 2, rb = wid & 3;
    float gn[8];
#pragma unroll
    for (int cb = 0; cb < 8; ++cb) gn[cb] = a.in[IN_HGNG][16 * cb + r];
    for (int up = F.vcu; up < NCH_UNITS / 2; up += F.G) {
        const int u = up * 2 + sub, bh = u >> 6, n = u & 63, b = bh >> 3, h = bh & 7;
        const size_t m0 = (size_t)b * SEQ + (size_t)n * 64 + 16 * rb;
        bf16x8 af[4];
#pragma unroll
        for (int ks = 0; ks < 4; ++ks) af[ks] = *(const GAS bf16x8*)(HQ + (m0 + r) * 1024 + h * 128 + 32 * ks + 8 * g);
        f32x4 acc[8];
#pragma unroll
        for (int cb = 0; cb < 8; ++cb) {
            acc[cb] = (f32x4){0.f, 0.f, 0.f, 0.f};
#pragma unroll
            for (int ks = 0; ks < 4; ++ks) { const bf16x8 bfv = *(const GAS bf16x8*)(STg + (size_t)u * 16384 + (16 * cb + r) * 128 + 32 * ks + 8 * g);
                acc[cb] = __builtin_amdgcn_mfma_f32_16x16x32_bf16(af[ks], bfv, acc[cb], 0, 0, 0); }
        }
        float ss[4] = {0.f, 0.f, 0.f, 0.f};
#pragma unroll
        for (int cb = 0; cb < 8; ++cb)
#pragma unroll
            for (int rg = 0; rg < 4; ++rg) { const float o = acc[cb][rg] + OI[(m0 + 4 * g + rg) * 1024 + h * 128 + 16 * cb + r]; acc[cb][rg] = o; ss[rg] += o * o; }
#pragma unroll
        for (int rg = 0; rg < 4; ++rg) { float s = ss[rg]; s += __shfl_xor(s, 1); s += __shfl_xor(s, 2); s += __shfl_xor(s, 4); s += __shfl_xor(s, 8); ss[rg] = 1.f / sqrtf(s * (1.f / 128.f) + EPS); }
#pragma unroll
        for (int cb = 0; cb < 8; ++cb)
#pragma unroll
            for (int rg = 0; rg < 4; ++rg) {
                const float gv = bf2f(HG[(m0 + 4 * g + rg) * 1024 + h * 128 + 16 * cb + r]);
                BR[(m0 + 4 * g + rg) * 2048 + h * 128 + 16 * cb + r] = (bf16)f2bf(acc[cb][rg] * ss[rg] * gn[cb] * (gv * fsigmoid(gv)));
            }
    }
}

__device__ __forceinline__ void phase_convert_experts(Frame& F, const Args& a) {
    PHASE_IDS();
    LAS float* scr = (LAS float*)(F.lds + wid * 16384);
    const int gw = F.vcu * NWAVES + wid, NGW = F.G * NWAVES;
    constexpr int IPM = 256, NITEMS = NEXP * 3 * IPM;
    for (int it = gw; it < NITEMS; it += NGW) {
        const int e = it / (3 * IPM), r = it % (3 * IPM), which = r / IPM, item = r % IPM;
        TrItem A_, B_; A_.fp8 = 1;
        if (which < 2) { const int kb2 = item / (DEXP / 32), n0 = (item % (DEXP / 32)) * 32, k0 = 128 * kb2;
            A_.src = a.in[which ? IN_EU : IN_EG] + (size_t)e * D * DEXP + (size_t)k0 * DEXP + n0; A_.N = DEXP; A_.ldb = D; A_.dst = F.ws + (which ? WS_WU : WS_WG) + (size_t)e * DEXP * D + (size_t)n0 * D + k0; }
        else { const int kb2 = item / (D / 32), n0 = (item % (D / 32)) * 32, k0 = 128 * kb2;
            A_.src = a.in[IN_ED] + (size_t)e * DEXP * D + (size_t)k0 * D + n0; A_.N = D; A_.ldb = DEXP; A_.dst = F.ws + WS_WDOWN + (size_t)e * D * DEXP + (size_t)n0 * DEXP + k0; }
        B_ = A_; B_.src = A_.src + (size_t)64 * A_.N; B_.dst = A_.dst + 64;
        TR_PAIR(A_, true, B_, lane, scr);
    }
}

constexpr int AT_KCH = 1040, AT_VDB = 4160, AT_STAGE = 33280, AT_TBL = 66560, AT_WSF = 67584, AT_QF = 68608;
__device__ __forceinline__ int crow(int r, int hi) { return (r & 3) + 8 * (r >> 2) + 4 * hi; }
__device__ __forceinline__ void phase_attn(Frame& F, const Args& a, const int pi_lo, const int pi_hi) {
    const bf16* DQ = (const bf16*)(F.ws + WS_DQN); const bf16* DK = (const bf16*)(F.ws + WS_DKN); const bf16* DV = (const bf16*)(F.ws + WS_DV);
    bf16* BR = (bf16*)(F.ws + WS_BR);
    LAS unsigned char* L = F.lds;
    LAS float* TBL = (LAS float*)(L + AT_TBL); LAS float* WSF = (LAS float*)(L + AT_WSF); LAS float* XB = (LAS float*)L;
    PHASE_IDS();
    const int c = wid >> 2, qblk = wid & 3, r32 = lane & 31, hi = lane >> 5;
    const float lam = F.vec[VW_LAM], M2 = F.vec[VW_M2];
    const int lrow0 = tid >> 4, lch = tid & 15, lrow1 = lrow0 + 32;
    const int kdst0 = lch * AT_KCH + lrow0 * 16, kdst1 = lch * AT_KCH + lrow1 * 16;
    const int vdst0 = 16640 + (lch >> 2) * AT_VDB + (lrow0 >> 4) * 1024 + (lrow0 & 15) * 64 + (lch & 3) * 16;
    const int vdst1 = 16640 + (lch >> 2) * AT_VDB + (lrow1 >> 4) * 1024 + (lrow1 & 15) * 64 + (lch & 3) * 16;
    const int vlane = 16640 + ((lane >> 4) & 1) * 32 + (lane & 3) * 8 + (4 * hi + ((lane & 15) >> 2)) * 64;
    float dg[4];
#pragma unroll
    for (int d0 = 0; d0 < 4; ++d0) dg[d0] = a.in[IN_DANG][32 * d0 + r32] * (1.0f - LAMBDA_INIT);
    for (int pi = pi_lo; pi < pi_hi; ++pi) {
        if (pi == (F.vcu & 3)) { phase_convert_experts(F, a); __syncthreads(); }
        const int pp = F.vcu * 2 + (pi >> 1);
        if (pp >= 512) break;
        const int bh = pp >> 4, s = pp & 15, qb = (pi & 1) ? 31 - s : s, b = bh >> 3, h = bh & 7;
        const int q0 = qb * 128, NT = 2 * qb + 2;
        const size_t rowb = (size_t)b * SEQ;
        if (tid < 256) TBL[tid] = F.vec[VW_TBL + h * 256 + tid];
        const int qfo = AT_QF + wid * 4096 + lane * 16;
#pragma unroll
        for (int d0 = 0; d0 < 4; ++d0) *(LAS bf16x8*)(L + qfo + d0 * 1024) = *(const GAS bf16x8*)(DQ + (rowb + q0 + 32 * qblk + r32) * 1024 + h * 128 + c * 64 + 16 * d0 + 8 * hi);
        const bf16* ksrc0 = DK + (rowb + lrow0) * 1024 + h * 128 + lch * 8; const bf16* ksrc1 = ksrc0 + (size_t)32 * 1024;
        const bf16* vsrc0 = DV + (rowb + lrow0) * 1024 + h * 128 + lch * 8; const bf16* vsrc1 = vsrc0 + (size_t)32 * 1024;
        v4u kr0, kr1, vr0, vr1;
        kr0 = *(const GAS v4u*)ksrc0; kr1 = *(const GAS v4u*)ksrc1; vr0 = *(const GAS v4u*)vsrc0; vr1 = *(const GAS v4u*)vsrc1;
        *(LAS v4u*)(L + kdst0) = kr0; *(LAS v4u*)(L + kdst1) = kr1; *(LAS v4u*)(L + vdst0) = vr0; *(LAS v4u*)(L + vdst1) = vr1;
        __syncthreads();
        const float tb31 = TBL[255];
        f32x16 o[4];
#pragma unroll
        for (int d0 = 0; d0 < 4; ++d0)
#pragma unroll
            for (int rr = 0; rr < 16; ++rr) o[d0][rr] = 0.f;
        float lsum = 0.f;
        const int qpos = q0 + 32 * qblk + r32;
        for (int j = 0; j < NT; ++j) {
            const int st = (j & 1) * AT_STAGE, sn = ((j + 1) & 1) * AT_STAGE;
            const bool more = (j + 1 < NT);
            if (more) { const size_t go = (size_t)(j + 1) * 64 * 1024;
                kr0 = *(const GAS v4u*)(ksrc0 + go); kr1 = *(const GAS v4u*)(ksrc1 + go); vr0 = *(const GAS v4u*)(vsrc0 + go); vr1 = *(const GAS v4u*)(vsrc1 + go); }
            const bool far = (j < NT - 4);
            const float cinit = far ? (tb31 - M2) : (-M2);
            f32x16 p0, p1;
#pragma unroll
            for (int rr = 0; rr < 16; ++rr) { p0[rr] = cinit; p1[rr] = cinit; }
#pragma unroll
            for (int d0 = 0; d0 < 4; ++d0) {
                const bf16x8 k0 = *(const LAS bf16x8*)(L + st + (8 * c + 2 * d0 + hi) * AT_KCH + r32 * 16);
                const bf16x8 k1 = *(const LAS bf16x8*)(L + st + (8 * c + 2 * d0 + hi) * AT_KCH + r32 * 16 + 512);
                const bf16x8 qf = *(const LAS bf16x8*)(L + qfo + d0 * 1024);
                p0 = __builtin_amdgcn_mfma_f32_32x32x16_bf16(k0, qf, p0, 0, 0, 0);
                p1 = __builtin_amdgcn_mfma_f32_32x32x16_bf16(k1, qf, p1, 0, 0, 0);
            }
            if (!far) {
                float tb0[16], tb1[16];
#pragma unroll
                for (int rr = 0; rr < 16; ++rr) { const int d0v = qpos - (64 * j + crow(rr, hi)), d1v = d0v - 32;
                    tb0[rr] = TBL[d0v < 0 ? 0 : (d0v > 255 ? 255 : d0v)]; tb1[rr] = TBL[d1v < 0 ? 0 : (d1v > 255 ? 255 : d1v)]; }
                asm volatile("s_waitcnt lgkmcnt(0)" ::: "memory");
#pragma unroll
                for (int rr = 0; rr < 16; ++rr) { const int d0v = qpos - (64 * j + crow(rr, hi)), d1v = d0v - 32;
                    p0[rr] = d0v >= 0 ? p0[rr] + tb0[rr] : -INFINITY; p1[rr] = d1v >= 0 ? p1[rr] + tb1[rr] : -INFINITY; }
            }
            float sacc = 0.f;
#pragma unroll
            for (int rr = 0; rr < 16; ++rr) { p0[rr] = __builtin_amdgcn_exp2f(p0[rr]); p1[rr] = __builtin_amdgcn_exp2f(p1[rr]); sacc += p0[rr] + p1[rr]; }
            lsum += sacc;
#define AT_VLD(dst, ks) do { _Pragma("unroll") for (int _d = 0; _d < 4; ++_d) { \
                const s16x4 _lo = __builtin_bit_cast(s16x4, __builtin_amdgcn_ds_read_tr16_b64_v4i16((LAS s16x4*)(L + st + vlane + _d * AT_VDB + (ks) * 1024))); \
                const s16x4 _hh = __builtin_bit_cast(s16x4, __builtin_amdgcn_ds_read_tr16_b64_v4i16((LAS s16x4*)(L + st + vlane + _d * AT_VDB + (ks) * 1024 + 512))); \
                dst[_d] = (bf16x8){_lo[0], _lo[1], _lo[2], _lo[3], _hh[0], _hh[1], _hh[2], _hh[3]}; } } while (0)
#define AT_PV(src, ks) do { v4u _w; if ((ks) < 2) { _w.x = pg8::cvt_pk_bf16(p0[8 * (ks) + 0], p0[8 * (ks) + 1]); _w.y = pg8::cvt_pk_bf16(p0[8 * (ks) + 2], p0[8 * (ks) + 3]); _w.z = pg8::cvt_pk_bf16(p0[8 * (ks) + 4], p0[8 * (ks) + 5]); _w.w = pg8::cvt_pk_bf16(p0[8 * (ks) + 6], p0[8 * (ks) + 7]); } \
                else { _w.x = pg8::cvt_pk_bf16(p1[8 * (ks) - 16], p1[8 * (ks) - 15]); _w.y = pg8::cvt_pk_bf16(p1[8 * (ks) - 14], p1[8 * (ks) - 13]); _w.z = pg8::cvt_pk_bf16(p1[8 * (ks) - 12], p1[8 * (ks) - 11]); _w.w = pg8::cvt_pk_bf16(p1[8 * (ks) - 10], p1[8 * (ks) - 9]); } \
                const bf16x8 _pa = __builtin_bit_cast(bf16x8, _w); \
                _Pragma("unroll") for (int _d = 0; _d < 4; ++_d) o[_d] = __builtin_amdgcn_mfma_f32_32x32x16_bf16(_pa, src[_d], o[_d], 0, 0, 0); } while (0)
            bf16x8 vfa[4], vfb[4];
            AT_VLD(vfa, 0);
            AT_VLD(vfb, 1); AT_PV(vfa, 0);
            AT_VLD(vfa, 2); AT_PV(vfb, 1);
            AT_VLD(vfb, 3); AT_PV(vfa, 2);
            AT_PV(vfb, 3);
#undef AT_VLD
#undef AT_PV
            if (more) { *(LAS v4u*)(L + sn + kdst0) = kr0; *(LAS v4u*)(L + sn + kdst1) = kr1; *(LAS v4u*)(L + sn + vdst0) = vr0; *(LAS v4u*)(L + sn + vdst1) = vr1; }
            __syncthreads();
        }
        lsum += __shfl_xor(lsum, 32);
        if (hi == 0) WSF[wid * 32 + r32] = lsum;
        LDS_WAIT();
        float rli[16];
#pragma unroll
        for (int rr = 0; rr < 16; ++rr) rli[rr] = 1.0f / WSF[wid * 32 + crow(rr, hi)];
        if (c == 1) {
#pragma unroll
            for (int d0 = 0; d0 < 4; ++d0)
#pragma unroll
                for (int rr = 0; rr < 16; ++rr) XB[(qblk * 32 + crow(rr, hi)) * 128 + 32 * d0 + r32] = o[d0][rr] * rli[rr] * lam;
        }
        __syncthreads();
        if (c == 0) {
            float ss[16];
#pragma unroll
            for (int rr = 0; rr < 16; ++rr) ss[rr] = 0.f;
#pragma unroll
            for (int d0 = 0; d0 < 4; ++d0)
#pragma unroll
                for (int rr = 0; rr < 16; ++rr) { const float df = o[d0][rr] * rli[rr] - XB[(qblk * 32 + crow(rr, hi)) * 128 + 32 * d0 + r32]; o[d0][rr] = df; ss[rr] += df * df; }
#pragma unroll
            for (int rr = 0; rr < 16; ++rr) { float s2 = ss[rr]; s2 += __shfl_xor(s2, 1); s2 += __shfl_xor(s2, 2); s2 += __shfl_xor(s2, 4); s2 += __shfl_xor(s2, 8); s2 += __shfl_xor(s2, 16);
                ss[rr] = 1.f / sqrtf(s2 * (1.f / 128.f) + EPS); }
#pragma unroll
            for (int d0 = 0; d0 < 4; ++d0)
#pragma unroll
                for (int rr = 0; rr < 16; ++rr)
                    BR[(rowb + q0 + 32 * qblk + crow(rr, hi)) * 2048 + 1024 + h * 128 + 32 * d0 + r32] = (bf16)f2bf(o[d0][rr] * ss[rr] * dg[d0]);
        }
        __syncthreads();
    }
}

__device__ __forceinline__ void unpack8(const v4u w, float (&x)[8]) { x[0] = bflo(w.x); x[1] = bfhi(w.x); x[2] = bflo(w.y); x[3] = bfhi(w.y); x[4] = bflo(w.z); x[5] = bfhi(w.z); x[6] = bflo(w.w); x[7] = bfhi(w.w); }
struct EpiMergeF {
    static constexpr bool PERM = true, MIDK = true;
    unsigned char* ws;
    __device__ __forceinline__ void mid(f32x4 (&acc)[2][2][4][2], const pg8::Unit& u, int wr, int wc, int fr_, int fq_) const {
        int fr = fr_, fq = fq_; OPAQUE_V(fr); OPAQUE_V(fq);
        const bf16* GAp = (const bf16*)(ws + WS_GA); const bf16* GBp = (const bf16*)(ws + WS_GB);
        const int row0 = u.pm * 256 + wr * 64 + fr, col0 = u.pn * 256 + wc * 32 + 8 * fq;
#pragma unroll
        for (int ai = 0; ai < 2; ++ai)
#pragma unroll
            for (int m = 0; m < 4; ++m)
#pragma unroll
                for (int bj = 0; bj < 2; ++bj) {
                    const size_t off = (size_t)(row0 + ai * 128 + m * 16) * 2048 + col0 + bj * 128;
                    float ga[8], gb[8]; unpack8(*(const GAS v4u*)(GAp + off), ga); unpack8(*(const GAS v4u*)(GBp + off), gb);
#pragma unroll
                    for (int j = 0; j < 4; ++j) {
                        acc[ai][bj][m][0][j] *= (1.0f + __expf(-gb[j])) * __builtin_amdgcn_rcpf(1.0f + __expf(-ga[j]));
                        acc[ai][bj][m][1][j] *= (1.0f + __expf(-gb[4 + j])) * __builtin_amdgcn_rcpf(1.0f + __expf(-ga[4 + j])); }
                }
    }
    __device__ __forceinline__ void operator()(const f32x4 (&acc)[2][2][4][2], const pg8::Unit& u, int wr, int wc, int fr_, int fq_) const {
        int fr = fr_, fq = fq_; OPAQUE_V(fr); OPAQUE_V(fq);
        const bf16* GBp = (const bf16*)(ws + WS_GB); bf16* O = (bf16*)(ws + WS_MERGED);
        const int row0 = u.pm * 256 + wr * 64 + fr, col0 = u.pn * 256 + wc * 32 + 8 * fq;
#pragma unroll
        for (int ai = 0; ai < 2; ++ai)
#pragma unroll
            for (int m = 0; m < 4; ++m)
#pragma unroll
                for (int bj = 0; bj < 2; ++bj) {
                    const size_t off = (size_t)(row0 + ai * 128 + m * 16) * 2048 + col0 + bj * 128;
                    float gb[8], y[8]; unpack8(*(const GAS v4u*)(GBp + off), gb);
                    const f32x4 v0 = acc[ai][bj][m][0], v1 = acc[ai][bj][m][1];
#pragma unroll
                    for (int j = 0; j < 4; ++j) { y[j] = v0[j] * fsigmoid(gb[j]); y[4 + j] = v1[j] * fsigmoid(gb[4 + j]); }
                    v4u w; w.x = pk2(y[0], y[1]); w.y = pk2(y[2], y[3]); w.z = pk2(y[4], y[5]); w.w = pk2(y[6], y[7]);
                    *(GAS v4u*)(O + off) = w;
                }
    }
};
struct EpiOutProj {
    static constexpr bool PERM = true, MIDK = false;
    const float* x; bf16* x1b; const float* mod;
    __device__ __forceinline__ void operator()(const f32x4 (&acc)[2][2][4][2], const pg8::Unit& u, int wr, int wc, int fr_, int fq_) const {
        int fr = fr_, fq = fq_; OPAQUE_V(fr); OPAQUE_V(fq);
        const int row0 = u.pm * 256 + wr * 64 + fr, col0 = u.pn * 256 + wc * 32 + 8 * fq;
        const int b = (u.pm * 256) / SEQ;
#pragma unroll
        for (int ai = 0; ai < 2; ++ai)
#pragma unroll
            for (int m = 0; m < 4; ++m) { const size_t ro = (size_t)(row0 + ai * 128 + m * 16) * D + col0;
#pragma unroll
                for (int bj = 0; bj < 2; ++bj) {
                    const f32x4 x0 = *(const GAS f32x4*)(x + ro + bj * 128), x4 = *(const GAS f32x4*)(x + ro + bj * 128 + 4);
                    const f32x4 g0 = *(const GAS f32x4*)(mod + b * 12288 + 4096 + col0 + bj * 128), g4 = *(const GAS f32x4*)(mod + b * 12288 + 4096 + col0 + bj * 128 + 4);
                    const f32x4 y0 = x0 + g0 * acc[ai][bj][m][0], y1 = x4 + g4 * acc[ai][bj][m][1];
                    v4u w; w.x = pk2(y0[0], y0[1]); w.y = pk2(y0[2], y0[3]); w.z = pk2(y1[0], y1[1]); w.w = pk2(y1[2], y1[3]);
                    *(GAS v4u*)(x1b + ro + bj * 128) = w; } }
    }
};


constexpr int RT_XSLD = 2056;
constexpr int RT_XS = 0, RT_PART = 65792;
constexpr int RT_LCNT = 98560, RT_STOK = 98816, RT_SW = 107008;
constexpr int MOE_TB = MISC_OFF + 1024;
__device__ __forceinline__ void phase_router(Frame& F, const Args& a) {
    PHASE_IDS();
    LAS unsigned char* L = F.lds;
    LAS bf16* XS = (LAS bf16*)(L + RT_XS); LAS float* PART = (LAS float*)(L + RT_PART);
    const bf16* x1 = (const bf16*)(F.ws + WS_X1B); const float* mod = (const float*)(F.ctl + CW_MOD);
    unsigned char* H2 = F.ws + WS_H2;
    int* LTOK = (int*)(F.ws + WS_LTOK); float* LW = (float*)(F.ws + WS_LW);
    const float rbias = a.in[IN_RB][lane];
    if (tid < 64) ((LAS unsigned*)(L + RT_LCNT))[tid] = 0u;
    __syncthreads();
    int rounds = 0, round_row0 = 0;
    for (int grp = F.vcu; grp < T / 16; grp += F.G) {
        if (rounds == 0) round_row0 = grp * 16;
#pragma unroll 1
        for (int rr2 = 0; rr2 < 2; ++rr2) {
            const int rloc = 2 * wid + rr2, m = grp * 16 + rloc, b = m / SEQ;
            const GAS v2u* xr = (const GAS v2u*)(x1 + (size_t)m * D) + lane;
            f32x4 v[8]; float s = 0.f;
#pragma unroll
            for (int j = 0; j < 8; ++j) { const v2u w = xr[64 * j]; v[j] = (f32x4){bflo(w.x), bfhi(w.x), bflo(w.y), bfhi(w.y)}; s += (v[j].x * v[j].x + v[j].y * v[j].y) + (v[j].z * v[j].z + v[j].w * v[j].w); }
            const float rstd = 1.f / sqrtf(wave_sum(s) * (1.f / D) + EPS);
            GAS unsigned* o8 = (GAS unsigned*)(H2 + (size_t)m * D) + lane;
#pragma unroll
            for (int j = 0; j < 8; ++j) {
                const int d = 4 * lane + 256 * j;
                const f32x4 gg = *(const f32x4*)(a.in[IN_N2G] + d), sh = *(const GAS f32x4*)(mod + b * 12288 + 6144 + d), sc = *(const GAS f32x4*)(mod + b * 12288 + 8192 + d);
                const f32x4 y = v[j] * rstd * gg * (sc + 1.0f) + sh;
                o8[64 * j] = pk4_fp8(y.x, y.y, y.z, y.w);
                v2u xb; xb.x = pk2(y.x, y.y); xb.y = pk2(y.z, y.w);
                *(LAS v2u*)(XS + rloc * RT_XSLD + d) = xb;
            }
        }
        __syncthreads();
        {
            const bf16* RH = (const bf16*)(F.ws + WS_RWT_HI);
            const int r = lane & 15, g = lane >> 4;
            f32x4 acc[4];
#pragma unroll
            for (int cb = 0; cb < 4; ++cb) acc[cb] = (f32x4){0.f, 0.f, 0.f, 0.f};
            bf16x8 wh[4], whn[4];
#pragma unroll
            for (int cb = 0; cb < 4; ++cb) wh[cb] = *(const GAS bf16x8*)(RH + (16 * cb + r) * D + 256 * wid + 8 * g);
#pragma unroll 1
            for (int ks = 0; ks < 8; ++ks) {
                const int k0 = 256 * wid + 32 * ks + 8 * g;
                if (ks < 7) {
#pragma unroll
                    for (int cb = 0; cb < 4; ++cb) whn[cb] = *(const GAS bf16x8*)(RH + (16 * cb + r) * D + k0 + 32); }
                const bf16x8 xf = *(const LAS bf16x8*)(XS + r * RT_XSLD + k0);
#pragma unroll
                for (int cb = 0; cb < 4; ++cb) acc[cb] = __builtin_amdgcn_mfma_f32_16x16x32_bf16(xf, wh[cb], acc[cb], 0, 0, 0);
                if (ks < 7) {
#pragma unroll
                    for (int cb = 0; cb < 4; ++cb) wh[cb] = whn[cb]; }
            }
#pragma unroll
            for (int cb = 0; cb < 4; ++cb)
#pragma unroll
                for (int rg = 0; rg < 4; ++rg) PART[(wid * 16 + 4 * g + rg) * 64 + 16 * cb + r] = acc[cb][rg];
        }
        __syncthreads();
#pragma unroll 1
        for (int rr2 = 0; rr2 < 2; ++rr2) {
            const int rloc = 2 * wid + rr2, m = grp * 16 + rloc;
            float logit = 0.f;
#pragma unroll
            for (int w2 = 0; w2 < 8; ++w2) logit += PART[(w2 * 16 + rloc) * 64 + lane];
            const float score = 1.0f / (1.0f + expf(-logit)), sel = score + rbias;
            const int eg = lane >> 3;
            float m1 = sel; m1 = fmaxf(m1, __shfl_xor(m1, 1)); m1 = fmaxf(m1, __shfl_xor(m1, 2)); m1 = fmaxf(m1, __shfl_xor(m1, 4));
            const unsigned long long bm = __ballot(sel == m1);
            const int first = __builtin_ctz((unsigned)((bm >> (8 * eg)) & 0xffull)) + 8 * eg;
            float m2 = (lane == first) ? -INFINITY : sel; m2 = fmaxf(m2, __shfl_xor(m2, 1)); m2 = fmaxf(m2, __shfl_xor(m2, 2)); m2 = fmaxf(m2, __shfl_xor(m2, 4));
            const float gs = m1 + m2;
            int grank = 0;
#pragma unroll
            for (int g2 = 0; g2 < 8; ++g2) { const float o = __shfl(gs, 8 * g2); grank += (o > gs || (o == gs && g2 < eg)) ? 1 : 0; }
            const float masked = grank < 4 ? sel : -INFINITY;
            int rank = 0;
#pragma unroll 8
            for (int e2 = 0; e2 < 64; ++e2) { const float o = __shfl(masked, e2); rank += (o > masked || (o == masked && e2 < lane)) ? 1 : 0; }
            const bool selected = rank < 8;
            const float ssum = wave_sum(selected ? score : 0.f);
            if (selected) {
                const unsigned pos = __hip_atomic_fetch_add((LAS unsigned*)(L + RT_LCNT) + lane, 1u, __ATOMIC_RELAXED, __HIP_MEMORY_SCOPE_WORKGROUP);
                ((LAS unsigned short*)(L + RT_STOK))[lane * 64 + pos] = (unsigned short)((rounds * 16 + rloc) * 8 + rank); ((LAS float*)(L + RT_SW))[lane * 64 + pos] = score / ssum * 2.5f;
            }
        }
        __syncthreads();
        ++rounds;
        if (rounds == 4 || grp + F.G >= T / 16) {
            const int e = tid >> 3, sub = tid & 7;
            const unsigned n = ((LAS unsigned*)(L + RT_LCNT))[e];
            unsigned base = 0u;
            if (sub == 0 && n) base = atomicAdd(F.ctl + CW_CNT + 64 * e, n);
            base = __shfl(base, lane & ~7);
            for (unsigned i = sub; i < n; i += 8) { const int sv = (int)((LAS unsigned short*)(L + RT_STOK))[e * 64 + i]; LTOK[e * 16384 + base + i] = (round_row0 + (sv >> 7) * F.G * 16 + ((sv >> 3) & 15)) * 8 + (sv & 7); LW[e * 16384 + base + i] = ((LAS float*)(L + RT_SW))[e * 64 + i]; }
            __syncthreads();
            if (tid < 64) ((LAS unsigned*)(L + RT_LCNT))[tid] = 0u;
            rounds = 0;
            __syncthreads();
        }
    }
}
__device__ __forceinline__ void moe_build_table(Frame& F) {
    PHASE_IDS();
    LAS int* tb = (LAS int*)(F.lds + MOE_TB); LAS int* cn = tb + 68; LAS int* ab = cn + 68;
    if (tid == 0) {
        int t = 0, r = 0;
        for (int e = 0; e < NEXP; ++e) { const int c = (int)__hip_atomic_load(F.ctl + CW_CNT + 64 * e, RLX_AGENT); tb[e] = t; cn[e] = c; ab[e] = r; t += (c + 255) >> 8; r += c; }
        tb[64] = t; cn[64] = T; ab[64] = r;
    }
    __syncthreads();
    {
        const int* LTOK = (const int*)(F.ws + WS_LTOK); int* INV = (int*)(F.ws + WS_INV);
        for (int wv = F.vcu; wv < 256; wv += F.G) { const int e = wv >> 2, part = wv & 3, n = cn[e], base = ab[e];
            for (int pos = part * NTHREADS + tid; pos < n; pos += 4 * NTHREADS) INV[LTOK[e * 16384 + pos]] = base + pos; }
    }
}
template <int NP>
struct MoeOrder {
    LAS int* tb; int G, c;
    __device__ bool next(int i, pg8::Unit& u) const {
        const int ntr = tb[64]; const long L = (long)i * G + c;
        if (L >= (long)(64 + ntr) * NP) return false;
        int tt = (int)(L / NP); u.pn = (int)(L % NP);
        if (tt < 64) { u.e = 64; u.pm = tt; u.cnt = 256; return true; }
        tt -= 64;
        int lo = 0, hi = 64;
        while (hi - lo > 1) { const int mid = (lo + hi) >> 1; if (tb[mid] <= tt) lo = mid; else hi = mid; }
        u.e = lo; u.pm = tt - tb[lo]; const int rem = tb[68 + lo] - 256 * u.pm; u.cnt = rem < 256 ? rem : 256; return true;
    }
};
struct MoeGemm1 : MoeOrder<4> {
    static constexpr bool GATHER = true;
    unsigned char* ws; unsigned lda2, ldb2; int nt;
    __device__ __forceinline__ const char* aptr(const pg8::Unit&) const { return (const char*)(ws + WS_H2); }
    __device__ __forceinline__ void aoffs(const pg8::Unit& u, int tid, unsigned (&o)[2][2]) const {
        const int* LTOK = (const int*)(ws + WS_LTOK);
        OPAQUE_V(tid);
        int R0, C0, R1, C1; pg8::stage_rc(tid * 16, R0, C0); pg8::stage_rc(tid * 16 + 8192, R1, C1);
#pragma unroll
        for (int h = 0; h < 2; ++h) {
            const int p0 = h * 128 + R0, p1 = h * 128 + R1; int t0, t1;
            if (u.e == 64) { t0 = u.pm * 256 + p0; t1 = u.pm * 256 + p1; }
            else { t0 = p0 < u.cnt ? (LTOK[u.e * 16384 + u.pm * 256 + p0] >> 3) : 0; t1 = p1 < u.cnt ? (LTOK[u.e * 16384 + u.pm * 256 + p1] >> 3) : 0; }
            o[h][0] = (unsigned)t0 * 2048u + (unsigned)C0 * 2u; o[h][1] = (unsigned)t1 * 2048u + (unsigned)C1 * 2u;
        }
    }
    __device__ __forceinline__ void bptrs(const pg8::Unit& u, const char*& b0, const char*& b1) const {
        const char* g = (u.e == 64) ? (const char*)(ws + WS_WSH) : (const char*)(ws + WS_WG) + (size_t)u.e * DEXP * D;
        const char* up = (u.e == 64) ? (const char*)(ws + WS_WSH + 2 * MiB) : (const char*)(ws + WS_WU) + (size_t)u.e * DEXP * D;
        b0 = g + (size_t)(u.pn * 128) * 2048; b1 = up + (size_t)(u.pn * 128) * 2048;
    }
};
struct EpiSwiglu {
    static constexpr bool PERM = true, MIDK = false;
    unsigned char* ws; LAS int* tb;
    __device__ __forceinline__ void operator()(const f32x4 (&acc)[2][2][4][2], const pg8::Unit& u, int wr, int wc, int fr_, int fq_) const {
        int fr = fr_, fq = fq_; OPAQUE_V(fr); OPAQUE_V(fq);
        unsigned char* ACT = ws + WS_ACT;
        const int rbase = tb[136 + u.e] + u.pm * 256, col0 = u.pn * 128 + wc * 32 + 8 * fq;
#pragma unroll
        for (int ai = 0; ai < 2; ++ai)
#pragma unroll
            for (int m = 0; m < 4; ++m) {
                const int rt = ai * 128 + wr * 64 + m * 16 + fr;
                if (rt < u.cnt) {
                    float y[8];
#pragma unroll
                    for (int n = 0; n < 2; ++n)
#pragma unroll
                        for (int j = 0; j < 4; ++j) { const float gt = acc[ai][0][m][n][j], upv = acc[ai][1][m][n][j]; y[4 * n + j] = fminf(fmaxf(gt * fsigmoid(gt) * upv, -448.f), 448.f); }
                    v2u w; w.x = pk4_fp8(y[0], y[1], y[2], y[3]); w.y = pk4_fp8(y[4], y[5], y[6], y[7]);
                    *(GAS v2u*)(ACT + (size_t)(rbase + rt) * DEXP + col0) = w;
                }
            }
    }
};
struct MoeGemm2 : MoeOrder<8> {
    static constexpr bool GATHER = false;
    unsigned char* ws; unsigned lda2, ldb2; int nt;
    __device__ __forceinline__ const char* aptr(const pg8::Unit& u) const { return (const char*)(ws + WS_ACT) + (size_t)(tb[136 + u.e] + u.pm * 256) * 512; }
    __device__ __forceinline__ void aoffs(const pg8::Unit&, int, unsigned (&)[2][2]) const {}
    __device__ __forceinline__ void bptrs(const pg8::Unit& u, const char*& b0, const char*& b1) const {
        const char* dn = (u.e == 64) ? (const char*)(ws + WS_WSH + 4 * MiB) : (const char*)(ws + WS_WDOWN) + (size_t)u.e * D * DEXP;
        b0 = dn + (size_t)(u.pn * 256) * 512; b1 = b0 + (size_t)128 * 512;
    }
};
struct EpiDown {
    static constexpr bool PERM = true, MIDK = false;
    unsigned char* ws; float* out; const float* mod; LAS int* tb;
    __device__ __forceinline__ void operator()(const f32x4 (&acc)[2][2][4][2], const pg8::Unit& u, int wr, int wc, int fr_, int fq_) const {
        int fr = fr_, fq = fq_; OPAQUE_V(fr); OPAQUE_V(fq);
        const int* LTOK = (const int*)(ws + WS_LTOK); const float* LW = (const float*)(ws + WS_LW); unsigned char* Y = ws + WS_Y;
        const int col0 = u.pn * 256 + wc * 32 + 8 * fq, rbase = tb[136 + u.e] + u.pm * 256;
#pragma unroll
        for (int ai = 0; ai < 2; ++ai)
#pragma unroll
            for (int m = 0; m < 4; ++m) {
                const int rt = ai * 128 + wr * 64 + m * 16 + fr;
                if (rt < u.cnt) {
                    if (u.e == 64) {
                        const int t = u.pm * 256 + rt; bf16* YSH = (bf16*)(ws + WS_YSH);
#pragma unroll
                        for (int bj = 0; bj < 2; ++bj) { const f32x4 v0 = acc[ai][bj][m][0], v1 = acc[ai][bj][m][1];
                            v4u pw; pw.x = pk2(v0[0], v0[1]); pw.y = pk2(v0[2], v0[3]); pw.z = pk2(v1[0], v1[1]); pw.w = pk2(v1[2], v1[3]);
                            *(GAS v4u*)(YSH + (size_t)t * D + col0 + bj * 128) = pw; }
                    } else {
                        const int pos = u.e * 16384 + u.pm * 256 + rt; const int tk = rbase + rt; const float w = LW[pos] * Y8_SCALE;
#pragma unroll
                        for (int bj = 0; bj < 2; ++bj) { f32x4 v0 = acc[ai][bj][m][0] * w, v1 = acc[ai][bj][m][1] * w;
#pragma unroll
                            for (int j = 0; j < 4; ++j) { v0[j] = fminf(fmaxf(v0[j], -448.f), 448.f); v1[j] = fminf(fmaxf(v1[j], -448.f), 448.f); }
                            v2u pw; pw.x = pk4_fp8(v0[0], v0[1], v0[2], v0[3]); pw.y = pk4_fp8(v1[0], v1[1], v1[2], v1[3]);
                            *(GAS v2u*)(Y + (size_t)tk * D + col0 + bj * 128) = pw; }
                    }
                }
            }
    }
};
__device__ __forceinline__ void phase_combine(Frame& F, const Args& a) {
    PHASE_IDS();
    const unsigned char* Y = F.ws + WS_Y; const float* mod = (const float*)(F.ctl + CW_MOD); float* out = a.out; const int* INV = (const int*)(F.ws + WS_INV);
    const int NIT = T * (D / 8);
    const bool bad = xb_ld(F.ctl + CW_BAR + XB_TMO) != 0u;
    for (int it = F.vcu * NTHREADS + tid; it < NIT; it += F.G * NTHREADS) {
        const int t = it >> 8, c8 = (it & 255) * 8, b = t / SEQ;
        float s[8];
#pragma unroll
        for (int j = 0; j < 8; ++j) s[j] = 0.f;
#pragma unroll
        for (int k = 0; k < 8; ++k) { const v2u w = *(const GAS v2u*)(Y + (size_t)INV[t * 8 + k] * D + c8);
            const auto f0 = __builtin_amdgcn_cvt_pk_f32_fp8((int)w.x, false), f1 = __builtin_amdgcn_cvt_pk_f32_fp8((int)w.x, true), f2 = __builtin_amdgcn_cvt_pk_f32_fp8((int)w.y, false), f3 = __builtin_amdgcn_cvt_pk_f32_fp8((int)w.y, true);
            s[0] += f0[0]; s[1] += f0[1]; s[2] += f1[0]; s[3] += f1[1]; s[4] += f2[0]; s[5] += f2[1]; s[6] += f3[0]; s[7] += f3[1]; }
#pragma unroll
        for (int j = 0; j < 8; ++j) s[j] *= (1.0f / Y8_SCALE);
        const f32x4 g0 = *(const GAS f32x4*)(mod + b * 12288 + 10240 + c8), g1 = *(const GAS f32x4*)(mod + b * 12288 + 10240 + c8 + 4);
        GAS f32x4* o = (GAS f32x4*)(out + (size_t)t * D + c8);
        float xv[8], sh[8]; unpack8(*(const GAS v4u*)((const bf16*)(F.ws + WS_X1B) + (size_t)t * D + c8), xv); unpack8(*(const GAS v4u*)((const bf16*)(F.ws + WS_YSH) + (size_t)t * D + c8), sh);
#pragma unroll
        for (int j = 0; j < 8; ++j) s[j] += sh[j];
        const f32x4 o0 = (f32x4){xv[0], xv[1], xv[2], xv[3]}, o1 = (f32x4){xv[4], xv[5], xv[6], xv[7]};
        f32x4 r0 = o0 + g0 * (f32x4){s[0], s[1], s[2], s[3]}; const f32x4 r1 = o1 + g1 * (f32x4){s[4], s[5], s[6], s[7]};
        if (bad) r0.x = __builtin_nanf("");
        o[0] = r0; o[1] = r1;
    }
}

__global__ void __launch_bounds__(NTHREADS, 2) fwd_kernel(Args args) {
    extern __shared__ __attribute__((aligned(16))) unsigned char lds[];
    Frame F;
    F.lds = (LAS unsigned char*)lds;
    F.MISC = (volatile LAS unsigned*)(F.lds + MISC_OFF);
    F.tid = threadIdx.x; F.lane = F.tid & 63; F.wave = __builtin_amdgcn_readfirstlane(F.tid >> 6);
    F.G = gridDim.x; { const int bx = blockIdx.x; F.vcu = (F.G % 8 == 0) ? (bx % 8) * (F.G / 8) + bx / 8 : bx; }
    F.ws = args.ws; F.ctl = (unsigned*)(args.ws + WS_CTL); F.vec = (float*)(args.ws + WS_VEC);
    for (int u = F.tid; u < 256; u += NTHREADS) ((LAS unsigned*)(F.lds + MISC_OFF))[u] = 0u;
    __syncthreads();
    XcdBarrier bar = xcd_barrier_post(F.ctl + CW_BAR, F.MISC + 8);
    unsigned char* ws = args.ws;

#define PH_MOD()   do { phase_mod(F, args); } while (0)
#define PH_PREP1() do { phase_prep1(F, args); } while (0)
#define PH_HROWS() do { phase_hrows(F, args); } while (0)
#define PH_INPROJ() do { { DenseGemm g; g.init(T, 6144, F.G, (int)blockIdx.x); g.A = (const char*)(ws + WS_H); g.Bt = (const char*)(ws + WS_WIN); g.lda2 = D * 2; g.ldb2 = D * 2; g.nt = D / 64; \
          EpiInProj<0> E{ws}; pg8::gemm_phase<DenseGemm, EpiInProj<0>>(F.lds, g, E); } \
        { DenseGemm g; g.init(T, 5120, F.G, (int)blockIdx.x); g.A = (const char*)(ws + WS_H8); g.Bt = (const char*)(ws + WS_WIN8); g.lda2 = D; g.ldb2 = D; g.nt = D / 128; \
          EpiInProj<1> E{ws}; pg8::gemm_phase<DenseGemm, EpiInProj<1>, true>(F.lds, g, E); } } while (0)
#define PH_H1()    do { phase_h1(F); } while (0)
#define PH_QKP()   do { phase_qkprep(F, args); } while (0)
#define PH_H2()    do { phase_h2(F); } while (0)
#define PH_H3()    do { phase_h3(F, args); } while (0)
#define PH_ATTN()  do { phase_attn(F, args, 0, 4); } while (0)
#define PH_MERGE() do { DenseGemm g; g.init(T, D, F.G, (int)blockIdx.x); g.A = (const char*)(ws + WS_BR); g.Bt = (const char*)(ws + WS_WA); g.lda2 = D * 2; g.ldb2 = D * 2; g.nt = D / 64; \
        EpiMergeF E{ws}; pg8::gemm_phase<DenseGemm, EpiMergeF>(F.lds, g, E); } while (0)
#define PH_OUTPROJ() do { DenseGemm g; g.init(T, D, F.G, (int)blockIdx.x); g.A = (const char*)(ws + WS_MERGED); g.Bt = (const char*)(ws + WS_WOUT); g.lda2 = D * 2; g.ldb2 = D * 2; g.nt = D / 64; \
        EpiOutProj E{args.in[IN_X], (bf16*)(ws + WS_X1B), (const float*)(F.ctl + CW_MOD)}; pg8::gemm_phase<DenseGemm, EpiOutProj>(F.lds, g, E); } while (0)
#define PH_ROUTER() do { phase_router(F, args); } while (0)
#define PH_CONVX()  do { phase_convert_experts(F, args); } while (0)
#define PH_MOE1()  do { MoeGemm1 g; g.tb = (LAS int*)(F.lds + MOE_TB); g.G = F.G; g.c = F.vcu; g.ws = ws; g.lda2 = D; g.ldb2 = D; g.nt = D / 128; \
        EpiSwiglu E{ws, (LAS int*)(F.lds + MOE_TB)}; pg8::gemm_phase<MoeGemm1, EpiSwiglu, true>(F.lds, g, E); } while (0)
#define PH_MOE2()  do { MoeGemm2 g; g.tb = (LAS int*)(F.lds + MOE_TB); g.G = F.G; g.c = F.vcu; g.ws = ws; g.lda2 = DEXP; g.ldb2 = DEXP; g.nt = DEXP / 128; \
        EpiDown E{ws, args.out, (const float*)(F.ctl + CW_MOD), (LAS int*)(F.lds + MOE_TB)}; pg8::gemm_phase<MoeGemm2, EpiDown, true>(F.lds, g, E); } while (0)
#define PH_COMBINE() do { phase_combine(F, args); } while (0)
#ifndef REPEAT_PHASE
#define REPEAT_PHASE -1
#endif
#define RUN(k, X) do { X; if (REPEAT_PHASE == (k)) { xcd_barrier(bar); X; } } while (0)
    if (F.vcu & 1) { PH_PREP1(); __syncthreads(); PH_MOD(); } else { PH_MOD(); __syncthreads(); PH_PREP1(); }
    xcd_barrier(bar);
    RUN(1, PH_HROWS());    xcd_barrier(bar);
    RUN(2, PH_INPROJ());   xcd_barrier(bar);
    if (F.vcu & 1) { PH_QKP(); PH_H1(); } else { PH_H1(); PH_QKP(); }
    xcd_barrier(bar);
    PH_H2();
    xcd_barrier(bar);
    PH_H3(); phase_attn(F, args, 0, 4);
    xcd_barrier(bar);
    RUN(8, PH_MERGE());    xcd_barrier(bar);
    RUN(9, PH_OUTPROJ());  xcd_barrier(bar);
    PH_ROUTER();           xcd_barrier(bar);
    moe_build_table(F);
    RUN(11, PH_MOE1());    xcd_barrier(bar);
    PH_MOE2();             xcd_barrier(bar);
    PH_COMBINE();
}

extern "C" void kernel_launch(void* const* d_in, const int* in_sizes, int n_in, void* d_out, int out_size, void* d_ws, size_t ws_size, hipStream_t stream) {
    static int grid = 0;
    if (grid == 0) {
        int dev = 0, cus = 0;
        if (n_in != 28 || ws_size < WS_NEED || out_size != T * D) { fprintf(stderr, "kernel_launch: unexpected n_in %d / ws %zu / out %d\n", n_in, ws_size, out_size); grid = -1; return; }
        if (hipGetDevice(&dev) != hipSuccess || hipDeviceGetAttribute(&cus, hipDeviceAttributeMultiprocessorCount, dev) != hipSuccess) { grid = -1; return; }
        if (hipFuncSetAttribute((const void*)fwd_kernel, hipFuncAttributeMaxDynamicSharedMemorySize, LDS_BYTES) != hipSuccess) { grid = -1; return; }
        int per_cu = 0;
        (void)hipOccupancyMaxActiveBlocksPerMultiprocessor(&per_cu, (const void*)fwd_kernel, NTHREADS, LDS_BYTES);
        (void)hipGetLastError();
        grid = cus;
        if (cus != 256) { fprintf(stderr, "kernel_launch: built for a 256-CU MI355X (static work split), found %d CUs; nothing launched\n", cus); grid = -1; return; }
    }
    if (grid < 0) return;
    if (hipMemsetAsync((char*)d_ws + WS_CTL, 0, CTL_ZERO_BYTES, stream) != hipSuccess) return;
    Args a{};
    for (int i = 0; i < 28; ++i) a.in[i] = (const float*)d_in[i];
    a.out = (float*)d_out; a.ws = (unsigned char*)d_ws; a.ph_lo = 0; a.ph_hi = 100;
    hipLaunchKernelGGL(fwd_kernel, dim3(grid), dim3(NTHREADS), LDS_BYTES, stream, a);
}
```

```cpp
#include <hip/hip_runtime.h>
#include <cstdio>
#include <cstdint>

#define GAS __attribute__((address_space(1)))
#define LAS __attribute__((address_space(3)))
typedef unsigned short bf16;
typedef unsigned v4u __attribute__((ext_vector_type(4)));
typedef unsigned v2u __attribute__((ext_vector_type(2)));
typedef float f32x4 __attribute__((ext_vector_type(4)));
typedef float f32x2 __attribute__((ext_vector_type(2)));
typedef float f32x16 __attribute__((ext_vector_type(16)));
typedef short bf16x8 __attribute__((ext_vector_type(8)));
typedef short s16x4 __attribute__((ext_vector_type(4)));
typedef int i32x4 __attribute__((ext_vector_type(4)));
typedef int i32x8 __attribute__((ext_vector_type(8)));

#ifndef STAGE_MAX
#define STAGE_MAX 99
#endif

constexpr int D = 2048, BATCH = 4, SEQ = 4096, T = BATCH * SEQ;
constexpr int HGH = 8, HGD = 128, CHUNK = 64, NCHUNK = SEQ / CHUNK;
constexpr int NCH_UNITS = BATCH * HGH * NCHUNK;
constexpr int DAH = 8, DADH = 64, DADV = 128;
constexpr int INCOLS = 11264;
constexpr int NEXP = 64, TOPK = 8, DEXP = 512;
constexpr float EPS = 1e-6f;
constexpr float LOG2E = 1.4426950408889634f;
constexpr float LAMBDA_INIT = 0.2f;
constexpr int NWAVES = 8, NTHREADS = NWAVES * 64;
constexpr int LDS_BYTES = 147456;
constexpr int MISC_OFF = 131072;

constexpr size_t MiB = 1u << 20;
constexpr size_t WS_CTL = 0, CTL_ZERO_BYTES = 1 * MiB;
constexpr size_t WS_VEC = 1 * MiB;
constexpr size_t WS_LTOK = 2 * MiB, WS_LW = 6 * MiB;
constexpr size_t WS_WSH = 10 * MiB;
constexpr size_t WS_WIN = 16 * MiB;
constexpr size_t WS_WIN8 = 40 * MiB;
constexpr size_t WS_H8 = 848 * MiB;
constexpr size_t WS_WA = 60 * MiB, WS_WB = 64 * MiB;
constexpr size_t WS_WOUT = 68 * MiB;
constexpr size_t WS_H = 76 * MiB;
constexpr size_t WS_PROJ = 140 * MiB;
constexpr size_t WS_HQ = WS_PROJ, WS_HF = WS_PROJ + 32 * MiB, WS_HI = WS_PROJ + 64 * MiB, WS_HG = WS_PROJ + 96 * MiB;
constexpr size_t WS_DQ = WS_PROJ + 128 * MiB, WS_DK = WS_PROJ + 160 * MiB, WS_DV = WS_PROJ + 192 * MiB;
constexpr size_t WS_GA = WS_PROJ + 224 * MiB, WS_GB = WS_PROJ + 288 * MiB;
constexpr size_t WS_ST = 492 * MiB;
constexpr size_t WS_DEC = 556 * MiB;
constexpr size_t WS_OI = 560 * MiB;
constexpr size_t WS_BR = 624 * MiB;
constexpr size_t WS_MERGED = 688 * MiB;
constexpr size_t WS_QT = 752 * MiB;
constexpr size_t WS_DQN = 784 * MiB, WS_DKN = 816 * MiB;
constexpr size_t WS_WDOWN = 882 * MiB;
constexpr size_t WS_ACT = 144 * MiB;
constexpr size_t WS_WG = 946 * MiB, WS_WU = 1010 * MiB;
constexpr size_t WS_H2 = 546 * MiB;
constexpr size_t WS_Y = 290 * MiB;
constexpr float Y8_SCALE = 32.0f;
constexpr size_t WS_X1B = WS_H;
constexpr size_t WS_YSH = WS_BR;
constexpr size_t WS_NEED = 1074 * MiB;

constexpr int CW_BAR = 4096;
constexpr int CW_CNT = 8192;
constexpr int CW_MOD = 16384;
constexpr int VW_LB = 0;
constexpr int VW_LAM = 1024, VW_M2 = 1025;
constexpr int VW_TBL = 2048;
constexpr size_t WS_RWT_HI = WS_VEC + 65536, WS_RWT_LO = WS_VEC + 65536 + 262144;

#define RLX_AGENT __ATOMIC_RELAXED, __HIP_MEMORY_SCOPE_AGENT
#define LDS_WAIT() asm volatile("s_waitcnt lgkmcnt(0)" ::: "memory")
#define VM_WAIT() asm volatile("s_waitcnt vmcnt(0)" ::: "memory")
__device__ __forceinline__ unsigned f2bf(float f) { unsigned u = __builtin_bit_cast(unsigned, f); return (u + 0x7fffu + ((u >> 16) & 1u)) >> 16; }
__device__ __forceinline__ unsigned pk2(float lo, float hi) { return f2bf(lo) | (f2bf(hi) << 16); }
__device__ __forceinline__ float bf2f(unsigned b) { return __builtin_bit_cast(float, b << 16); }
__device__ __forceinline__ float bflo(unsigned w) { return __builtin_bit_cast(float, w << 16); }
__device__ __forceinline__ float bfhi(unsigned w) { return __builtin_bit_cast(float, w & 0xffff0000u); }
__device__ __forceinline__ float fsigmoid(float x) { return __builtin_amdgcn_rcpf(1.0f + __expf(-x)); }
__device__ __forceinline__ float wave_sum(float v) {
#pragma unroll
    for (int o = 1; o < 64; o <<= 1) v += __shfl_xor(v, o);
    return v;
}

#define XB_TMO      128
#define XB_XCNT(j)  (256  + 64 * (j))
#define XB_XSUB(j)  (1280 + 64 * (j))
#define XB_XGEN(j)  (2304 + 64 * (j))
#define XB_TOP      3328
#define XB_TOPGEN   3392
#define XCD_BAR_WORDS 3456
#define XB_SPIN_CAP (1u << 18)
__device__ __forceinline__ unsigned xb_ld(unsigned* p)              { return __hip_atomic_load(p, __ATOMIC_RELAXED, __HIP_MEMORY_SCOPE_AGENT); }
__device__ __forceinline__ unsigned xb_add(unsigned* p, unsigned v) { return __hip_atomic_fetch_add(p, v, __ATOMIC_RELAXED, __HIP_MEMORY_SCOPE_AGENT); }
__device__ __forceinline__ unsigned xb_xcc_id() { return (unsigned)__builtin_amdgcn_s_getreg((3 << 11) | 20) & 0xFu; }
#define XB_SPIN(cond, bar) do { unsigned _sp = 0; while (cond) { __builtin_amdgcn_s_sleep(1); \
    if ((++_sp & 255u) == 0u) { if (xb_ld(&(bar)[XB_TMO])) break; if (_sp > XB_SPIN_CAP) { atomicAdd(&(bar)[XB_TMO], 1u); break; } } } } while (0)
struct XcdBarrier { unsigned* bar; unsigned x; volatile LAS unsigned* st; };
__device__ __forceinline__ XcdBarrier xcd_barrier_post(unsigned* bar, volatile LAS unsigned* st) {
    XcdBarrier b; b.bar = bar; b.x = xb_xcc_id(); b.st = st;
    if (threadIdx.x == 0) (void)xb_add(&bar[XB_XCNT(b.x)], 1u);
    return b;
}
__device__ __forceinline__ void xcd_barrier_complete(unsigned* bar, unsigned x, unsigned& nloc, unsigned& nx) {
    const unsigned G = gridDim.x * gridDim.y * gridDim.z;
    unsigned sum, cnt, mine, sp = 0u;
    for (;;) {
        sum = 0u; cnt = 0u; mine = 0u;
#pragma unroll
        for (unsigned j = 0; j < 16; ++j) { const unsigned c = xb_ld(&bar[XB_XCNT(j)]); sum += c; cnt += (c > 0u) ? 1u : 0u; mine = (j == x) ? c : mine; }
        if (sum == G) break;
        __builtin_amdgcn_s_sleep(1);
        if ((++sp & 255u) == 0u) { if (xb_ld(&bar[XB_TMO])) break; if (sp > XB_SPIN_CAP) { atomicAdd(&bar[XB_TMO], 1u); break; } }
    }
    nloc = mine > 0u ? mine : 1u; nx = cnt > 0u ? cnt : 1u;
}
__device__ __forceinline__ void xcd_barrier(const XcdBarrier& b) {
    asm volatile("s_waitcnt vmcnt(0)" ::: "memory");
    __syncthreads();
    if (threadIdx.x == 0) {
        unsigned* bar = b.bar;
        __builtin_amdgcn_s_waitcnt(0);
        unsigned nloc = b.st[0], nx = b.st[1];
        if (nloc == 0u) { xcd_barrier_complete(bar, b.x, nloc, nx); b.st[0] = nloc; b.st[1] = nx; }
        const unsigned old = xb_add(&bar[XB_XSUB(b.x)], 1u);
        const unsigned gen = old / nloc;
        if (old + 1u == (gen + 1u) * nloc) {
            __builtin_amdgcn_fence(__ATOMIC_RELEASE, "agent");
            asm volatile("s_waitcnt vmcnt(0)" ::: "memory");
            const unsigned og = xb_add(&bar[XB_TOP], 1u);
            const unsigned tg = og / nx;
            if (og + 1u == (tg + 1u) * nx) xb_add(&bar[XB_TOPGEN], 1u);
            else XB_SPIN(xb_ld(&bar[XB_TOPGEN]) == tg, bar);
            __builtin_amdgcn_fence(__ATOMIC_ACQUIRE, "agent");
            xb_add(&bar[XB_XGEN(b.x)], 1u);
            asm volatile("s_waitcnt vmcnt(0)" ::: "memory");
        } else {
            XB_SPIN(xb_ld(&bar[XB_XGEN(b.x)]) == gen, bar);
            __builtin_amdgcn_fence(__ATOMIC_ACQUIRE, "agent");
            asm volatile("s_waitcnt vmcnt(0)" ::: "memory");
        }
    }
    __syncthreads();
}

namespace pg8 {
constexpr int BM = 256, BK = 64, HALF = 128, HTB = HALF * BK * 2, STAGE_BYTES = 8 * HTB, NXCD = 8, WGM = 8;
__host__ __device__ __forceinline__ int lds_byte(int r, int c) { const int st = (r >> 4) * 2 + (c >> 5), rr = r & 15, cc = c & 31, ob = rr * 64 + cc * 2; return st * 1024 + (ob ^ (((ob >> 9) & 1) << 5)); }
__host__ __device__ __forceinline__ void stage_rc(int b, int& R, int& C) { const int st = b / 1024, sb = b % 1024, swz = sb ^ (((sb >> 9) & 1) << 5); R = (st >> 1) * 16 + swz / 64; C = (st & 1) * 32 + (swz % 64) / 2; }
__host__ __device__ __forceinline__ int perm32(int rho) { const int n = rho >> 4, i = rho & 15; return 8 * (i >> 2) + 4 * n + (i & 3); }
__device__ __forceinline__ unsigned cvt_pk_bf16(float lo, float hi) { unsigned r; asm volatile("v_cvt_pk_bf16_f32 %0, %1, %2" : "=v"(r) : "v"(lo), "v"(hi)); return r; }

struct Unit { int pm, pn, e, cnt; };

struct DenseOrder {
    int nM, nN, nwg, G, c;
    __device__ void init(int M, int N, int G_, int c_) { nM = M / BM; nN = N / BM; nwg = nM * nN; G = G_; c = c_; }
    __device__ bool next(int i, Unit& u) const {
        const long L = (long)i * G + c; if (L >= nwg) return false;
        int wgid = (int)L; { const int q = nwg / NXCD, r = nwg % NXCD, xcd = wgid % NXCD, off = wgid / NXCD; wgid = (xcd < r ? xcd * (q + 1) : r * (q + 1) + (xcd - r) * q) + off; }
        const int nig = WGM * nN, gid = wgid / nig, fm = gid * WGM, gsz = (nM - fm) < WGM ? (nM - fm) : WGM;
        u.pm = fm + ((wgid % nig) % gsz); u.pn = (wgid % nig) / gsz; u.e = 0; u.cnt = 256; return true;
    }
};

template <class P, class Epi, bool FP8 = false>
__device__ __forceinline__ void gemm_phase(LAS unsigned char* lds, const P& S, const Epi& E) {
    int tid_ = threadIdx.x; asm volatile("" : "+v"(tid_));
    const int tid = tid_, wid = __builtin_amdgcn_readfirstlane(tid >> 6), lane = tid & 63, wr = wid >> 2, wc = wid & 3, fr = lane & 15, fq = lane >> 4;
    const int nt = S.nt;
    unsigned voffA[2], voffB[2];
    { int R0, C0, R1, C1; stage_rc(tid * 16, R0, C0); stage_rc(tid * 16 + 8192, R1, C1);
      const int Rb0 = Epi::PERM ? ((R0 & ~31) + perm32(R0 & 31)) : R0, Rb1 = Epi::PERM ? ((R1 & ~31) + perm32(R1 & 31)) : R1;
      voffB[0] = (unsigned)Rb0 * S.ldb2 + (unsigned)C0 * 2u; voffB[1] = (unsigned)Rb1 * S.ldb2 + (unsigned)C1 * 2u;
      if constexpr (!P::GATHER) { voffA[0] = (unsigned)R0 * S.lda2 + (unsigned)C0 * 2u; voffA[1] = (unsigned)R1 * S.lda2 + (unsigned)C1 * 2u; } else { voffA[0] = 0u; voffA[1] = 0u; } }
    const unsigned ldsw = (unsigned)wid * 1024u;
    const int aoff = lds_byte(wr * 64 + fr, fq * 8), boff = lds_byte(wc * 32 + fr, fq * 8);
#define PG8_SA(b, h) (((b) * 2 + (h)) * HTB)
#define PG8_SB(b, h) ((4 + (b) * 2 + (h)) * HTB)
#define PG8_STAGE_A(bufoff, aptr, koff, h) do { _Pragma("unroll") for (int _i = 0; _i < 2; ++_i) { \
        const char* _src; if constexpr (P::GATHER) _src = (aptr) + (size_t)ga[h][_i] + (size_t)(koff); else _src = (aptr) + (size_t)(h) * hstepA + (size_t)voffA[_i] + (size_t)(koff); \
        __builtin_amdgcn_global_load_lds((const unsigned*)_src, (LAS unsigned*)(lds + (bufoff) + ldsw + _i * 8192), 16, 0, 0); } } while (0)
#define PG8_STAGE_B(bufoff, bptr) do { _Pragma("unroll") for (int _i = 0; _i < 2; ++_i) \
        __builtin_amdgcn_global_load_lds((const unsigned*)((bptr) + voffB[_i]), (LAS unsigned*)(lds + (bufoff) + ldsw + _i * 8192), 16, 0, 0); } while (0)
#define PG8_LD16(off) (*(const LAS i32x4*)(lds + (off)))
#define PG8_LDA(dst, b, h) do { _Pragma("unroll") for (int m = 0; m < 4; ++m) { \
        if constexpr (FP8) { const i32x4 _l = PG8_LD16(PG8_SA(b, h) + aoff + m * 2048), _h = PG8_LD16(PG8_SA(b, h) + aoff + m * 2048 + 1024); dst[m] = __builtin_shufflevector(_l, _h, 0, 1, 2, 3, 4, 5, 6, 7); } \
        else { dst##16[m][0] = *(const LAS bf16x8*)(lds + PG8_SA(b, h) + aoff + m * 2048); dst##16[m][1] = *(const LAS bf16x8*)(lds + PG8_SA(b, h) + aoff + m * 2048 + 1024); } } } while (0)
#define PG8_LDB(dst, b, h) do { _Pragma("unroll") for (int n = 0; n < 2; ++n) { \
        if constexpr (FP8) { const i32x4 _l = PG8_LD16(PG8_SB(b, h) + boff + n * 2048), _h = PG8_LD16(PG8_SB(b, h) + boff + n * 2048 + 1024); dst[n] = __builtin_shufflevector(_l, _h, 0, 1, 2, 3, 4, 5, 6, 7); } \
        else { dst##16[n][0] = *(const LAS bf16x8*)(lds + PG8_SB(b, h) + boff + n * 2048); dst##16[n][1] = *(const LAS bf16x8*)(lds + PG8_SB(b, h) + boff + n * 2048 + 1024); } } } while (0)
#define PG8_MMA(ai, bj, At, Bt) do { __builtin_amdgcn_s_setprio(1); _Pragma("unroll") for (int m = 0; m < 4; ++m) _Pragma("unroll") for (int n = 0; n < 2; ++n) { \
        if constexpr (FP8) {   \
            asm volatile("v_mfma_scale_f32_16x16x128_f8f6f4 %0, %1, %2, %0, %3, %4 op_sel_hi:[0,0,0]" : "+v"(acc[ai][bj][m][n]) : "v"(Bt[n]), "v"(At[m]), "v"(scw), "v"(scx)); \
        } else { _Pragma("unroll") for (int k = 0; k < 2; ++k) \
            acc[ai][bj][m][n] = __builtin_amdgcn_mfma_f32_16x16x32_bf16(Bt##16[n][k], At##16[m][k], acc[ai][bj][m][n], 0, 0, 0); } } \
        __builtin_amdgcn_s_setprio(0); } while (0)
#define PG8_WAIT_V(n) asm volatile("s_waitcnt vmcnt(" #n ")" ::: "memory")
#define PG8_WAIT_L(n) asm volatile("s_waitcnt lgkmcnt(" #n ")" ::: "memory")
#define PG8_BAR __builtin_amdgcn_s_barrier()
#define PG8_SCHED __builtin_amdgcn_sched_barrier(0)
    Unit cur, nxt; int ui = 0;
    if (!S.next(0, cur)) return;
    f32x4 acc[2][2][4][2];
#pragma unroll
    for (int a = 0; a < 2; ++a)
#pragma unroll
        for (int b = 0; b < 2; ++b)
#pragma unroll
            for (int m = 0; m < 4; ++m)
#pragma unroll
                for (int n = 0; n < 2; ++n) acc[a][b][m][n] = (f32x4){0.f, 0.f, 0.f, 0.f};
    const int scw = 0x7a7a7a7a, scx = 0x7f7f7f7f;
    i32x8 At[4], B0[2], B1[2]; bf16x8 At16[4][2], B016[2][2], B116[2][2];
    unsigned ga[2][2] = {{0u, 0u}, {0u, 0u}};
    const size_t hstepA = P::GATHER ? (size_t)0 : (size_t)128 * S.lda2;
    const char *cA, *nA, *cB0, *cB1, *nB0, *nB1;
    cA = S.aptr(cur); if constexpr (P::GATHER) S.aoffs(cur, tid, ga);
    S.bptrs(cur, cB0, cB1);
    const size_t kstep = (size_t)(BK * 2);
    PG8_STAGE_B(PG8_SB(0, 0), cB0); PG8_STAGE_B(PG8_SB(0, 1), cB1); PG8_STAGE_A(PG8_SA(0, 0), cA, 0, 0); PG8_STAGE_A(PG8_SA(0, 1), cA, 0, 1);
    if (wr == 1) PG8_BAR;
    PG8_WAIT_V(2); PG8_BAR;
    PG8_STAGE_B(PG8_SB(1, 0), cB0 + kstep); PG8_STAGE_A(PG8_SA(1, 0), cA, kstep, 0); PG8_STAGE_B(PG8_SB(1, 1), cB1 + kstep);
    PG8_WAIT_V(6); PG8_BAR;
    for (;;) {
        const bool has_next = S.next(ui + 1, nxt);
        if (has_next) { nA = S.aptr(nxt); S.bptrs(nxt, nB0, nB1); } else { nxt = cur; nA = cA; nB0 = cB0; nB1 = cB1; }
        for (int t = 0; t < nt; t += 2) {
            if constexpr (Epi::MIDK) { if (t == (nt >> 1)) E.mid(acc, cur, wr, wc, fr, fq); }
            const bool last = (t == nt - 2);
            const size_t k1 = (size_t)(t + 1) * kstep;
            const size_t k2 = last ? (size_t)0 : (size_t)(t + 2) * kstep, k3 = k2 + kstep;
            const char* a2 = last ? nA : cA;
            const char* b20 = (last ? nB0 : cB0) + k2; const char* b21 = (last ? nB1 : cB1) + k2;
            const char* b30 = b20 + kstep; const char* b31 = b21 + kstep;
            PG8_LDB(B0, 0, 0); PG8_LDB(B1, 0, 1); PG8_SCHED; PG8_LDA(At, 0, 0); PG8_STAGE_A(PG8_SA(1, 1), cA, k1, 1);
            if constexpr (P::GATHER) { if (last && has_next) S.aoffs(nxt, tid, ga); }
            PG8_WAIT_V(8); PG8_WAIT_L(0); PG8_BAR; PG8_MMA(0, 0, At, B0); PG8_MMA(0, 1, At, B1); PG8_BAR; PG8_SCHED;
            PG8_LDA(At, 0, 1); PG8_STAGE_B(PG8_SB(0, 0), b20); PG8_STAGE_B(PG8_SB(0, 1), b21); PG8_STAGE_A(PG8_SA(0, 0), a2, k2, 0);
            PG8_WAIT_V(8); PG8_WAIT_L(0); PG8_BAR; PG8_MMA(1, 0, At, B0); PG8_MMA(1, 1, At, B1); PG8_BAR; PG8_SCHED;
            PG8_LDB(B0, 1, 0); PG8_LDB(B1, 1, 1); PG8_SCHED; PG8_LDA(At, 1, 0); PG8_STAGE_A(PG8_SA(0, 1), a2, k2, 1);
            PG8_WAIT_V(8); PG8_WAIT_L(0); PG8_BAR; PG8_MMA(0, 0, At, B0); PG8_MMA(0, 1, At, B1); PG8_BAR; PG8_SCHED;
            PG8_LDA(At, 1, 1); PG8_STAGE_B(PG8_SB(1, 0), b30); PG8_STAGE_B(PG8_SB(1, 1), b31); PG8_STAGE_A(PG8_SA(1, 0), a2, k3, 0);
            PG8_WAIT_V(8); PG8_WAIT_L(0); PG8_BAR; PG8_MMA(1, 0, At, B0); PG8_MMA(1, 1, At, B1); PG8_BAR; PG8_SCHED;
        }
        if (wr == 0) PG8_BAR;
        if constexpr (FP8) asm volatile("s_nop 15\n\ts_nop 15" ::: "memory");
        E(acc, cur, wr, wc, fr, fq);
        if (!has_next) break;
#pragma unroll
        for (int a = 0; a < 2; ++a)
#pragma unroll
            for (int b = 0; b < 2; ++b)
#pragma unroll
                for (int m = 0; m < 4; ++m)
#pragma unroll
                    for (int n = 0; n < 2; ++n) acc[a][b][m][n] = (f32x4){0.f, 0.f, 0.f, 0.f};
        cur = nxt; cA = nA; cB0 = nB0; cB1 = nB1; ++ui;
        if (wr == 1) PG8_BAR;
    }
    PG8_WAIT_V(0);
    PG8_BAR;
#undef PG8_SA
#undef PG8_SB
#undef PG8_STAGE_A
#undef PG8_STAGE_B
#undef PG8_LD16
#undef PG8_LDA
#undef PG8_LDB
#undef PG8_MMA
#undef PG8_WAIT_V
#undef PG8_WAIT_L
#undef PG8_BAR
#undef PG8_SCHED
}
}

struct Args { const float* in[28]; float* out; unsigned char* ws; int ph_lo, ph_hi; };
enum { IN_X = 0, IN_C, IN_ADAW, IN_ADAB, IN_N1G, IN_WIN, IN_LBL, IN_HGNG, IN_QNG, IN_KNG, IN_LQ1, IN_LK1, IN_LQ2, IN_LK2, IN_DANG, IN_RELB, IN_WA, IN_WB, IN_WOUT,
       IN_N2G, IN_RW, IN_RB, IN_EG, IN_EU, IN_ED, IN_SG, IN_SU, IN_SD };

struct Frame {
    LAS unsigned char* lds;
    volatile LAS unsigned* MISC;
    unsigned* ctl; float* vec;
    int tid, lane, wave, vcu, G;
    unsigned char* ws;
};


__device__ __forceinline__ unsigned pk4_fp8(float a, float b, float c, float d) { int p = 0; p = __builtin_amdgcn_cvt_pk_fp8_f32(a, b, p, false); p = __builtin_amdgcn_cvt_pk_fp8_f32(c, d, p, true); return (unsigned)p; }
constexpr float W8_SCALE = 32.0f;
#define OPAQUE_V(x) asm volatile("" : "+v"(x))
#define PHASE_IDS() int tid_ = threadIdx.x; asm volatile("" : "+v"(tid_)); const int tid = tid_, lane = tid & 63, wid = __builtin_amdgcn_readfirstlane(tid >> 6); (void)lane; (void)wid
struct TrItem { const float* src; int N; unsigned char* dst; int ldb; int fp8; };
__device__ __forceinline__ void tr_load(const TrItem& it, int lane, f32x4 (&v)[8]) {
#pragma unroll
    for (int i = 0; i < 8; ++i) v[i] = *(const GAS f32x4*)(it.src + (size_t)(8 * i + (lane >> 3)) * it.N + 4 * (lane & 7));
}
__device__ __forceinline__ void tr_finish(const TrItem& it, int lane, LAS float* scr, const f32x4 (&v)[8]) {
    const int q = lane & 7;
#pragma unroll
    for (int i = 0; i < 8; ++i) { const int kk = 8 * i + (lane >> 3);
        scr[(4 * q + 0) * 68 + kk] = v[i].x; scr[(4 * q + 1) * 68 + kk] = v[i].y; scr[(4 * q + 2) * 68 + kk] = v[i].z; scr[(4 * q + 3) * 68 + kk] = v[i].w; }
    LDS_WAIT(); asm volatile("" ::: "memory");
    const int n = lane >> 1, kh = lane & 1; const LAS float* s = scr + n * 68 + 32 * kh;
    f32x4 x[8];
#pragma unroll
    for (int j = 0; j < 8; ++j) x[j] = *(const LAS f32x4*)(s + 4 * j);
    if (it.fp8) {
        unsigned o[8];
#pragma unroll
        for (int j = 0; j < 8; ++j) o[j] = pk4_fp8(x[j].x * W8_SCALE, x[j].y * W8_SCALE, x[j].z * W8_SCALE, x[j].w * W8_SCALE);
        GAS v4u* d = (GAS v4u*)(it.dst + (size_t)n * it.ldb + 32 * kh);
        d[0] = (v4u){o[0], o[1], o[2], o[3]}; d[1] = (v4u){o[4], o[5], o[6], o[7]};
    } else {
        unsigned o[16];
#pragma unroll
        for (int j = 0; j < 8; ++j) { o[2 * j] = pk2(x[j].x, x[j].y); o[2 * j + 1] = pk2(x[j].z, x[j].w); }
        GAS v4u* d = (GAS v4u*)(it.dst + (size_t)n * it.ldb + 64 * kh);
#pragma unroll
        for (int j = 0; j < 4; ++j) d[j] = (v4u){o[4 * j], o[4 * j + 1], o[4 * j + 2], o[4 * j + 3]};
    }
    LDS_WAIT(); asm volatile("" ::: "memory");
}
#define TR_PAIR(itA, hasB, itB, lane, scr) do { f32x4 _va[8], _vb[8]; tr_load(itA, lane, _va); if (hasB) tr_load(itB, lane, _vb); tr_finish(itA, lane, scr, _va); if (hasB) tr_finish(itB, lane, scr, _vb); } while (0)

__device__ __forceinline__ void transpose_item(const float* W, int N, bf16* WT, int ldt, int koff, int row_off, LAS float* scr, int item, int lane) {
    const int nblk = N / 32, kb = item / nblk, nb = item % nblk, k0 = 64 * kb, n0 = 32 * nb;
#pragma unroll 8
    for (int i = 0; i < 32; ++i) { const int kk = 2 * i + (lane >> 5); scr[kk * 33 + (lane & 31)] = W[(size_t)(k0 + kk) * N + n0 + (lane & 31)]; }
    LDS_WAIT(); asm volatile("" ::: "memory");
    const int c = lane & 7;
#pragma unroll
    for (int j = 0; j < 4; ++j) { const int n = (lane >> 3) + 8 * j; const LAS float* s = scr + (8 * c) * 33 + n;
        v4u o; o.x = pk2(s[0 * 33], s[1 * 33]); o.y = pk2(s[2 * 33], s[3 * 33]); o.z = pk2(s[4 * 33], s[5 * 33]); o.w = pk2(s[6 * 33], s[7 * 33]);
        *(GAS v4u*)(WT + (size_t)(row_off + n0 + n) * ldt + koff + k0 + 8 * c) = o; }
    LDS_WAIT(); asm volatile("" ::: "memory");
}

__device__ __forceinline__ void transpose_item_fp8(const float* W, int N, unsigned char* WT, int ldt, LAS float* scr, int kb, int nb, int lane) {
    const int k0 = 64 * kb, n0 = 32 * nb;
#pragma unroll 8
    for (int i = 0; i < 32; ++i) { const int kk = 2 * i + (lane >> 5); scr[kk * 33 + (lane & 31)] = W[(size_t)(k0 + kk) * N + n0 + (lane & 31)]; }
    LDS_WAIT(); asm volatile("" ::: "memory");
    const int n = lane >> 1, kh = lane & 1; const LAS float* s = scr + (32 * kh) * 33 + n;
    unsigned o[8];
#pragma unroll
    for (int q = 0; q < 8; ++q) o[q] = pk4_fp8(s[(4 * q) * 33] * W8_SCALE, s[(4 * q + 1) * 33] * W8_SCALE, s[(4 * q + 2) * 33] * W8_SCALE, s[(4 * q + 3) * 33] * W8_SCALE);
    GAS v4u* dst = (GAS v4u*)(WT + (size_t)(n0 + n) * ldt + k0 + 32 * kh);
    dst[0] = (v4u){o[0], o[1], o[2], o[3]}; dst[1] = (v4u){o[4], o[5], o[6], o[7]};
    LDS_WAIT(); asm volatile("" ::: "memory");
}

__device__ __forceinline__ void phase_mod(Frame& F, const Args& a) {
    const float* c = a.in[IN_C]; const float* W = a.in[IN_ADAW]; const float* bia = a.in[IN_ADAB];
    PHASE_IDS();
    LAS float* cact = (LAS float*)F.lds;
    for (int i = tid; i < 4 * D; i += NTHREADS) { const float v = c[i]; cact[i] = v * fsigmoid(v); }
    __syncthreads();
    float* mod = (float*)(F.ctl + CW_MOD);
    LAS float* RED = (LAS float*)(F.lds + 32768);
    for (int cg = blockIdx.x; cg < 256; cg += F.G) {
        const int cq = tid % 12, dg = tid / 12, n = cg * 48 + cq * 4;
        if (dg < 42) {
            f32x4 acc[4];
#pragma unroll
            for (int b = 0; b < 4; ++b) acc[b] = (f32x4){0.f, 0.f, 0.f, 0.f};
            for (int d = dg; d < D; d += 42) {
                const f32x4 w = *(const GAS f32x4*)(W + (size_t)d * 12288 + n);
#pragma unroll
                for (int b = 0; b < 4; ++b) { const float cv = cact[b * D + d]; acc[b] += w * cv; }
            }
#pragma unroll
            for (int b = 0; b < 4; ++b) *(LAS f32x4*)(RED + (dg * 4 + b) * 48 + cq * 4) = acc[b];
        }
        __syncthreads();
        if (tid < 192) {
            const int b = tid / 48, cc = tid % 48;
            float s = bia[cg * 48 + cc];
            for (int g2 = 0; g2 < 42; ++g2) s += RED[(g2 * 4 + b) * 48 + cc];
            mod[b * 12288 + cg * 48 + cc] = s;
        }
        __syncthreads();
    }
    if (blockIdx.x == 0) {
        const float* lbl = a.in[IN_LBL];
        for (int k = tid; k < 1024; k += NTHREADS) { const float l0 = lbl[k], l1 = lbl[1024 + k]; const float m = fmaxf(l0, l1); const float e0 = __expf(l0 - m), e1 = __expf(l1 - m); F.vec[VW_LB + k] = e0 / (e0 + e1); }
        if (tid < 64) {
            const int l = tid;
            float s1 = a.in[IN_LQ1][l] * a.in[IN_LK1][l], s2 = a.in[IN_LQ2][l] * a.in[IN_LK2][l];
            s1 = wave_sum(s1); s2 = wave_sum(s2);
            float qg = fabsf(a.in[IN_QNG][l]), kg = fabsf(a.in[IN_KNG][l]);
#pragma unroll
            for (int o = 1; o < 64; o <<= 1) { qg = fmaxf(qg, __shfl_xor(qg, o)); kg = fmaxf(kg, __shfl_xor(kg, o)); }
            float mb = -1e30f;
            for (int i = l; i < 256; i += 64) mb = fmaxf(mb, a.in[IN_RELB][i]);
#pragma unroll
            for (int o = 1; o < 64; o <<= 1) mb = fmaxf(mb, __shfl_xor(mb, o));
            if (l == 0) { F.vec[VW_LAM] = __expf(s1) - __expf(s2) + LAMBDA_INIT; F.vec[VW_M2] = (8.0f * qg * kg * 1.01f + fmaxf(mb, 0.f)) * LOG2E; }
        }
        for (int i = tid; i < 8 * 256; i += NTHREADS) {
            const int h = i >> 8, dist = i & 255;
            int bucket;
            if (dist < 16) bucket = dist; else { const double v = log((double)dist / 16.0) / log(8.0) * 16.0; int lg = 16 + (int)v; bucket = lg < 31 ? lg : 31; }
            F.vec[VW_TBL + i] = a.in[IN_RELB][bucket * 8 + h] * LOG2E;
        }
    }
}

__device__ __forceinline__ void norm_mod_row(const float* xrow, const float* g, const float* shift, const float* scale, bf16* orow, unsigned char* orow8, int lane) {
    const GAS f32x4* xr = (const GAS f32x4*)xrow + lane;
    f32x4 v[8]; float s = 0.f;
#pragma unroll
    for (int j = 0; j < 8; ++j) { v[j] = xr[64 * j]; s += (v[j].x * v[j].x + v[j].y * v[j].y) + (v[j].z * v[j].z + v[j].w * v[j].w); }
    const float rstd = 1.f / sqrtf(wave_sum(s) * (1.f / D) + EPS);
    GAS v2u* o8 = (GAS v2u*)orow + lane;
#pragma unroll
    for (int j = 0; j < 8; ++j) {
        const int d = 4 * lane + 256 * j;
        const f32x4 gg = *(const f32x4*)(g + d), sh = *(const f32x4*)(shift + d), sc = *(const f32x4*)(scale + d);
        const f32x4 y = v[j] * rstd * gg * (sc + 1.0f) + sh;
        v2u o; o.x = pk2(y.x, y.y); o.y = pk2(y.z, y.w); o8[64 * j] = o;
        ((GAS unsigned*)orow8)[lane + 64 * j] = pk4_fp8(y.x, y.y, y.z, y.w);
    }
}
__device__ __forceinline__ void phase_prep1(Frame& F, const Args& a) {
    PHASE_IDS();
    LAS float* scr = (LAS float*)(F.lds + wid * 16384);
    const int gw = F.vcu * NWAVES + wid, NGW = F.G * NWAVES;
    constexpr int I_IN = (D / 64) * (INCOLS / 32), I_A = (1024 / 64) * (D / 32), I_O = (D / 64) * (D / 32), I_SG = (D / 64) * (DEXP / 32), I_SD = (DEXP / 64) * (D / 32);
    constexpr int NITEMS = I_IN + 2 * I_A + I_O + 2 * I_SG + I_SD;
    unsigned char* ws = F.ws;
#define PREP_DECODE(IT, idx) do { int r_ = (idx); \
        if (r_ < I_IN) { const int nblk = INCOLS / 32, kb = r_ / nblk, n0 = (r_ % nblk) * 32, k0 = 64 * kb; IT.src = a.in[IN_WIN] + (size_t)k0 * INCOLS + n0; IT.N = INCOLS; \
            if (n0 < 3072)      { IT.fp8 = 0; IT.ldb = D * 2; IT.dst = ws + WS_WIN + ((size_t)n0 * D + k0) * 2; }                         \
            else if (n0 < 4096) { IT.fp8 = 1; IT.ldb = D;     IT.dst = ws + WS_WIN8 + (size_t)(n0 - 3072) * D + k0; }                       \
            else if (n0 < 7168) { IT.fp8 = 0; IT.ldb = D * 2; IT.dst = ws + WS_WIN + ((size_t)(n0 - 1024) * D + k0) * 2; }                  \
            else                { IT.fp8 = 1; IT.ldb = D;     IT.dst = ws + WS_WIN8 + (size_t)(n0 - 7168 + 1024) * D + k0; } }              \
        else { r_ -= I_IN; \
        if (r_ < I_A) { const int kb = r_ / (D / 32), n0 = (r_ % (D / 32)) * 32, k0 = 64 * kb; IT.src = a.in[IN_WA] + (size_t)k0 * D + n0; IT.N = D; IT.fp8 = 0; IT.ldb = D * 2; IT.dst = ws + WS_WA + ((size_t)n0 * D + k0) * 2; } \
        else { r_ -= I_A; \
        if (r_ < I_A) { const int kb = r_ / (D / 32), n0 = (r_ % (D / 32)) * 32, k0 = 64 * kb; IT.src = a.in[IN_WB] + (size_t)k0 * D + n0; IT.N = D; IT.fp8 = 0; IT.ldb = D * 2; IT.dst = ws + WS_WA + ((size_t)n0 * D + 1024 + k0) * 2; } \
        else { r_ -= I_A; \
        if (r_ < I_O) { const int kb = r_ / (D / 32), n0 = (r_ % (D / 32)) * 32, k0 = 64 * kb; IT.src = a.in[IN_WOUT] + (size_t)k0 * D + n0; IT.N = D; IT.fp8 = 0; IT.ldb = D * 2; IT.dst = ws + WS_WOUT + ((size_t)n0 * D + k0) * 2; } \
        else { r_ -= I_O; \
        if (r_ < I_SG) { const int kb = r_ / (DEXP / 32), n0 = (r_ % (DEXP / 32)) * 32, k0 = 64 * kb; IT.src = a.in[IN_SG] + (size_t)k0 * DEXP + n0; IT.N = DEXP; IT.fp8 = 1; IT.ldb = D; IT.dst = ws + WS_WSH + (size_t)n0 * D + k0; } \
        else { r_ -= I_SG; \
        if (r_ < I_SG) { const int kb = r_ / (DEXP / 32), n0 = (r_ % (DEXP / 32)) * 32, k0 = 64 * kb; IT.src = a.in[IN_SU] + (size_t)k0 * DEXP + n0; IT.N = DEXP; IT.fp8 = 1; IT.ldb = D; IT.dst = ws + WS_WSH + 2 * MiB + (size_t)n0 * D + k0; } \
        else { r_ -= I_SG; const int kb = r_ / (D / 32), n0 = (r_ % (D / 32)) * 32, k0 = 64 * kb; IT.src = a.in[IN_SD] + (size_t)k0 * D + n0; IT.N = D; IT.fp8 = 1; IT.ldb = DEXP; IT.dst = ws + WS_WSH + 4 * MiB + (size_t)n0 * DEXP + k0; } } } } } } } while (0)
    for (int it = gw; it < NITEMS; it += 2 * NGW) {
        TrItem A_, B_; const bool hasB = (it + NGW < NITEMS);
        PREP_DECODE(A_, it); if (hasB) PREP_DECODE(B_, it + NGW); else B_ = A_;
        TR_PAIR(A_, hasB, B_, lane, scr);
    }
#undef PREP_DECODE
    { bf16* RH = (bf16*)(ws + WS_RWT_HI); bf16* RL = (bf16*)(ws + WS_RWT_LO); const float* rw = a.in[IN_RW];
      for (int i = (F.vcu * NWAVES + wid) * 64 + lane; i < 64 * D; i += F.G * NTHREADS) { const int e = i & 63, k = i >> 6; const float w = rw[i];
          const unsigned hb = f2bf(w); RH[e * D + k] = (bf16)hb; RL[e * D + k] = (bf16)f2bf(w - bf2f(hb)); } }
}
__device__ __forceinline__ void phase_hrows(Frame& F, const Args& a) {
    PHASE_IDS();
    const int gw = F.vcu * NWAVES + wid, NGW = F.G * NWAVES;
    unsigned char* ws = F.ws;
    const float* mod = (const float*)(F.ctl + CW_MOD);
    for (int m = gw; m < T; m += NGW) { const int b = m / SEQ;
        norm_mod_row(a.in[IN_X] + (size_t)m * D, a.in[IN_N1G], mod + b * 12288, mod + b * 12288 + 2048, (bf16*)(ws + WS_H) + (size_t)m * D, ws + WS_H8 + (size_t)m * D, lane); }
}

struct DenseGemm : pg8::DenseOrder {
    static constexpr bool GATHER = false;
    const char* A; const char* Bt; unsigned lda2, ldb2; int nt;
    __device__ __forceinline__ const char* aptr(const pg8::Unit& u) const { return A + (size_t)(u.pm * 256) * lda2; }
    __device__ __forceinline__ void aoffs(const pg8::Unit&, int, unsigned (&)[2][2]) const {}
    __device__ __forceinline__ void bptrs(const pg8::Unit& u, const char*& b0, const char*& b1) const { b0 = Bt + (size_t)(u.pn * 256) * ldb2; b1 = b0 + (size_t)128 * ldb2; }
};

template <int PART>
struct EpiInProj {
    static constexpr bool PERM = true, MIDK = false;
    unsigned char* ws;
    __device__ __forceinline__ void operator()(const f32x4 (&acc)[2][2][4][2], const pg8::Unit& u, int wr, int wc, int fr, int fq) const {
        bf16* base; int ldc, colt;
        if (PART == 0) { const int idx = u.pn >> 2, slot = idx < 3 ? idx : idx + 1; base = (bf16*)(ws + WS_PROJ + (size_t)slot * 32 * MiB); ldc = 1024; colt = (u.pn & 3) * 256; }
        else if (u.pn < 4) { base = (bf16*)(ws + WS_HG); ldc = 1024; colt = u.pn * 256; }
        else { const int q = u.pn - 4; base = (bf16*)(ws + WS_GA + (size_t)(q >> 3) * 64 * MiB); ldc = 2048; colt = (q & 7) * 256; }
        const int row0 = u.pm * 256 + wr * 64 + fr, col0 = colt + wc * 32 + 8 * fq;
#pragma unroll
        for (int ai = 0; ai < 2; ++ai)
#pragma unroll
            for (int m = 0; m < 4; ++m) { bf16* rowp = base + (size_t)(row0 + ai * 128 + m * 16) * ldc + col0;
#pragma unroll
                for (int bj = 0; bj < 2; ++bj) { const f32x4 v0 = acc[ai][bj][m][0], v1 = acc[ai][bj][m][1];
                    v4u w; w.x = pg8::cvt_pk_bf16(v0[0], v0[1]); w.y = pg8::cvt_pk_bf16(v0[2], v0[3]); w.z = pg8::cvt_pk_bf16(v1[0], v1[1]); w.w = pg8::cvt_pk_bf16(v1[2], v1[3]);
                    *(v4u*)(rowp + bj * 128) = w; } }
    }
};


constexpr int H1_TS = 272, H1_TS2 = 144;
constexpr int H1_QD = 0, H1_KD = 17408, H1_KI = 34816, H1_KBT = 60928, H1_VT = 79360, H1_AT = 97792, H1_TOT = 107008;
__device__ __forceinline__ void phase_h1(Frame& F) {
    unsigned char* ws = F.ws;
    const bf16* HQ = (const bf16*)(ws + WS_HQ); bf16* QT = (bf16*)(ws + WS_QT); const bf16* HF = (const bf16*)(ws + WS_HF); const bf16* HI = (const bf16*)(ws + WS_HI);
    bf16* STg = (bf16*)(ws + WS_ST); float* DEC = (float*)(ws + WS_DEC); float* OI = (float*)(ws + WS_OI);
    LAS unsigned char* L = F.lds;
    LAS float* TOT = (LAS float*)(L + H1_TOT);
    PHASE_IDS();
    const int kp = lane, seg = wid, qd = wid >> 1, r = lane & 15, g = lane >> 4;
    unsigned nq[8], nf[8], ni[8];
#define H1_LOAD(uu_) do { const int bh_ = (uu_) >> 6, n_ = (uu_) & 63; const size_t r0_ = (size_t)(bh_ >> 3) * SEQ + (size_t)n_ * 64 + 8 * seg; const int c_ = (bh_ & 7) * 128 + 2 * kp; \
        _Pragma("unroll") for (int i_ = 0; i_ < 8; ++i_) { const size_t idx_ = (r0_ + i_) * 1024 + c_; nq[i_] = *(const GAS unsigned*)(HQ + idx_); nf[i_] = *(const GAS unsigned*)(HF + idx_); ni[i_] = *(const GAS unsigned*)(HI + idx_); } } while (0)
    if (F.vcu < NCH_UNITS) H1_LOAD(F.vcu);
    for (int u = F.vcu; u < NCH_UNITS; u += F.G) {
        const int bh = u >> 6, n = u & 63, b = bh >> 3, h = bh & 7;
        const size_t row0 = (size_t)b * SEQ + (size_t)n * 64;
        const int col = h * 128 + 2 * kp;
        float cs0[8], cs1[8], kk0[8], kk1[8], qs0[8], qs1[8]; unsigned vv[8];
        const float lb0 = F.vec[VW_LB + col], lb1 = F.vec[VW_LB + col + 1];
        {
            float run0 = 0.f, run1 = 0.f;
#pragma unroll
            for (int uu = 0; uu < 8; ++uu) {
                const float q0 = bflo(nq[uu]), q1 = bfhi(nq[uu]), f0 = bflo(nf[uu]), f1 = bfhi(nf[uu]); vv[uu] = ni[uu];
                const float fg0 = lb0 + (1.f - lb0) * fsigmoid(f0), fg1 = lb1 + (1.f - lb1) * fsigmoid(f1);
                run0 += __logf(fg0); run1 += __logf(fg1); cs0[uu] = run0; cs1[uu] = run1; kk0[uu] = 1.f - fg0; kk1[uu] = 1.f - fg1;
                qs0[uu] = q0 * fsigmoid(q0) * 0.08838834764831845f; qs1[uu] = q1 * fsigmoid(q1) * 0.08838834764831845f;
            }
            *(LAS f32x2*)(TOT + seg * 128 + 2 * kp) = (f32x2){run0, run1};
        }
        __syncthreads();
        {
            float P0[9], P1[9]; P0[0] = 0.f; P1[0] = 0.f;
#pragma unroll
            for (int s = 0; s < 8; ++s) { const f32x2 tt = *(const LAS f32x2*)(TOT + s * 128 + 2 * kp); P0[s + 1] = P0[s] + tt.x; P1[s + 1] = P1[s] + tt.y; }
            float rq0 = 0.f, rq1 = 0.f, rs0 = 0.f, rs1 = 0.f;
#pragma unroll
            for (int s = 1; s < 8; ++s) if (seg == s) { rq0 = P0[s]; rq1 = P1[s]; rs0 = P0[s & ~1]; rs1 = P1[s & ~1]; }
            const float a0 = __expf(rq0 - rs0), a1 = __expf(rq1 - rs1), ai0 = __expf(fminf(rs0 - rq0, 40.f)), ai1 = __expf(fminf(rs1 - rq1, 40.f));
            const float e10 = __expf(P0[2] - rq0), e11 = __expf(P1[2] - rq1), e20 = __expf(P0[4] - rq0), e21 = __expf(P1[4] - rq1), e30 = __expf(P0[6] - rq0), e31 = __expf(P1[6] - rq1);
            const float eb0 = __expf(P0[8] - rq0), eb1 = __expf(P1[8] - rq1), eq0 = __expf(rq0), eq1 = __expf(rq1);
            float kb0[8], kb1[8];
#pragma unroll
            for (int uu = 0; uu < 8; ++uu) {
                const int t = 8 * seg + uu;
                const float qE0 = qs0[uu] * __expf(cs0[uu]), qE1 = qs1[uu] * __expf(cs1[uu]);
                const float kE0 = kk0[uu] * __expf(fminf(-cs0[uu], 40.f)), kE1 = kk1[uu] * __expf(fminf(-cs1[uu], 40.f));
                *(LAS unsigned*)(L + H1_QD + t * H1_TS + 4 * kp) = pg8::cvt_pk_bf16(qE0 * a0, qE1 * a1);
                *(LAS unsigned*)(L + H1_KD + t * H1_TS + 4 * kp) = pg8::cvt_pk_bf16(kE0 * ai0, kE1 * ai1);
                if (qd < 1) *(LAS unsigned*)(L + H1_KI + (0 + t) * H1_TS + 4 * kp) = pg8::cvt_pk_bf16(kE0 * e10, kE1 * e11);
                if (qd < 2) *(LAS unsigned*)(L + H1_KI + (16 + t) * H1_TS + 4 * kp) = pg8::cvt_pk_bf16(kE0 * e20, kE1 * e21);
                if (qd < 3) *(LAS unsigned*)(L + H1_KI + (48 + t) * H1_TS + 4 * kp) = pg8::cvt_pk_bf16(kE0 * e30, kE1 * e31);
                kb0[uu] = kE0 * eb0; kb1[uu] = kE1 * eb1;
                *(GAS unsigned*)(QT + (row0 + t) * 1024 + col) = pg8::cvt_pk_bf16(qE0 * eq0, qE1 * eq1);
            }
            *(LAS v4u*)(L + H1_KBT + (2 * kp) * H1_TS2 + 16 * seg) = (v4u){pg8::cvt_pk_bf16(kb0[0], kb0[1]), pg8::cvt_pk_bf16(kb0[2], kb0[3]), pg8::cvt_pk_bf16(kb0[4], kb0[5]), pg8::cvt_pk_bf16(kb0[6], kb0[7])};
            *(LAS v4u*)(L + H1_KBT + (2 * kp + 1) * H1_TS2 + 16 * seg) = (v4u){pg8::cvt_pk_bf16(kb1[0], kb1[1]), pg8::cvt_pk_bf16(kb1[2], kb1[3]), pg8::cvt_pk_bf16(kb1[4], kb1[5]), pg8::cvt_pk_bf16(kb1[6], kb1[7])};
            *(LAS v4u*)(L + H1_VT + (2 * kp) * H1_TS2 + 16 * seg) = (v4u){(vv[0] & 0xffffu) | (vv[1] << 16), (vv[2] & 0xffffu) | (vv[3] << 16), (vv[4] & 0xffffu) | (vv[5] << 16), (vv[6] & 0xffffu) | (vv[7] << 16)};
            *(LAS v4u*)(L + H1_VT + (2 * kp + 1) * H1_TS2 + 16 * seg) = (v4u){(vv[0] >> 16) | (vv[1] & 0xffff0000u), (vv[2] >> 16) | (vv[3] & 0xffff0000u), (vv[4] >> 16) | (vv[5] & 0xffff0000u), (vv[6] >> 16) | (vv[7] & 0xffff0000u)};
            if (seg == 0) *(GAS f32x2*)(DEC + (size_t)u * 128 + 2 * kp) = (f32x2){__expf(P0[8]), __expf(P1[8])};
        }
        __syncthreads();
        if (u + F.G < NCH_UNITS) H1_LOAD(u + F.G);
        for (int blk = wid; blk < 10; blk += 8) {
            const int i = blk >= 6 ? 3 : (blk >= 3 ? 2 : (blk >= 1 ? 1 : 0)), j = blk - (i * (i + 1)) / 2;
            const int kib = (i == 2) ? 16 : (i == 3 ? 48 : 0);
            const int krow_off = (j == i) ? (H1_KD + (16 * j + r) * H1_TS) : (H1_KI + (kib + 16 * j + r) * H1_TS);
            f32x4 acc = (f32x4){0.f, 0.f, 0.f, 0.f};
#pragma unroll
            for (int ks = 0; ks < 4; ++ks) {
                const bf16x8 af = *(const LAS bf16x8*)(L + H1_QD + (16 * i + r) * H1_TS + (32 * ks + 8 * g) * 2);
                const bf16x8 bfv = *(const LAS bf16x8*)(L + krow_off + (32 * ks + 8 * g) * 2);
                acc = __builtin_amdgcn_mfma_f32_16x16x32_bf16(af, bfv, acc, 0, 0, 0);
            }
#pragma unroll
            for (int rg = 0; rg < 4; ++rg) {
                const int tl = 4 * g + rg; float v = acc[rg];
                if (j == i && r > tl) v = 0.f;
                *(LAS bf16*)(L + H1_AT + (16 * i + tl) * H1_TS2 + (16 * j + r) * 2) = (bf16)f2bf(v);
            }
        }
        if (wid >= 2) {
            const int zb = wid - 2, zi = zb < 3 ? 0 : (zb < 5 ? 1 : 2), zj = zb < 3 ? zb + 1 : (zb < 5 ? zb - 1 : 3);
#pragma unroll
            for (int rg = 0; rg < 4; ++rg) *(LAS bf16*)(L + H1_AT + (16 * zi + 4 * g + rg) * H1_TS2 + (16 * zj + r) * 2) = (bf16)0;
        }
        __syncthreads();
        {
            bf16x8 vf[2];
#pragma unroll
            for (int ks = 0; ks < 2; ++ks) vf[ks] = *(const LAS bf16x8*)(L + H1_VT + (16 * wid + r) * H1_TS2 + (32 * ks + 8 * g) * 2);
#pragma unroll
            for (int rb = 0; rb < 4; ++rb) {
                f32x4 acc = (f32x4){0.f, 0.f, 0.f, 0.f};
#pragma unroll
                for (int ks = 0; ks < 2; ++ks) { const bf16x8 af = *(const LAS bf16x8*)(L + H1_AT + (16 * rb + r) * H1_TS2 + (32 * ks + 8 * g) * 2);
                    acc = __builtin_amdgcn_mfma_f32_16x16x32_bf16(vf[ks], af, acc, 0, 0, 0); }
                *(GAS f32x4*)(OI + (row0 + 16 * rb + r) * 1024 + h * 128 + 16 * wid + 4 * g) = acc;
            }
#pragma unroll
            for (int rb = 0; rb < 8; ++rb) {
                f32x4 acc = (f32x4){0.f, 0.f, 0.f, 0.f};
#pragma unroll
                for (int ks = 0; ks < 2; ++ks) { const bf16x8 af = *(const LAS bf16x8*)(L + H1_KBT + (16 * rb + r) * H1_TS2 + (32 * ks + 8 * g) * 2);
                    acc = __builtin_amdgcn_mfma_f32_16x16x32_bf16(af, vf[ks], acc, 0, 0, 0); }
                v2u o; o.x = pk2(acc[0], acc[1]); o.y = pk2(acc[2], acc[3]);
                *(GAS v2u*)(STg + (size_t)u * 16384 + (16 * wid + r) * 128 + 16 * rb + 4 * g) = o;
            }
        }
        __syncthreads();
    }
#undef H1_LOAD
}

__device__ __forceinline__ void phase_qkprep(Frame& F, const Args& a) {
    PHASE_IDS();
    const int gw = F.vcu * NWAVES + wid, NGW = F.G * NWAVES;
    float gq[16], gk[16];
#pragma unroll
    for (int e = 0; e < 16; ++e) { gq[e] = a.in[IN_QNG][16 * (lane & 3) + e] * (0.125f * LOG2E); gk[e] = a.in[IN_KNG][16 * (lane & 3) + e]; }
    for (int m = gw; m < T; m += NGW) {
#pragma unroll
        for (int which = 0; which < 2; ++which) {
            const bf16* p = (const bf16*)(F.ws + (which ? WS_DK : WS_DQ)) + (size_t)m * 1024 + 16 * lane;
            bf16* po = (bf16*)(F.ws + (which ? WS_DKN : WS_DQN)) + (size_t)m * 1024 + 16 * lane;
            const v4u w0 = *(const GAS v4u*)p, w1 = *(const GAS v4u*)(p + 8);
            float x[16];
            x[0] = bflo(w0.x); x[1] = bfhi(w0.x); x[2] = bflo(w0.y); x[3] = bfhi(w0.y); x[4] = bflo(w0.z); x[5] = bfhi(w0.z); x[6] = bflo(w0.w); x[7] = bfhi(w0.w);
            x[8] = bflo(w1.x); x[9] = bfhi(w1.x); x[10] = bflo(w1.y); x[11] = bfhi(w1.y); x[12] = bflo(w1.z); x[13] = bfhi(w1.z); x[14] = bflo(w1.w); x[15] = bfhi(w1.w);
            float ss = 0.f;
#pragma unroll
            for (int e = 0; e < 16; ++e) ss += x[e] * x[e];
            ss += __shfl_xor(ss, 1); ss += __shfl_xor(ss, 2);
            const float rstd = 1.f / sqrtf(ss * (1.f / 64.f) + EPS);
#pragma unroll
            for (int e = 0; e < 16; ++e) x[e] = x[e] * rstd * (which ? gk[e] : gq[e]);
            v4u o0, o1;
            o0.x = pk2(x[0], x[1]); o0.y = pk2(x[2], x[3]); o0.z = pk2(x[4], x[5]); o0.w = pk2(x[6], x[7]);
            o1.x = pk2(x[8], x[9]); o1.y = pk2(x[10], x[11]); o1.z = pk2(x[12], x[13]); o1.w = pk2(x[14], x[15]);
            *(GAS v4u*)po = o0; *(GAS v4u*)(po + 8) = o1;
        }
    }
}

__device__ __forceinline__ void phase_h2(Frame& F) {
    bf16* STg = (bf16*)(F.ws + WS_ST); const float* DEC = (const float*)(F.ws + WS_DEC);
    const int NIT = 32 * 128 * 32;
    PHASE_IDS();
    for (int it = F.vcu * NTHREADS + tid; it < NIT; it += F.G * NTHREADS) {
        const int bh = it >> 12, v = (it >> 5) & 127, kg = it & 31;
        float run0 = 0.f, run1 = 0.f, run2 = 0.f, run3 = 0.f;
        for (int n0 = 0; n0 < NCHUNK; n0 += 4) {
            v2u loc[4]; f32x4 dc[4];
#pragma unroll
            for (int j = 0; j < 4; ++j) { const size_t un = (size_t)bh * 64 + n0 + j;
                loc[j] = *(const GAS v2u*)(STg + un * 16384 + v * 128 + kg * 4); dc[j] = *(const GAS f32x4*)(DEC + un * 128 + kg * 4); }
#pragma unroll
            for (int j = 0; j < 4; ++j) { const size_t un = (size_t)bh * 64 + n0 + j;
                v2u o; o.x = pk2(run0, run1); o.y = pk2(run2, run3);
                *(GAS v2u*)(STg + un * 16384 + v * 128 + kg * 4) = o;
                run0 = dc[j].x * run0 + bflo(loc[j].x); run1 = dc[j].y * run1 + bfhi(loc[j].x); run2 = dc[j].z * run2 + bflo(loc[j].y); run3 = dc[j].w * run3 + bfhi(loc[j].y); }
        }
    }
}

__device__ __forceinline__ void phase_h3(Frame& F, const Args& a) {
    const bf16* HQ = (const bf16*)(F.ws + WS_QT); const bf16* HG = (const bf16*)(F.ws + WS_HG); const bf16* STg = (const bf16*)(F.ws + WS_ST);
    const float* OI = (const float*)(F.ws + WS_OI); bf16* BR = (bf16*)(F.ws + WS_BR);
    PHASE_IDS();
    const int r = lane & 15, g = lane >> 4, sub = wid >> 2, rb = wid & 3;
    f32x4 gn[8];
#pragma unroll
    for (int cb = 0; cb < 8; ++cb) gn[cb] = *(const GAS f32x4*)(a.in[IN_HGNG] + 16 * cb + 4 * g);
    for (int up = F.vcu; up < NCH_UNITS / 2; up += F.G) {
        const int u = up * 2 + sub, bh = u >> 6, n = u & 63, b = bh >> 3, h = bh & 7;
        const size_t m0 = (size_t)b * SEQ + (size_t)n * 64 + 16 * rb;
        bf16x8 af[4];
#pragma unroll
        for (int ks = 0; ks < 4; ++ks) af[ks] = *(const GAS bf16x8*)(HQ + (m0 + r) * 1024 + h * 128 + 32 * ks + 8 * g);
        f32x4 acc[8];
#pragma unroll
        for (int cb = 0; cb < 8; ++cb) {
            acc[cb] = (f32x4){0.f, 0.f, 0.f, 0.f};
#pragma unroll
            for (int ks = 0; ks < 4; ++ks) { const bf16x8 bfv = *(const GAS bf16x8*)(STg + (size_t)u * 16384 + (16 * cb + r) * 128 + 32 * ks + 8 * g);
                acc[cb] = __builtin_amdgcn_mfma_f32_16x16x32_bf16(bfv, af[ks], acc[cb], 0, 0, 0); }
        }
        float ss = 0.f;
#pragma unroll
        for (int cb = 0; cb < 8; ++cb) {
            const f32x4 o4 = *(const GAS f32x4*)(OI + (m0 + r) * 1024 + h * 128 + 16 * cb + 4 * g);
#pragma unroll
            for (int rg = 0; rg < 4; ++rg) { const float o = acc[cb][rg] + o4[rg]; acc[cb][rg] = o; ss += o * o; }
        }
        ss += __shfl_xor(ss, 16); ss += __shfl_xor(ss, 32);
        const float rstd = 1.f / sqrtf(ss * (1.f / 128.f) + EPS);
#pragma unroll
        for (int cb = 0; cb < 8; ++cb) {
            const v2u hg = *(const GAS v2u*)(HG + (m0 + r) * 1024 + h * 128 + 16 * cb + 4 * g);
            const float g0 = bflo(hg.x), g1 = bfhi(hg.x), g2 = bflo(hg.y), g3 = bfhi(hg.y);
            v2u o;
            o.x = pg8::cvt_pk_bf16(acc[cb][0] * rstd * gn[cb][0] * (g0 * fsigmoid(g0)), acc[cb][1] * rstd * gn[cb][1] * (g1 * fsigmoid(g1)));
            o.y = pg8::cvt_pk_bf16(acc[cb][2] * rstd * gn[cb][2] * (g2 * fsigmoid(g2)), acc[cb][3] * rstd * gn[cb][3] * (g3 * fsigmoid(g3)));
            *(GAS v2u*)(BR + (m0 + r) * 2048 + h * 128 + 16 * cb + 4 * g) = o;
        }
    }
}

__device__ __forceinline__ void phase_convert_experts(Frame& F, const Args& a) {
    PHASE_IDS();
    LAS float* scr = (LAS float*)(F.lds + wid * 16384);
    const int gw = F.vcu * NWAVES + wid, NGW = F.G * NWAVES;
    constexpr int IPM = 256, NITEMS = NEXP * 3 * IPM;
    for (int it = gw; it < NITEMS; it += NGW) {
        const int e = it / (3 * IPM), r = it % (3 * IPM), which = r / IPM, item = r % IPM;
        TrItem A_, B_; A_.fp8 = 1;
        if (which < 2) { const int kb2 = item / (DEXP / 32), n0 = (item % (DEXP / 32)) * 32, k0 = 128 * kb2;
            A_.src = a.in[which ? IN_EU : IN_EG] + (size_t)e * D * DEXP + (size_t)k0 * DEXP + n0; A_.N = DEXP; A_.ldb = D; A_.dst = F.ws + (which ? WS_WU : WS_WG) + (size_t)e * DEXP * D + (size_t)n0 * D + k0; }
        else { const int kb2 = item / (D / 32), n0 = (item % (D / 32)) * 32, k0 = 128 * kb2;
            A_.src = a.in[IN_ED] + (size_t)e * DEXP * D + (size_t)k0 * D + n0; A_.N = D; A_.ldb = DEXP; A_.dst = F.ws + WS_WDOWN + (size_t)e * D * DEXP + (size_t)n0 * DEXP + k0; }
        B_ = A_; B_.src = A_.src + (size_t)64 * A_.N; B_.dst = A_.dst + 64;
        TR_PAIR(A_, true, B_, lane, scr);
    }
}

constexpr int AT_KCH = 1040, AT_VDB = 4160, AT_STAGE = 33280, AT_TBL = 66560, AT_WSF = 67584, AT_QF = 68608;
__device__ __forceinline__ int crow(int r, int hi) { return (r & 3) + 8 * (r >> 2) + 4 * hi; }
__device__ __forceinline__ void phase_attn(Frame& F, const Args& a, const int pi_lo, const int pi_hi) {
    const bf16* DQ = (const bf16*)(F.ws + WS_DQN); const bf16* DK = (const bf16*)(F.ws + WS_DKN); const bf16* DV = (const bf16*)(F.ws + WS_DV);
    bf16* BR = (bf16*)(F.ws + WS_BR);
    LAS unsigned char* L = F.lds;
    LAS float* TBL = (LAS float*)(L + AT_TBL); LAS float* WSF = (LAS float*)(L + AT_WSF); LAS float* XB = (LAS float*)L;
    PHASE_IDS();
    const int c = wid >> 2, qblk = wid & 3, r32 = lane & 31, hi = lane >> 5;
    const float lam = F.vec[VW_LAM], M2 = F.vec[VW_M2];
    const int lrow0 = tid >> 4, lch = tid & 15, lrow1 = lrow0 + 32;
    const int kdst0 = lch * AT_KCH + lrow0 * 16, kdst1 = lch * AT_KCH + lrow1 * 16;
    const int vdst0 = 16640 + (lch >> 2) * AT_VDB + (lrow0 >> 4) * 1024 + (lrow0 & 15) * 64 + (lch & 3) * 16;
    const int vdst1 = 16640 + (lch >> 2) * AT_VDB + (lrow1 >> 4) * 1024 + (lrow1 & 15) * 64 + (lch & 3) * 16;
    const int vlane = 16640 + ((lane >> 4) & 1) * 32 + (lane & 3) * 8 + (4 * hi + ((lane & 15) >> 2)) * 64;
    float dg[4];
#pragma unroll
    for (int d0 = 0; d0 < 4; ++d0) dg[d0] = a.in[IN_DANG][32 * d0 + r32] * (1.0f - LAMBDA_INIT);
    for (int pi = pi_lo; pi < pi_hi; ++pi) {
        if (pi == (F.vcu & 3)) { phase_convert_experts(F, a); __syncthreads(); }
        const int pp = F.vcu * 2 + (pi >> 1);
        if (pp >= 512) break;
        const int bh = pp >> 4, s = pp & 15, qb = (pi & 1) ? 31 - s : s, b = bh >> 3, h = bh & 7;
        const int q0 = qb * 128, NT = 2 * qb + 2;
        const size_t rowb = (size_t)b * SEQ;
        if (tid < 256) TBL[tid] = F.vec[VW_TBL + h * 256 + tid];
        const int qfo = AT_QF + wid * 4096 + lane * 16;
#pragma unroll
        for (int d0 = 0; d0 < 4; ++d0) *(LAS bf16x8*)(L + qfo + d0 * 1024) = *(const GAS bf16x8*)(DQ + (rowb + q0 + 32 * qblk + r32) * 1024 + h * 128 + c * 64 + 16 * d0 + 8 * hi);
        const bf16* ksrc0 = DK + (rowb + lrow0) * 1024 + h * 128 + lch * 8; const bf16* ksrc1 = ksrc0 + (size_t)32 * 1024;
        const bf16* vsrc0 = DV + (rowb + lrow0) * 1024 + h * 128 + lch * 8; const bf16* vsrc1 = vsrc0 + (size_t)32 * 1024;
        v4u kr0, kr1, vr0, vr1;
        kr0 = *(const GAS v4u*)ksrc0; kr1 = *(const GAS v4u*)ksrc1; vr0 = *(const GAS v4u*)vsrc0; vr1 = *(const GAS v4u*)vsrc1;
        *(LAS v4u*)(L + kdst0) = kr0; *(LAS v4u*)(L + kdst1) = kr1; *(LAS v4u*)(L + vdst0) = vr0; *(LAS v4u*)(L + vdst1) = vr1;
        __syncthreads();
        const float tb31 = TBL[255];
        f32x16 o[4];
#pragma unroll
        for (int d0 = 0; d0 < 4; ++d0)
#pragma unroll
            for (int rr = 0; rr < 16; ++rr) o[d0][rr] = 0.f;
        float lsum = 0.f;
        const int qpos = q0 + 32 * qblk + r32;
        for (int j = 0; j < NT; ++j) {
            const int st = (j & 1) * AT_STAGE, sn = ((j + 1) & 1) * AT_STAGE;
            const bool more = (j + 1 < NT);
            if (more) { const size_t go = (size_t)(j + 1) * 64 * 1024;
                kr0 = *(const GAS v4u*)(ksrc0 + go); kr1 = *(const GAS v4u*)(ksrc1 + go); vr0 = *(const GAS v4u*)(vsrc0 + go); vr1 = *(const GAS v4u*)(vsrc1 + go); }
            const bool far = (j < NT - 4);
            const float cinit = far ? (tb31 - M2) : (-M2);
            f32x16 p0, p1;
#pragma unroll
            for (int rr = 0; rr < 16; ++rr) { p0[rr] = cinit; p1[rr] = cinit; }
#pragma unroll
            for (int d0 = 0; d0 < 4; ++d0) {
                const bf16x8 k0 = *(const LAS bf16x8*)(L + st + (8 * c + 2 * d0 + hi) * AT_KCH + r32 * 16);
                const bf16x8 k1 = *(const LAS bf16x8*)(L + st + (8 * c + 2 * d0 + hi) * AT_KCH + r32 * 16 + 512);
                const bf16x8 qf = *(const LAS bf16x8*)(L + qfo + d0 * 1024);
                p0 = __builtin_amdgcn_mfma_f32_32x32x16_bf16(k0, qf, p0, 0, 0, 0);
                p1 = __builtin_amdgcn_mfma_f32_32x32x16_bf16(k1, qf, p1, 0, 0, 0);
            }
            if (!far) {
                float tb0[16], tb1[16];
#pragma unroll
                for (int rr = 0; rr < 16; ++rr) { const int d0v = qpos - (64 * j + crow(rr, hi)), d1v = d0v - 32;
                    tb0[rr] = TBL[d0v < 0 ? 0 : (d0v > 255 ? 255 : d0v)]; tb1[rr] = TBL[d1v < 0 ? 0 : (d1v > 255 ? 255 : d1v)]; }
                asm volatile("s_waitcnt lgkmcnt(0)" ::: "memory");
#pragma unroll
                for (int rr = 0; rr < 16; ++rr) { const int d0v = qpos - (64 * j + crow(rr, hi)), d1v = d0v - 32;
                    p0[rr] = d0v >= 0 ? p0[rr] + tb0[rr] : -INFINITY; p1[rr] = d1v >= 0 ? p1[rr] + tb1[rr] : -INFINITY; }
            }
            float sacc = 0.f;
#pragma unroll
            for (int rr = 0; rr < 16; ++rr) { p0[rr] = __builtin_amdgcn_exp2f(p0[rr]); p1[rr] = __builtin_amdgcn_exp2f(p1[rr]); sacc += p0[rr] + p1[rr]; }
            lsum += sacc;
#define AT_VLD(dst, ks) do { _Pragma("unroll") for (int _d = 0; _d < 4; ++_d) { \
                const s16x4 _lo = __builtin_bit_cast(s16x4, __builtin_amdgcn_ds_read_tr16_b64_v4i16((LAS s16x4*)(L + st + vlane + _d * AT_VDB + (ks) * 1024))); \
                const s16x4 _hh = __builtin_bit_cast(s16x4, __builtin_amdgcn_ds_read_tr16_b64_v4i16((LAS s16x4*)(L + st + vlane + _d * AT_VDB + (ks) * 1024 + 512))); \
                dst[_d] = (bf16x8){_lo[0], _lo[1], _lo[2], _lo[3], _hh[0], _hh[1], _hh[2], _hh[3]}; } } while (0)
#define AT_PV(src, ks) do { v4u _w; if ((ks) < 2) { _w.x = pg8::cvt_pk_bf16(p0[8 * (ks) + 0], p0[8 * (ks) + 1]); _w.y = pg8::cvt_pk_bf16(p0[8 * (ks) + 2], p0[8 * (ks) + 3]); _w.z = pg8::cvt_pk_bf16(p0[8 * (ks) + 4], p0[8 * (ks) + 5]); _w.w = pg8::cvt_pk_bf16(p0[8 * (ks) + 6], p0[8 * (ks) + 7]); } \
                else { _w.x = pg8::cvt_pk_bf16(p1[8 * (ks) - 16], p1[8 * (ks) - 15]); _w.y = pg8::cvt_pk_bf16(p1[8 * (ks) - 14], p1[8 * (ks) - 13]); _w.z = pg8::cvt_pk_bf16(p1[8 * (ks) - 12], p1[8 * (ks) - 11]); _w.w = pg8::cvt_pk_bf16(p1[8 * (ks) - 10], p1[8 * (ks) - 9]); } \
                const bf16x8 _pa = __builtin_bit_cast(bf16x8, _w); \
                _Pragma("unroll") for (int _d = 0; _d < 4; ++_d) o[_d] = __builtin_amdgcn_mfma_f32_32x32x16_bf16(_pa, src[_d], o[_d], 0, 0, 0); } while (0)
            bf16x8 vfa[4], vfb[4];
            AT_VLD(vfa, 0);
            AT_VLD(vfb, 1); AT_PV(vfa, 0);
            AT_VLD(vfa, 2); AT_PV(vfb, 1);
            AT_VLD(vfb, 3); AT_PV(vfa, 2);
            AT_PV(vfb, 3);
#undef AT_VLD
#undef AT_PV
            if (more) { *(LAS v4u*)(L + sn + kdst0) = kr0; *(LAS v4u*)(L + sn + kdst1) = kr1; *(LAS v4u*)(L + sn + vdst0) = vr0; *(LAS v4u*)(L + sn + vdst1) = vr1; }
            __syncthreads();
        }
        lsum += __shfl_xor(lsum, 32);
        if (hi == 0) WSF[wid * 32 + r32] = lsum;
        LDS_WAIT();
        float rli[16];
#pragma unroll
        for (int rr = 0; rr < 16; ++rr) rli[rr] = 1.0f / WSF[wid * 32 + crow(rr, hi)];
        if (c == 1) {
#pragma unroll
            for (int d0 = 0; d0 < 4; ++d0)
#pragma unroll
                for (int rr = 0; rr < 16; ++rr) XB[(qblk * 32 + crow(rr, hi)) * 128 + 32 * d0 + r32] = o[d0][rr] * rli[rr] * lam;
        }
        __syncthreads();
        if (c == 0) {
            float ss[16];
#pragma unroll
            for (int rr = 0; rr < 16; ++rr) ss[rr] = 0.f;
#pragma unroll
            for (int d0 = 0; d0 < 4; ++d0)
#pragma unroll
                for (int rr = 0; rr < 16; ++rr) { const float df = o[d0][rr] * rli[rr] - XB[(qblk * 32 + crow(rr, hi)) * 128 + 32 * d0 + r32]; o[d0][rr] = df; ss[rr] += df * df; }
#pragma unroll
            for (int rr = 0; rr < 16; ++rr) { float s2 = ss[rr]; s2 += __shfl_xor(s2, 1); s2 += __shfl_xor(s2, 2); s2 += __shfl_xor(s2, 4); s2 += __shfl_xor(s2, 8); s2 += __shfl_xor(s2, 16);
                ss[rr] = 1.f / sqrtf(s2 * (1.f / 128.f) + EPS); }
#pragma unroll
            for (int d0 = 0; d0 < 4; ++d0)
#pragma unroll
                for (int rr = 0; rr < 16; ++rr)
                    BR[(rowb + q0 + 32 * qblk + crow(rr, hi)) * 2048 + 1024 + h * 128 + 32 * d0 + r32] = (bf16)f2bf(o[d0][rr] * ss[rr] * dg[d0]);
        }
        __syncthreads();
    }
}

__device__ __forceinline__ void unpack8(const v4u w, float (&x)[8]) { x[0] = bflo(w.x); x[1] = bfhi(w.x); x[2] = bflo(w.y); x[3] = bfhi(w.y); x[4] = bflo(w.z); x[5] = bfhi(w.z); x[6] = bflo(w.w); x[7] = bfhi(w.w); }
struct EpiMergeF {
    static constexpr bool PERM = true, MIDK = true;
    unsigned char* ws;
    __device__ __forceinline__ void mid(f32x4 (&acc)[2][2][4][2], const pg8::Unit& u, int wr, int wc, int fr_, int fq_) const {
        int fr = fr_, fq = fq_; OPAQUE_V(fr); OPAQUE_V(fq);
        const bf16* GAp = (const bf16*)(ws + WS_GA); const bf16* GBp = (const bf16*)(ws + WS_GB);
        const int row0 = u.pm * 256 + wr * 64 + fr, col0 = u.pn * 256 + wc * 32 + 8 * fq;
#pragma unroll
        for (int ai = 0; ai < 2; ++ai)
#pragma unroll
            for (int m = 0; m < 4; ++m)
#pragma unroll
                for (int bj = 0; bj < 2; ++bj) {
                    const size_t off = (size_t)(row0 + ai * 128 + m * 16) * 2048 + col0 + bj * 128;
                    float ga[8], gb[8]; unpack8(*(const GAS v4u*)(GAp + off), ga); unpack8(*(const GAS v4u*)(GBp + off), gb);
#pragma unroll
                    for (int j = 0; j < 4; ++j) {
                        acc[ai][bj][m][0][j] *= (1.0f + __expf(-gb[j])) * __builtin_amdgcn_rcpf(1.0f + __expf(-ga[j]));
                        acc[ai][bj][m][1][j] *= (1.0f + __expf(-gb[4 + j])) * __builtin_amdgcn_rcpf(1.0f + __expf(-ga[4 + j])); }
                }
    }
    __device__ __forceinline__ void operator()(const f32x4 (&acc)[2][2][4][2], const pg8::Unit& u, int wr, int wc, int fr_, int fq_) const {
        int fr = fr_, fq = fq_; OPAQUE_V(fr); OPAQUE_V(fq);
        const bf16* GBp = (const bf16*)(ws + WS_GB); bf16* O = (bf16*)(ws + WS_MERGED);
        const int row0 = u.pm * 256 + wr * 64 + fr, col0 = u.pn * 256 + wc * 32 + 8 * fq;
#pragma unroll
        for (int ai = 0; ai < 2; ++ai)
#pragma unroll
            for (int m = 0; m < 4; ++m)
#pragma unroll
                for (int bj = 0; bj < 2; ++bj) {
                    const size_t off = (size_t)(row0 + ai * 128 + m * 16) * 2048 + col0 + bj * 128;
                    float gb[8], y[8]; unpack8(*(const GAS v4u*)(GBp + off), gb);
                    const f32x4 v0 = acc[ai][bj][m][0], v1 = acc[ai][bj][m][1];
#pragma unroll
                    for (int j = 0; j < 4; ++j) { y[j] = v0[j] * fsigmoid(gb[j]); y[4 + j] = v1[j] * fsigmoid(gb[4 + j]); }
                    v4u w; w.x = pk2(y[0], y[1]); w.y = pk2(y[2], y[3]); w.z = pk2(y[4], y[5]); w.w = pk2(y[6], y[7]);
                    *(GAS v4u*)(O + off) = w;
                }
    }
};
struct EpiOutProj {
    static constexpr bool PERM = true, MIDK = false;
    const float* x; bf16* x1b; const float* mod;
    __device__ __forceinline__ void operator()(const f32x4 (&acc)[2][2][4][2], const pg8::Unit& u, int wr, int wc, int fr_, int fq_) const {
        int fr = fr_, fq = fq_; OPAQUE_V(fr); OPAQUE_V(fq);
        const int row0 = u.pm * 256 + wr * 64 + fr, col0 = u.pn * 256 + wc * 32 + 8 * fq;
        const int b = (u.pm * 256) / SEQ;
#pragma unroll
        for (int ai = 0; ai < 2; ++ai)
#pragma unroll
            for (int m = 0; m < 4; ++m) { const size_t ro = (size_t)(row0 + ai * 128 + m * 16) * D + col0;
#pragma unroll
                for (int bj = 0; bj < 2; ++bj) {
                    const f32x4 x0 = *(const GAS f32x4*)(x + ro + bj * 128), x4 = *(const GAS f32x4*)(x + ro + bj * 128 + 4);
                    const f32x4 g0 = *(const GAS f32x4*)(mod + b * 12288 + 4096 + col0 + bj * 128), g4 = *(const GAS f32x4*)(mod + b * 12288 + 4096 + col0 + bj * 128 + 4);
                    const f32x4 y0 = x0 + g0 * acc[ai][bj][m][0], y1 = x4 + g4 * acc[ai][bj][m][1];
                    v4u w; w.x = pk2(y0[0], y0[1]); w.y = pk2(y0[2], y0[3]); w.z = pk2(y1[0], y1[1]); w.w = pk2(y1[2], y1[3]);
                    *(GAS v4u*)(x1b + ro + bj * 128) = w; } }
    }
};


constexpr int RT_XSLD = 2056;
constexpr int RT_XS = 0, RT_PART = 65792;
constexpr int RT_LCNT = 98560, RT_STOK = 98816, RT_SW = 107008;
constexpr int MOE_TB = MISC_OFF + 1024;
__device__ __forceinline__ void phase_router(Frame& F, const Args& a) {
    PHASE_IDS();
    LAS unsigned char* L = F.lds;
    LAS bf16* XS = (LAS bf16*)(L + RT_XS); LAS float* PART = (LAS float*)(L + RT_PART);
    const bf16* x1 = (const bf16*)(F.ws + WS_X1B); const float* mod = (const float*)(F.ctl + CW_MOD);
    unsigned char* H2 = F.ws + WS_H2;
    int* LTOK = (int*)(F.ws + WS_LTOK); float* LW = (float*)(F.ws + WS_LW);
    const float rbias = a.in[IN_RB][lane];
    if (tid < 64) ((LAS unsigned*)(L + RT_LCNT))[tid] = 0u;
    __syncthreads();
    int rounds = 0, round_row0 = 0;
    for (int grp = F.vcu; grp < T / 16; grp += F.G) {
        if (rounds == 0) round_row0 = grp * 16;
#pragma unroll 1
        for (int rr2 = 0; rr2 < 2; ++rr2) {
            const int rloc = 2 * wid + rr2, m = grp * 16 + rloc, b = m / SEQ;
            const GAS v2u* xr = (const GAS v2u*)(x1 + (size_t)m * D) + lane;
            f32x4 v[8]; float s = 0.f;
#pragma unroll
            for (int j = 0; j < 8; ++j) { const v2u w = xr[64 * j]; v[j] = (f32x4){bflo(w.x), bfhi(w.x), bflo(w.y), bfhi(w.y)}; s += (v[j].x * v[j].x + v[j].y * v[j].y) + (v[j].z * v[j].z + v[j].w * v[j].w); }
            const float rstd = 1.f / sqrtf(wave_sum(s) * (1.f / D) + EPS);
            GAS unsigned* o8 = (GAS unsigned*)(H2 + (size_t)m * D) + lane;
#pragma unroll
            for (int j = 0; j < 8; ++j) {
                const int d = 4 * lane + 256 * j;
                const f32x4 gg = *(const f32x4*)(a.in[IN_N2G] + d), sh = *(const GAS f32x4*)(mod + b * 12288 + 6144 + d), sc = *(const GAS f32x4*)(mod + b * 12288 + 8192 + d);
                const f32x4 y = v[j] * rstd * gg * (sc + 1.0f) + sh;
                o8[64 * j] = pk4_fp8(y.x, y.y, y.z, y.w);
                v2u xb; xb.x = pk2(y.x, y.y); xb.y = pk2(y.z, y.w);
                *(LAS v2u*)(XS + rloc * RT_XSLD + d) = xb;
            }
        }
        __syncthreads();
        {
            const bf16* RH = (const bf16*)(F.ws + WS_RWT_HI);
            const int r = lane & 15, g = lane >> 4;
            f32x4 acc[4];
#pragma unroll
            for (int cb = 0; cb < 4; ++cb) acc[cb] = (f32x4){0.f, 0.f, 0.f, 0.f};
            bf16x8 wh[4], whn[4];
#pragma unroll
            for (int cb = 0; cb < 4; ++cb) wh[cb] = *(const GAS bf16x8*)(RH + (16 * cb + r) * D + 256 * wid + 8 * g);
#pragma unroll 1
            for (int ks = 0; ks < 8; ++ks) {
                const int k0 = 256 * wid + 32 * ks + 8 * g;
                if (ks < 7) {
#pragma unroll
                    for (int cb = 0; cb < 4; ++cb) whn[cb] = *(const GAS bf16x8*)(RH + (16 * cb + r) * D + k0 + 32); }
                const bf16x8 xf = *(const LAS bf16x8*)(XS + r * RT_XSLD + k0);
#pragma unroll
                for (int cb = 0; cb < 4; ++cb) acc[cb] = __builtin_amdgcn_mfma_f32_16x16x32_bf16(xf, wh[cb], acc[cb], 0, 0, 0);
                if (ks < 7) {
#pragma unroll
                    for (int cb = 0; cb < 4; ++cb) wh[cb] = whn[cb]; }
            }
#pragma unroll
            for (int cb = 0; cb < 4; ++cb)
#pragma unroll
                for (int rg = 0; rg < 4; ++rg) PART[(wid * 16 + 4 * g + rg) * 64 + 16 * cb + r] = acc[cb][rg];
        }
        __syncthreads();
#pragma unroll 1
        for (int rr2 = 0; rr2 < 2; ++rr2) {
            const int rloc = 2 * wid + rr2, m = grp * 16 + rloc;
            float logit = 0.f;
#pragma unroll
            for (int w2 = 0; w2 < 8; ++w2) logit += PART[(w2 * 16 + rloc) * 64 + lane];
            const float score = 1.0f / (1.0f + expf(-logit)), sel = score + rbias;
            const int eg = lane >> 3;
            float m1 = sel; m1 = fmaxf(m1, __shfl_xor(m1, 1)); m1 = fmaxf(m1, __shfl_xor(m1, 2)); m1 = fmaxf(m1, __shfl_xor(m1, 4));
            const unsigned long long bm = __ballot(sel == m1);
            const int first = __builtin_ctz((unsigned)((bm >> (8 * eg)) & 0xffull)) + 8 * eg;
            float m2 = (lane == first) ? -INFINITY : sel; m2 = fmaxf(m2, __shfl_xor(m2, 1)); m2 = fmaxf(m2, __shfl_xor(m2, 2)); m2 = fmaxf(m2, __shfl_xor(m2, 4));
            const float gs = m1 + m2;
            int grank = 0;
#pragma unroll
            for (int g2 = 0; g2 < 8; ++g2) { const float o = __shfl(gs, 8 * g2); grank += (o > gs || (o == gs && g2 < eg)) ? 1 : 0; }
            const float masked = grank < 4 ? sel : -INFINITY;
            int rank = 0;
#pragma unroll 8
            for (int e2 = 0; e2 < 64; ++e2) { const float o = __shfl(masked, e2); rank += (o > masked || (o == masked && e2 < lane)) ? 1 : 0; }
            const bool selected = rank < 8;
            const float ssum = wave_sum(selected ? score : 0.f);
            if (selected) {
                const unsigned pos = __hip_atomic_fetch_add((LAS unsigned*)(L + RT_LCNT) + lane, 1u, __ATOMIC_RELAXED, __HIP_MEMORY_SCOPE_WORKGROUP);
                ((LAS unsigned short*)(L + RT_STOK))[lane * 64 + pos] = (unsigned short)((rounds * 16 + rloc) * 8 + rank); ((LAS float*)(L + RT_SW))[lane * 64 + pos] = score / ssum * 2.5f;
            }
        }
        __syncthreads();
        ++rounds;
        if (rounds == 4 || grp + F.G >= T / 16) {
            const int e = tid >> 3, sub = tid & 7;
            const unsigned n = ((LAS unsigned*)(L + RT_LCNT))[e];
            unsigned base = 0u;
            if (sub == 0 && n) base = atomicAdd(F.ctl + CW_CNT + 64 * e, n);
            base = __shfl(base, lane & ~7);
            for (unsigned i = sub; i < n; i += 8) { const int sv = (int)((LAS unsigned short*)(L + RT_STOK))[e * 64 + i]; LTOK[e * 16384 + base + i] = (round_row0 + (sv >> 7) * F.G * 16 + ((sv >> 3) & 15)) * 8 + (sv & 7); LW[e * 16384 + base + i] = ((LAS float*)(L + RT_SW))[e * 64 + i]; }
            __syncthreads();
            if (tid < 64) ((LAS unsigned*)(L + RT_LCNT))[tid] = 0u;
            rounds = 0;
            __syncthreads();
        }
    }
}
__device__ __forceinline__ void moe_build_table(Frame& F) {
    PHASE_IDS();
    LAS int* tb = (LAS int*)(F.lds + MOE_TB); LAS int* cn = tb + 68; LAS int* ab = cn + 68;
    if (tid == 0) {
        int t = 0, r = 0;
        for (int e = 0; e < NEXP; ++e) { const int c = (int)__hip_atomic_load(F.ctl + CW_CNT + 64 * e, RLX_AGENT); tb[e] = t; cn[e] = c; ab[e] = r; t += (c + 255) >> 8; r += c; }
        tb[64] = t; cn[64] = T; ab[64] = r;
    }
    __syncthreads();
}
template <int NP>
struct MoeOrder {
    LAS int* tb; int G, c;
    __device__ bool next(int i, pg8::Unit& u) const {
        const int ntr = tb[64]; const long L = (long)i * G + c;
        if (L >= (long)(64 + ntr) * NP) return false;
        int tt = (int)(L / NP); u.pn = (int)(L % NP);
        if (tt < 64) { u.e = 64; u.pm = tt; u.cnt = 256; return true; }
        tt -= 64;
        int lo = 0, hi = 64;
        while (hi - lo > 1) { const int mid = (lo + hi) >> 1; if (tb[mid] <= tt) lo = mid; else hi = mid; }
        u.e = lo; u.pm = tt - tb[lo]; const int rem = tb[68 + lo] - 256 * u.pm; u.cnt = rem < 256 ? rem : 256; return true;
    }
};
struct MoeGemm1 : MoeOrder<4> {
    static constexpr bool GATHER = true;
    unsigned char* ws; unsigned lda2, ldb2; int nt;
    __device__ __forceinline__ const char* aptr(const pg8::Unit&) const { return (const char*)(ws + WS_H2); }
    __device__ __forceinline__ void aoffs(const pg8::Unit& u, int tid, unsigned (&o)[2][2]) const {
        const int* LTOK = (const int*)(ws + WS_LTOK);
        OPAQUE_V(tid);
        int R0, C0, R1, C1; pg8::stage_rc(tid * 16, R0, C0); pg8::stage_rc(tid * 16 + 8192, R1, C1);
#pragma unroll
        for (int h = 0; h < 2; ++h) {
            const int p0 = h * 128 + R0, p1 = h * 128 + R1; int t0, t1;
            if (u.e == 64) { t0 = u.pm * 256 + p0; t1 = u.pm * 256 + p1; }
            else { t0 = p0 < u.cnt ? (LTOK[u.e * 16384 + u.pm * 256 + p0] >> 3) : 0; t1 = p1 < u.cnt ? (LTOK[u.e * 16384 + u.pm * 256 + p1] >> 3) : 0; }
            o[h][0] = (unsigned)t0 * 2048u + (unsigned)C0 * 2u; o[h][1] = (unsigned)t1 * 2048u + (unsigned)C1 * 2u;
        }
    }
    __device__ __forceinline__ void bptrs(const pg8::Unit& u, const char*& b0, const char*& b1) const {
        const char* g = (u.e == 64) ? (const char*)(ws + WS_WSH) : (const char*)(ws + WS_WG) + (size_t)u.e * DEXP * D;
        const char* up = (u.e == 64) ? (const char*)(ws + WS_WSH + 2 * MiB) : (const char*)(ws + WS_WU) + (size_t)u.e * DEXP * D;
        b0 = g + (size_t)(u.pn * 128) * 2048; b1 = up + (size_t)(u.pn * 128) * 2048;
    }
};
struct EpiSwiglu {
    static constexpr bool PERM = true, MIDK = false;
    unsigned char* ws; LAS int* tb;
    __device__ __forceinline__ void operator()(const f32x4 (&acc)[2][2][4][2], const pg8::Unit& u, int wr, int wc, int fr_, int fq_) const {
        int fr = fr_, fq = fq_; OPAQUE_V(fr); OPAQUE_V(fq);
        unsigned char* ACT = ws + WS_ACT;
        const int rbase = tb[136 + u.e] + u.pm * 256, col0 = u.pn * 128 + wc * 32 + 8 * fq;
#pragma unroll
        for (int ai = 0; ai < 2; ++ai)
#pragma unroll
            for (int m = 0; m < 4; ++m) {
                const int rt = ai * 128 + wr * 64 + m * 16 + fr;
                if (rt < u.cnt) {
                    float y[8];
#pragma unroll
                    for (int n = 0; n < 2; ++n)
#pragma unroll
                        for (int j = 0; j < 4; ++j) { const float gt = acc[ai][0][m][n][j], upv = acc[ai][1][m][n][j]; y[4 * n + j] = fminf(fmaxf(gt * fsigmoid(gt) * upv, -448.f), 448.f); }
                    v2u w; w.x = pk4_fp8(y[0], y[1], y[2], y[3]); w.y = pk4_fp8(y[4], y[5], y[6], y[7]);
                    *(GAS v2u*)(ACT + (size_t)(rbase + rt) * DEXP + col0) = w;
                }
            }
    }
};
struct MoeGemm2 : MoeOrder<8> {
    static constexpr bool GATHER = false;
    unsigned char* ws; unsigned lda2, ldb2; int nt;
    __device__ __forceinline__ const char* aptr(const pg8::Unit& u) const { return (const char*)(ws + WS_ACT) + (size_t)(tb[136 + u.e] + u.pm * 256) * 512; }
    __device__ __forceinline__ void aoffs(const pg8::Unit&, int, unsigned (&)[2][2]) const {}
    __device__ __forceinline__ void bptrs(const pg8::Unit& u, const char*& b0, const char*& b1) const {
        const char* dn = (u.e == 64) ? (const char*)(ws + WS_WSH + 4 * MiB) : (const char*)(ws + WS_WDOWN) + (size_t)u.e * D * DEXP;
        b0 = dn + (size_t)(u.pn * 256) * 512; b1 = b0 + (size_t)128 * 512;
    }
};
struct EpiDown {
    static constexpr bool PERM = true, MIDK = false;
    unsigned char* ws; float* out; const float* mod;
    __device__ __forceinline__ void operator()(const f32x4 (&acc)[2][2][4][2], const pg8::Unit& u, int wr, int wc, int fr_, int fq_) const {
        int fr = fr_, fq = fq_; OPAQUE_V(fr); OPAQUE_V(fq);
        const int* LTOK = (const int*)(ws + WS_LTOK); const float* LW = (const float*)(ws + WS_LW); unsigned char* Y = ws + WS_Y;
        const int col0 = u.pn * 256 + wc * 32 + 8 * fq;
#pragma unroll
        for (int ai = 0; ai < 2; ++ai)
#pragma unroll
            for (int m = 0; m < 4; ++m) {
                const int rt = ai * 128 + wr * 64 + m * 16 + fr;
                if (rt < u.cnt) {
                    if (u.e == 64) {
                        const int t = u.pm * 256 + rt; bf16* YSH = (bf16*)(ws + WS_YSH);
#pragma unroll
                        for (int bj = 0; bj < 2; ++bj) { const f32x4 v0 = acc[ai][bj][m][0], v1 = acc[ai][bj][m][1];
                            v4u pw; pw.x = pk2(v0[0], v0[1]); pw.y = pk2(v0[2], v0[3]); pw.z = pk2(v1[0], v1[1]); pw.w = pk2(v1[2], v1[3]);
                            *(GAS v4u*)(YSH + (size_t)t * D + col0 + bj * 128) = pw; }
                    } else {
                        const int pos = u.e * 16384 + u.pm * 256 + rt; const int tk = LTOK[pos]; const float w = LW[pos] * Y8_SCALE;
#pragma unroll
                        for (int bj = 0; bj < 2; ++bj) { f32x4 v0 = acc[ai][bj][m][0] * w, v1 = acc[ai][bj][m][1] * w;
#pragma unroll
                            for (int j = 0; j < 4; ++j) { v0[j] = fminf(fmaxf(v0[j], -448.f), 448.f); v1[j] = fminf(fmaxf(v1[j], -448.f), 448.f); }
                            v2u pw; pw.x = pk4_fp8(v0[0], v0[1], v0[2], v0[3]); pw.y = pk4_fp8(v1[0], v1[1], v1[2], v1[3]);
                            *(GAS v2u*)(Y + (size_t)tk * D + col0 + bj * 128) = pw; }
                    }
                }
            }
    }
};
__device__ __forceinline__ void phase_combine(Frame& F, const Args& a) {
    PHASE_IDS();
    const unsigned char* Y = F.ws + WS_Y; const float* mod = (const float*)(F.ctl + CW_MOD); float* out = a.out;
    const int NIT = T * (D / 8);
    const bool bad = xb_ld(F.ctl + CW_BAR + XB_TMO) != 0u;
    for (int it = F.vcu * NTHREADS + tid; it < NIT; it += F.G * NTHREADS) {
        const int t = it >> 8, c8 = (it & 255) * 8, b = t / SEQ;
        float s[8];
#pragma unroll
        for (int j = 0; j < 8; ++j) s[j] = 0.f;
#pragma unroll
        for (int k = 0; k < 8; ++k) { const v2u w = *(const GAS v2u*)(Y + ((size_t)t * 8 + k) * D + c8);
            const auto f0 = __builtin_amdgcn_cvt_pk_f32_fp8((int)w.x, false), f1 = __builtin_amdgcn_cvt_pk_f32_fp8((int)w.x, true), f2 = __builtin_amdgcn_cvt_pk_f32_fp8((int)w.y, false), f3 = __builtin_amdgcn_cvt_pk_f32_fp8((int)w.y, true);
            s[0] += f0[0]; s[1] += f0[1]; s[2] += f1[0]; s[3] += f1[1]; s[4] += f2[0]; s[5] += f2[1]; s[6] += f3[0]; s[7] += f3[1]; }
#pragma unroll
        for (int j = 0; j < 8; ++j) s[j] *= (1.0f / Y8_SCALE);
        const f32x4 g0 = *(const GAS f32x4*)(mod + b * 12288 + 10240 + c8), g1 = *(const GAS f32x4*)(mod + b * 12288 + 10240 + c8 + 4);
        GAS f32x4* o = (GAS f32x4*)(out + (size_t)t * D + c8);
        float xv[8], sh[8]; unpack8(*(const GAS v4u*)((const bf16*)(F.ws + WS_X1B) + (size_t)t * D + c8), xv); unpack8(*(const GAS v4u*)((const bf16*)(F.ws + WS_YSH) + (size_t)t * D + c8), sh);
#pragma unroll
        for (int j = 0; j < 8; ++j) s[j] += sh[j];
        const f32x4 o0 = (f32x4){xv[0], xv[1], xv[2], xv[3]}, o1 = (f32x4){xv[4], xv[5], xv[6], xv[7]};
        f32x4 r0 = o0 + g0 * (f32x4){s[0], s[1], s[2], s[3]}; const f32x4 r1 = o1 + g1 * (f32x4){s[4], s[5], s[6], s[7]};
        if (bad) r0.x = __builtin_nanf("");
        o[0] = r0; o[1] = r1;
    }
}

__global__ void __launch_bounds__(NTHREADS, 2) fwd_kernel(Args args) {
    extern __shared__ __attribute__((aligned(16))) unsigned char lds[];
    Frame F;
    F.lds = (LAS unsigned char*)lds;
    F.MISC = (volatile LAS unsigned*)(F.lds + MISC_OFF);
    F.tid = threadIdx.x; F.lane = F.tid & 63; F.wave = __builtin_amdgcn_readfirstlane(F.tid >> 6);
    F.G = gridDim.x; { const int bx = blockIdx.x; F.vcu = (F.G % 8 == 0) ? (bx % 8) * (F.G / 8) + bx / 8 : bx; }
    F.ws = args.ws; F.ctl = (unsigned*)(args.ws + WS_CTL); F.vec = (float*)(args.ws + WS_VEC);
    for (int u = F.tid; u < 256; u += NTHREADS) ((LAS unsigned*)(F.lds + MISC_OFF))[u] = 0u;
    __syncthreads();
    XcdBarrier bar = xcd_barrier_post(F.ctl + CW_BAR, F.MISC + 8);
    unsigned char* ws = args.ws;

#define PH_MOD()   do { phase_mod(F, args); } while (0)
#define PH_PREP1() do { phase_prep1(F, args); } while (0)
#define PH_HROWS() do { phase_hrows(F, args); } while (0)
#define PH_INPROJ() do { { DenseGemm g; g.init(T, 6144, F.G, (int)blockIdx.x); g.A = (const char*)(ws + WS_H); g.Bt = (const char*)(ws + WS_WIN); g.lda2 = D * 2; g.ldb2 = D * 2; g.nt = D / 64; \
          EpiInProj<0> E{ws}; pg8::gemm_phase<DenseGemm, EpiInProj<0>>(F.lds, g, E); } \
        { DenseGemm g; g.init(T, 5120, F.G, (int)blockIdx.x); g.A = (const char*)(ws + WS_H8); g.Bt = (const char*)(ws + WS_WIN8); g.lda2 = D; g.ldb2 = D; g.nt = D / 128; \
          EpiInProj<1> E{ws}; pg8::gemm_phase<DenseGemm, EpiInProj<1>, true>(F.lds, g, E); } } while (0)
#define PH_H1()    do { phase_h1(F); } while (0)
#define PH_QKP()   do { phase_qkprep(F, args); } while (0)
#define PH_H2()    do { phase_h2(F); } while (0)
#define PH_H3()    do { phase_h3(F, args); } while (0)
#define PH_ATTN()  do { phase_attn(F, args, 0, 4); } while (0)
#define PH_MERGE() do { DenseGemm g; g.init(T, D, F.G, (int)blockIdx.x); g.A = (const char*)(ws + WS_BR); g.Bt = (const char*)(ws + WS_WA); g.lda2 = D * 2; g.ldb2 = D * 2; g.nt = D / 64; \
        EpiMergeF E{ws}; pg8::gemm_phase<DenseGemm, EpiMergeF>(F.lds, g, E); } while (0)
#define PH_OUTPROJ() do { DenseGemm g; g.init(T, D, F.G, (int)blockIdx.x); g.A = (const char*)(ws + WS_MERGED); g.Bt = (const char*)(ws + WS_WOUT); g.lda2 = D * 2; g.ldb2 = D * 2; g.nt = D / 64; \
        EpiOutProj E{args.in[IN_X], (bf16*)(ws + WS_X1B), (const float*)(F.ctl + CW_MOD)}; pg8::gemm_phase<DenseGemm, EpiOutProj>(F.lds, g, E); } while (0)
#define PH_ROUTER() do { phase_router(F, args); } while (0)
#define PH_CONVX()  do { phase_convert_experts(F, args); } while (0)
#define PH_MOE1()  do { MoeGemm1 g; g.tb = (LAS int*)(F.lds + MOE_TB); g.G = F.G; g.c = F.vcu; g.ws = ws; g.lda2 = D; g.ldb2 = D; g.nt = D / 128; \
        EpiSwiglu E{ws, (LAS int*)(F.lds + MOE_TB)}; pg8::gemm_phase<MoeGemm1, EpiSwiglu, true>(F.lds, g, E); } while (0)
#define PH_MOE2()  do { MoeGemm2 g; g.tb = (LAS int*)(F.lds + MOE_TB); g.G = F.G; g.c = F.vcu; g.ws = ws; g.lda2 = DEXP; g.ldb2 = DEXP; g.nt = DEXP / 128; \
        EpiDown E{ws, args.out, (const float*)(F.ctl + CW_MOD)}; pg8::gemm_phase<MoeGemm2, EpiDown, true>(F.lds, g, E); } while (0)
#define PH_COMBINE() do { phase_combine(F, args); } while (0)
#ifndef REPEAT_PHASE
#define REPEAT_PHASE -1
#endif
#define RUN(k, X) do { X; if (REPEAT_PHASE == (k)) { xcd_barrier(bar); X; } } while (0)
    if (F.vcu & 1) { PH_PREP1(); __syncthreads(); PH_MOD(); } else { PH_MOD(); __syncthreads(); PH_PREP1(); }
    xcd_barrier(bar);
    RUN(1, PH_HROWS());    xcd_barrier(bar);
    RUN(2, PH_INPROJ());   xcd_barrier(bar);
    if (F.vcu & 1) { PH_QKP(); PH_H1(); } else { PH_H1(); PH_QKP(); }
    xcd_barrier(bar);
    PH_H2();
    xcd_barrier(bar);
    PH_H3(); phase_attn(F, args, 0, 4);
    xcd_barrier(bar);
    RUN(8, PH_MERGE());    xcd_barrier(bar);
    RUN(9, PH_OUTPROJ());  xcd_barrier(bar);
    PH_ROUTER();           xcd_barrier(bar);
    moe_build_table(F);
    RUN(11, PH_MOE1());    xcd_barrier(bar);
    PH_MOE2();             xcd_barrier(bar);
    PH_COMBINE();
}

extern "C" void kernel_launch(void* const* d_in, const int* in_sizes, int n_in, void* d_out, int out_size, void* d_ws, size_t ws_size, hipStream_t stream) {
    static int grid = 0;
    if (grid == 0) {
        int dev = 0, cus = 0;
        if (n_in != 28 || ws_size < WS_NEED || out_size != T * D) { fprintf(stderr, "kernel_launch: unexpected n_in %d / ws %zu / out %d\n", n_in, ws_size, out_size); grid = -1; return; }
        if (hipGetDevice(&dev) != hipSuccess || hipDeviceGetAttribute(&cus, hipDeviceAttributeMultiprocessorCount, dev) != hipSuccess) { grid = -1; return; }
        if (hipFuncSetAttribute((const void*)fwd_kernel, hipFuncAttributeMaxDynamicSharedMemorySize, LDS_BYTES) != hipSuccess) { grid = -1; return; }
        int per_cu = 0;
        (void)hipOccupancyMaxActiveBlocksPerMultiprocessor(&per_cu, (const void*)fwd_kernel, NTHREADS, LDS_BYTES);
        (void)hipGetLastError();
        grid = cus;
        if (cus != 256) { fprintf(stderr, "kernel_launch: built for a 256-CU MI355X (static work split), found %d CUs; nothing launched\n", cus); grid = -1; return; }
    }
    if (grid < 0) return;
    if (hipMemsetAsync((char*)d_ws + WS_CTL, 0, CTL_ZERO_BYTES, stream) != hipSuccess) return;
    Args a{};
    for (int i = 0; i < 28; ++i) a.in[i] = (const float*)d_in[i];
    a.out = (float*)d_out; a.ws = (unsigned char*)d_ws; a.ph_lo = 0; a.ph_hi = 100;
    hipLaunchKernelGGL(fwd_kernel, dim3(grid), dim3(NTHREADS), LDS_BYTES, stream, a);
}
```

```cpp
#include <hip/hip_runtime.h>
#include <cstdio>
#include <cstdint>

#define GAS __attribute__((address_space(1)))
#define LAS __attribute__((address_space(3)))
typedef unsigned short bf16;
typedef unsigned v4u __attribute__((ext_vector_type(4)));
typedef unsigned v2u __attribute__((ext_vector_type(2)));
typedef float f32x4 __attribute__((ext_vector_type(4)));
typedef float f32x2 __attribute__((ext_vector_type(2)));
typedef float f32x16 __attribute__((ext_vector_type(16)));
typedef short bf16x8 __attribute__((ext_vector_type(8)));
typedef short s16x4 __attribute__((ext_vector_type(4)));
typedef int i32x4 __attribute__((ext_vector_type(4)));
typedef int i32x8 __attribute__((ext_vector_type(8)));

#ifndef STAGE_MAX
#define STAGE_MAX 99
#endif

constexpr int D = 2048, BATCH = 4, SEQ = 4096, T = BATCH * SEQ;
constexpr int HGH = 8, HGD = 128, CHUNK = 64, NCHUNK = SEQ / CHUNK;
constexpr int NCH_UNITS = BATCH * HGH * NCHUNK;
constexpr int DAH = 8, DADH = 64, DADV = 128;
constexpr int INCOLS = 11264;
constexpr int NEXP = 64, TOPK = 8, DEXP = 512;
constexpr float EPS = 1e-6f;
constexpr float LOG2E = 1.4426950408889634f;
constexpr float LAMBDA_INIT = 0.2f;
constexpr int NWAVES = 8, NTHREADS = NWAVES * 64;
constexpr int LDS_BYTES = 147456;
constexpr int MISC_OFF = 131072;

constexpr size_t MiB = 1u << 20;
constexpr size_t WS_CTL = 0, CTL_ZERO_BYTES = 1 * MiB;
constexpr size_t WS_VEC = 1 * MiB;
constexpr size_t WS_LTOK = 2 * MiB, WS_LW = 6 * MiB;
constexpr size_t WS_WSH = 10 * MiB;
constexpr size_t WS_WIN = 16 * MiB;
constexpr size_t WS_WIN8 = 40 * MiB;
constexpr size_t WS_H8 = 848 * MiB;
constexpr size_t WS_WA = 60 * MiB, WS_WB = 64 * MiB;
constexpr size_t WS_WOUT = 68 * MiB;
constexpr size_t WS_H = 76 * MiB;
constexpr size_t WS_PROJ = 140 * MiB;
constexpr size_t WS_HQ = WS_PROJ, WS_HF = WS_PROJ + 32 * MiB, WS_HI = WS_PROJ + 64 * MiB, WS_HG = WS_PROJ + 96 * MiB;
constexpr size_t WS_DQ = WS_PROJ + 128 * MiB, WS_DK = WS_PROJ + 160 * MiB, WS_DV = WS_PROJ + 192 * MiB;
constexpr size_t WS_GA = WS_PROJ + 224 * MiB, WS_GB = WS_PROJ + 288 * MiB;
constexpr size_t WS_ST = 492 * MiB;
constexpr size_t WS_DEC = 556 * MiB;
constexpr size_t WS_OI = 560 * MiB;
constexpr size_t WS_BR = 624 * MiB;
constexpr size_t WS_MERGED = 688 * MiB;
constexpr size_t WS_QT = 752 * MiB;
constexpr size_t WS_DQN = 784 * MiB, WS_DKN = 816 * MiB;
constexpr size_t WS_WDOWN = 882 * MiB;
constexpr size_t WS_ACT = 144 * MiB;
constexpr size_t WS_WG = 946 * MiB, WS_WU = 1010 * MiB;
constexpr size_t WS_H2 = 546 * MiB;
constexpr size_t WS_Y = 290 * MiB;
constexpr float Y8_SCALE = 32.0f;
constexpr size_t WS_X1B = WS_H;
constexpr size_t WS_YSH = WS_BR;
constexpr size_t WS_NEED = 1074 * MiB;

constexpr int CW_BAR = 4096;
constexpr int CW_CNT = 8192;
constexpr int CW_MOD = 16384;
constexpr int VW_LB = 0;
constexpr int VW_LAM = 1024, VW_M2 = 1025;
constexpr int VW_TBL = 2048;
constexpr size_t WS_RWT_HI = WS_VEC + 65536, WS_RWT_LO = WS_VEC + 65536 + 262144;

#define RLX_AGENT __ATOMIC_RELAXED, __HIP_MEMORY_SCOPE_AGENT
#define LDS_WAIT() asm volatile("s_waitcnt lgkmcnt(0)" ::: "memory")
#define VM_WAIT() asm volatile("s_waitcnt vmcnt(0)" ::: "memory")
__device__ __forceinline__ unsigned f2bf_sw(float f) { unsigned u = __builtin_bit_cast(unsigned, f); return (u + 0x7fffu + ((u >> 16) & 1u)) >> 16; }
typedef __bf16 bf16x2v __attribute__((ext_vector_type(2)));
__device__ __forceinline__ unsigned pk2(float lo, float hi) { const f32x2 v = {lo, hi}; return __builtin_bit_cast(unsigned, __builtin_convertvector(v, bf16x2v)); }
__device__ __forceinline__ unsigned f2bf(float f) { return (unsigned)__builtin_bit_cast(unsigned short, (__bf16)f); }
__device__ __forceinline__ float bf2f(unsigned b) { return __builtin_bit_cast(float, b << 16); }
__device__ __forceinline__ float bflo(unsigned w) { return __builtin_bit_cast(float, w << 16); }
__device__ __forceinline__ float bfhi(unsigned w) { return __builtin_bit_cast(float, w & 0xffff0000u); }
__device__ __forceinline__ float fsigmoid(float x) { return __builtin_amdgcn_rcpf(1.0f + __expf(-x)); }
__device__ __forceinline__ float wave_sum(float v) {
#pragma unroll
    for (int o = 1; o < 64; o <<= 1) v += __shfl_xor(v, o);
    return v;
}

#define XB_TMO      128
#define XB_XCNT(j)  (256  + 64 * (j))
#define XB_XSUB(j)  (1280 + 64 * (j))
#define XB_XGEN(j)  (2304 + 64 * (j))
#define XB_TOP      3328
#define XB_TOPGEN   3392
#define XCD_BAR_WORDS 3456
#define XB_SPIN_CAP (1u << 18)
__device__ __forceinline__ unsigned xb_ld(unsigned* p)              { return __hip_atomic_load(p, __ATOMIC_RELAXED, __HIP_MEMORY_SCOPE_AGENT); }
__device__ __forceinline__ unsigned xb_add(unsigned* p, unsigned v) { return __hip_atomic_fetch_add(p, v, __ATOMIC_RELAXED, __HIP_MEMORY_SCOPE_AGENT); }
__device__ __forceinline__ unsigned xb_xcc_id() { return (unsigned)__builtin_amdgcn_s_getreg((3 << 11) | 20) & 0xFu; }
#define XB_SPIN(cond, bar) do { unsigned _sp = 0; while (cond) { __builtin_amdgcn_s_sleep(1); \
    if ((++_sp & 255u) == 0u) { if (xb_ld(&(bar)[XB_TMO])) break; if (_sp > XB_SPIN_CAP) { atomicAdd(&(bar)[XB_TMO], 1u); break; } } } } while (0)
struct XcdBarrier { unsigned* bar; unsigned x; volatile LAS unsigned* st; };
__device__ __forceinline__ XcdBarrier xcd_barrier_post(unsigned* bar, volatile LAS unsigned* st) {
    XcdBarrier b; b.bar = bar; b.x = xb_xcc_id(); b.st = st;
    if (threadIdx.x == 0) (void)xb_add(&bar[XB_XCNT(b.x)], 1u);
    return b;
}
__device__ __forceinline__ void xcd_barrier_complete(unsigned* bar, unsigned x, unsigned& nloc, unsigned& nx) {
    const unsigned G = gridDim.x * gridDim.y * gridDim.z;
    unsigned sum, cnt, mine, sp = 0u;
    for (;;) {
        sum = 0u; cnt = 0u; mine = 0u;
#pragma unroll
        for (unsigned j = 0; j < 16; ++j) { const unsigned c = xb_ld(&bar[XB_XCNT(j)]); sum += c; cnt += (c > 0u) ? 1u : 0u; mine = (j == x) ? c : mine; }
        if (sum == G) break;
        __builtin_amdgcn_s_sleep(1);
        if ((++sp & 255u) == 0u) { if (xb_ld(&bar[XB_TMO])) break; if (sp > XB_SPIN_CAP) { atomicAdd(&bar[XB_TMO], 1u); break; } }
    }
    nloc = mine > 0u ? mine : 1u; nx = cnt > 0u ? cnt : 1u;
}
__device__ __forceinline__ void xcd_barrier(const XcdBarrier& b) {
    asm volatile("s_waitcnt vmcnt(0)" ::: "memory");
    __syncthreads();
    if (threadIdx.x == 0) {
        unsigned* bar = b.bar;
        __builtin_amdgcn_s_waitcnt(0);
        unsigned nloc = b.st[0], nx = b.st[1];
        if (nloc == 0u) { xcd_barrier_complete(bar, b.x, nloc, nx); b.st[0] = nloc; b.st[1] = nx; }
        const unsigned old = xb_add(&bar[XB_XSUB(b.x)], 1u);
        const unsigned gen = old / nloc;
        if (old + 1u == (gen + 1u) * nloc) {
            __builtin_amdgcn_fence(__ATOMIC_RELEASE, "agent");
            asm volatile("s_waitcnt vmcnt(0)" ::: "memory");
            const unsigned og = xb_add(&bar[XB_TOP], 1u);
            const unsigned tg = og / nx;
            if (og + 1u == (tg + 1u) * nx) xb_add(&bar[XB_TOPGEN], 1u);
            else XB_SPIN(xb_ld(&bar[XB_TOPGEN]) == tg, bar);
            __builtin_amdgcn_fence(__ATOMIC_ACQUIRE, "agent");
            xb_add(&bar[XB_XGEN(b.x)], 1u);
            asm volatile("s_waitcnt vmcnt(0)" ::: "memory");
        } else {
            XB_SPIN(xb_ld(&bar[XB_XGEN(b.x)]) == gen, bar);
            __builtin_amdgcn_fence(__ATOMIC_ACQUIRE, "agent");
            asm volatile("s_waitcnt vmcnt(0)" ::: "memory");
        }
    }
    __syncthreads();
}

namespace pg8 {
constexpr int BM = 256, BK = 64, HALF = 128, HTB = HALF * BK * 2, STAGE_BYTES = 8 * HTB, NXCD = 8, WGM = 8;
__host__ __device__ __forceinline__ int lds_byte(int r, int c) { const int st = (r >> 4) * 2 + (c >> 5), rr = r & 15, cc = c & 31, ob = rr * 64 + cc * 2; return st * 1024 + (ob ^ (((ob >> 9) & 1) << 5)); }
__host__ __device__ __forceinline__ void stage_rc(int b, int& R, int& C) { const int st = b / 1024, sb = b % 1024, swz = sb ^ (((sb >> 9) & 1) << 5); R = (st >> 1) * 16 + swz / 64; C = (st & 1) * 32 + (swz % 64) / 2; }
__host__ __device__ __forceinline__ int perm32(int rho) { const int n = rho >> 4, i = rho & 15; return 8 * (i >> 2) + 4 * n + (i & 3); }
__device__ __forceinline__ unsigned cvt_pk_bf16(float lo, float hi) { unsigned r; asm volatile("v_cvt_pk_bf16_f32 %0, %1, %2" : "=v"(r) : "v"(lo), "v"(hi)); return r; }

struct Unit { int pm, pn, e, cnt; };

struct DenseOrder {
    int nM, nN, nwg, G, c;
    __device__ void init(int M, int N, int G_, int c_) { nM = M / BM; nN = N / BM; nwg = nM * nN; G = G_; c = c_; }
    __device__ bool next(int i, Unit& u) const {
        const long L = (long)i * G + c; if (L >= nwg) return false;
        int wgid = (int)L; { const int q = nwg / NXCD, r = nwg % NXCD, xcd = wgid % NXCD, off = wgid / NXCD; wgid = (xcd < r ? xcd * (q + 1) : r * (q + 1) + (xcd - r) * q) + off; }
        const int nig = WGM * nN, gid = wgid / nig, fm = gid * WGM, gsz = (nM - fm) < WGM ? (nM - fm) : WGM;
        u.pm = fm + ((wgid % nig) % gsz); u.pn = (wgid % nig) / gsz; u.e = 0; u.cnt = 256; return true;
    }
};

template <class P, class Epi, bool FP8 = false>
__device__ __forceinline__ void gemm_phase(LAS unsigned char* lds, const P& S, const Epi& E) {
    int tid_ = threadIdx.x; asm volatile("" : "+v"(tid_));
    const int tid = tid_, wid = __builtin_amdgcn_readfirstlane(tid >> 6), lane = tid & 63, wr = wid >> 2, wc = wid & 3, fr = lane & 15, fq = lane >> 4;
    const int nt = S.nt;
    unsigned voffA[2], voffB[2];
    { int R0, C0, R1, C1; stage_rc(tid * 16, R0, C0); stage_rc(tid * 16 + 8192, R1, C1);
      const int Rb0 = Epi::PERM ? ((R0 & ~31) + perm32(R0 & 31)) : R0, Rb1 = Epi::PERM ? ((R1 & ~31) + perm32(R1 & 31)) : R1;
      voffB[0] = (unsigned)Rb0 * S.ldb2 + (unsigned)C0 * 2u; voffB[1] = (unsigned)Rb1 * S.ldb2 + (unsigned)C1 * 2u;
      if constexpr (!P::GATHER) { voffA[0] = (unsigned)R0 * S.lda2 + (unsigned)C0 * 2u; voffA[1] = (unsigned)R1 * S.lda2 + (unsigned)C1 * 2u; } else { voffA[0] = 0u; voffA[1] = 0u; } }
    const unsigned ldsw = (unsigned)wid * 1024u;
    const int aoff = lds_byte(wr * 64 + fr, fq * 8), boff = lds_byte(wc * 32 + fr, fq * 8);
#define PG8_SA(b, h) (((b) * 2 + (h)) * HTB)
#define PG8_SB(b, h) ((4 + (b) * 2 + (h)) * HTB)
#define PG8_STAGE_A(bufoff, aptr, koff, h) do { _Pragma("unroll") for (int _i = 0; _i < 2; ++_i) { \
        const char* _src; if constexpr (P::GATHER) _src = (aptr) + (size_t)ga[h][_i] + (size_t)(koff); else _src = (aptr) + (size_t)(h) * hstepA + (size_t)voffA[_i] + (size_t)(koff); \
        __builtin_amdgcn_global_load_lds((const unsigned*)_src, (LAS unsigned*)(lds + (bufoff) + ldsw + _i * 8192), 16, 0, 0); } } while (0)
#define PG8_STAGE_B(bufoff, bptr) do { _Pragma("unroll") for (int _i = 0; _i < 2; ++_i) \
        __builtin_amdgcn_global_load_lds((const unsigned*)((bptr) + voffB[_i]), (LAS unsigned*)(lds + (bufoff) + ldsw + _i * 8192), 16, 0, 0); } while (0)
#define PG8_LD16(off) (*(const LAS i32x4*)(lds + (off)))
#define PG8_LDA(dst, b, h) do { _Pragma("unroll") for (int m = 0; m < 4; ++m) { \
        if constexpr (FP8) { const i32x4 _l = PG8_LD16(PG8_SA(b, h) + aoff + m * 2048), _h = PG8_LD16(PG8_SA(b, h) + aoff + m * 2048 + 1024); dst[m] = __builtin_shufflevector(_l, _h, 0, 1, 2, 3, 4, 5, 6, 7); } \
        else { dst##16[m][0] = *(const LAS bf16x8*)(lds + PG8_SA(b, h) + aoff + m * 2048); dst##16[m][1] = *(const LAS bf16x8*)(lds + PG8_SA(b, h) + aoff + m * 2048 + 1024); } } } while (0)
#define PG8_LDB(dst, b, h) do { _Pragma("unroll") for (int n = 0; n < 2; ++n) { \
        if constexpr (FP8) { const i32x4 _l = PG8_LD16(PG8_SB(b, h) + boff + n * 2048), _h = PG8_LD16(PG8_SB(b, h) + boff + n * 2048 + 1024); dst[n] = __builtin_shufflevector(_l, _h, 0, 1, 2, 3, 4, 5, 6, 7); } \
        else { dst##16[n][0] = *(const LAS bf16x8*)(lds + PG8_SB(b, h) + boff + n * 2048); dst##16[n][1] = *(const LAS bf16x8*)(lds + PG8_SB(b, h) + boff + n * 2048 + 1024); } } } while (0)
#define PG8_MMA(ai, bj, At, Bt) do { __builtin_amdgcn_s_setprio(1); _Pragma("unroll") for (int m = 0; m < 4; ++m) _Pragma("unroll") for (int n = 0; n < 2; ++n) { \
        if constexpr (FP8) {   \
            asm volatile("v_mfma_scale_f32_16x16x128_f8f6f4 %0, %1, %2, %0, %3, %4 op_sel_hi:[0,0,0]" : "+v"(acc[ai][bj][m][n]) : "v"(Bt[n]), "v"(At[m]), "v"(scw), "v"(scx)); \
        } else { _Pragma("unroll") for (int k = 0; k < 2; ++k) \
            acc[ai][bj][m][n] = __builtin_amdgcn_mfma_f32_16x16x32_bf16(Bt##16[n][k], At##16[m][k], acc[ai][bj][m][n], 0, 0, 0); } } \
        __builtin_amdgcn_s_setprio(0); } while (0)
#define PG8_WAIT_V(n) asm volatile("s_waitcnt vmcnt(" #n ")" ::: "memory")
#define PG8_WAIT_L(n) asm volatile("s_waitcnt lgkmcnt(" #n ")" ::: "memory")
#define PG8_BAR __builtin_amdgcn_s_barrier()
#define PG8_SCHED __builtin_amdgcn_sched_barrier(0)
    Unit cur, nxt; int ui = 0;
    if (!S.next(0, cur)) return;
    f32x4 acc[2][2][4][2];
#pragma unroll
    for (int a = 0; a < 2; ++a)
#pragma unroll
        for (int b = 0; b < 2; ++b)
#pragma unroll
            for (int m = 0; m < 4; ++m)
#pragma unroll
                for (int n = 0; n < 2; ++n) acc[a][b][m][n] = (f32x4){0.f, 0.f, 0.f, 0.f};
    const int scw = 0x7a7a7a7a, scx = 0x7f7f7f7f;
    i32x8 At[4], B0[2], B1[2]; bf16x8 At16[4][2], B016[2][2], B116[2][2];
    unsigned ga[2][2] = {{0u, 0u}, {0u, 0u}};
    const size_t hstepA = P::GATHER ? (size_t)0 : (size_t)128 * S.lda2;
    const char *cA, *nA, *cB0, *cB1, *nB0, *nB1;
    cA = S.aptr(cur); if constexpr (P::GATHER) S.aoffs(cur, tid, ga);
    S.bptrs(cur, cB0, cB1);
    const size_t kstep = (size_t)(BK * 2);
    PG8_STAGE_B(PG8_SB(0, 0), cB0); PG8_STAGE_B(PG8_SB(0, 1), cB1); PG8_STAGE_A(PG8_SA(0, 0), cA, 0, 0); PG8_STAGE_A(PG8_SA(0, 1), cA, 0, 1);
    if (wr == 1) PG8_BAR;
    PG8_WAIT_V(2); PG8_BAR;
    PG8_STAGE_B(PG8_SB(1, 0), cB0 + kstep); PG8_STAGE_A(PG8_SA(1, 0), cA, kstep, 0); PG8_STAGE_B(PG8_SB(1, 1), cB1 + kstep);
    PG8_WAIT_V(6); PG8_BAR;
    for (;;) {
        const bool has_next = S.next(ui + 1, nxt);
        if (has_next) { nA = S.aptr(nxt); S.bptrs(nxt, nB0, nB1); } else { nxt = cur; nA = cA; nB0 = cB0; nB1 = cB1; }
        for (int t = 0; t < nt; t += 2) {
            if constexpr (Epi::MIDK) { if (t == (nt >> 1)) E.mid(acc, cur, wr, wc, fr, fq); }
            const bool last = (t == nt - 2);
            const size_t k1 = (size_t)(t + 1) * kstep;
            const size_t k2 = last ? (size_t)0 : (size_t)(t + 2) * kstep, k3 = k2 + kstep;
            const char* a2 = last ? nA : cA;
            const char* b20 = (last ? nB0 : cB0) + k2; const char* b21 = (last ? nB1 : cB1) + k2;
            const char* b30 = b20 + kstep; const char* b31 = b21 + kstep;
            PG8_LDB(B0, 0, 0); PG8_LDB(B1, 0, 1); PG8_SCHED; PG8_LDA(At, 0, 0); PG8_STAGE_A(PG8_SA(1, 1), cA, k1, 1);
            if constexpr (P::GATHER) { if (last && has_next) S.aoffs(nxt, tid, ga); }
            PG8_WAIT_V(8); PG8_WAIT_L(0); PG8_BAR; PG8_MMA(0, 0, At, B0); PG8_MMA(0, 1, At, B1); PG8_BAR; PG8_SCHED;
            PG8_LDA(At, 0, 1); PG8_STAGE_B(PG8_SB(0, 0), b20); PG8_STAGE_B(PG8_SB(0, 1), b21); PG8_STAGE_A(PG8_SA(0, 0), a2, k2, 0);
            PG8_WAIT_V(8); PG8_WAIT_L(0); PG8_BAR; PG8_MMA(1, 0, At, B0); PG8_MMA(1, 1, At, B1); PG8_BAR; PG8_SCHED;
            PG8_LDB(B0, 1, 0); PG8_LDB(B1, 1, 1); PG8_SCHED; PG8_LDA(At, 1, 0); PG8_STAGE_A(PG8_SA(0, 1), a2, k2, 1);
            PG8_WAIT_V(8); PG8_WAIT_L(0); PG8_BAR; PG8_MMA(0, 0, At, B0); PG8_MMA(0, 1, At, B1); PG8_BAR; PG8_SCHED;
            PG8_LDA(At, 1, 1); PG8_STAGE_B(PG8_SB(1, 0), b30); PG8_STAGE_B(PG8_SB(1, 1), b31); PG8_STAGE_A(PG8_SA(1, 0), a2, k3, 0);
            PG8_WAIT_V(8); PG8_WAIT_L(0); PG8_BAR; PG8_MMA(1, 0, At, B0); PG8_MMA(1, 1, At, B1); PG8_BAR; PG8_SCHED;
        }
        if (wr == 0) PG8_BAR;
        if constexpr (FP8) asm volatile("s_nop 15\n\ts_nop 15" ::: "memory");
        E(acc, cur, wr, wc, fr, fq);
        if (!has_next) break;
#pragma unroll
        for (int a = 0; a < 2; ++a)
#pragma unroll
            for (int b = 0; b < 2; ++b)
#pragma unroll
                for (int m = 0; m < 4; ++m)
#pragma unroll
                    for (int n = 0; n < 2; ++n) acc[a][b][m][n] = (f32x4){0.f, 0.f, 0.f, 0.f};
        cur = nxt; cA = nA; cB0 = nB0; cB1 = nB1; ++ui;
        if (wr == 1) PG8_BAR;
    }
    PG8_WAIT_V(0);
    PG8_BAR;
#undef PG8_SA
#undef PG8_SB
#undef PG8_STAGE_A
#undef PG8_STAGE_B
#undef PG8_LD16
#undef PG8_LDA
#undef PG8_LDB
#undef PG8_MMA
#undef PG8_WAIT_V
#undef PG8_WAIT_L
#undef PG8_BAR
#undef PG8_SCHED
}
}

struct Args { const float* in[28]; float* out; unsigned char* ws; int ph_lo, ph_hi; };
enum { IN_X = 0, IN_C, IN_ADAW, IN_ADAB, IN_N1G, IN_WIN, IN_LBL, IN_HGNG, IN_QNG, IN_KNG, IN_LQ1, IN_LK1, IN_LQ2, IN_LK2, IN_DANG, IN_RELB, IN_WA, IN_WB, IN_WOUT,
       IN_N2G, IN_RW, IN_RB, IN_EG, IN_EU, IN_ED, IN_SG, IN_SU, IN_SD };

struct Frame {
    LAS unsigned char* lds;
    volatile LAS unsigned* MISC;
    unsigned* ctl; float* vec;
    int tid, lane, wave, vcu, G;
    unsigned char* ws;
};


__device__ __forceinline__ unsigned pk4_fp8(float a, float b, float c, float d) { int p = 0; p = __builtin_amdgcn_cvt_pk_fp8_f32(a, b, p, false); p = __builtin_amdgcn_cvt_pk_fp8_f32(c, d, p, true); return (unsigned)p; }
constexpr float W8_SCALE = 32.0f;
#define OPAQUE_V(x) asm volatile("" : "+v"(x))
#define PHASE_IDS() int tid_ = threadIdx.x; asm volatile("" : "+v"(tid_)); const int tid = tid_, lane = tid & 63, wid = __builtin_amdgcn_readfirstlane(tid >> 6); (void)lane; (void)wid
struct TrItem { const float* src; int N; unsigned char* dst; int ldb; int fp8; };
__device__ __forceinline__ void tr_load(const TrItem& it, int lane, f32x4 (&v)[8]) {
#pragma unroll
    for (int i = 0; i < 8; ++i) v[i] = *(const GAS f32x4*)(it.src + (size_t)(8 * i + (lane >> 3)) * it.N + 4 * (lane & 7));
}
__device__ __forceinline__ void tr_finish(const TrItem& it, int lane, LAS float* scr, const f32x4 (&v)[8]) {
    const int q = lane & 7;
#pragma unroll
    for (int i = 0; i < 8; ++i) { const int kk = 8 * i + (lane >> 3);
        scr[(4 * q + 0) * 68 + kk] = v[i].x; scr[(4 * q + 1) * 68 + kk] = v[i].y; scr[(4 * q + 2) * 68 + kk] = v[i].z; scr[(4 * q + 3) * 68 + kk] = v[i].w; }
    LDS_WAIT(); asm volatile("" ::: "memory");
    const int n = lane >> 1, kh = lane & 1; const LAS float* s = scr + n * 68 + 32 * kh;
    f32x4 x[8];
#pragma unroll
    for (int j = 0; j < 8; ++j) x[j] = *(const LAS f32x4*)(s + 4 * j);
    if (it.fp8) {
        unsigned o[8];
#pragma unroll
        for (int j = 0; j < 8; ++j) o[j] = pk4_fp8(x[j].x * W8_SCALE, x[j].y * W8_SCALE, x[j].z * W8_SCALE, x[j].w * W8_SCALE);
        GAS v4u* d = (GAS v4u*)(it.dst + (size_t)n * it.ldb + 32 * kh);
        d[0] = (v4u){o[0], o[1], o[2], o[3]}; d[1] = (v4u){o[4], o[5], o[6], o[7]};
    } else {
        unsigned o[16];
#pragma unroll
        for (int j = 0; j < 8; ++j) { o[2 * j] = pk2(x[j].x, x[j].y); o[2 * j + 1] = pk2(x[j].z, x[j].w); }
        GAS v4u* d = (GAS v4u*)(it.dst + (size_t)n * it.ldb + 64 * kh);
#pragma unroll
        for (int j = 0; j < 4; ++j) d[j] = (v4u){o[4 * j], o[4 * j + 1], o[4 * j + 2], o[4 * j + 3]};
    }
    LDS_WAIT(); asm volatile("" ::: "memory");
}
#define TR_PAIR(itA, hasB, itB, lane, scr) do { f32x4 _va[8], _vb[8]; tr_load(itA, lane, _va); if (hasB) tr_load(itB, lane, _vb); tr_finish(itA, lane, scr, _va); if (hasB) tr_finish(itB, lane, scr, _vb); } while (0)

__device__ __forceinline__ void transpose_item(const float* W, int N, bf16* WT, int ldt, int koff, int row_off, LAS float* scr, int item, int lane) {
    const int nblk = N / 32, kb = item / nblk, nb = item % nblk, k0 = 64 * kb, n0 = 32 * nb;
#pragma unroll 8
    for (int i = 0; i < 32; ++i) { const int kk = 2 * i + (lane >> 5); scr[kk * 33 + (lane & 31)] = W[(size_t)(k0 + kk) * N + n0 + (lane & 31)]; }
    LDS_WAIT(); asm volatile("" ::: "memory");
    const int c = lane & 7;
#pragma unroll
    for (int j = 0; j < 4; ++j) { const int n = (lane >> 3) + 8 * j; const LAS float* s = scr + (8 * c) * 33 + n;
        v4u o; o.x = pk2(s[0 * 33], s[1 * 33]); o.y = pk2(s[2 * 33], s[3 * 33]); o.z = pk2(s[4 * 33], s[5 * 33]); o.w = pk2(s[6 * 33], s[7 * 33]);
        *(GAS v4u*)(WT + (size_t)(row_off + n0 + n) * ldt + koff + k0 + 8 * c) = o; }
    LDS_WAIT(); asm volatile("" ::: "memory");
}

__device__ __forceinline__ void transpose_item_fp8(const float* W, int N, unsigned char* WT, int ldt, LAS float* scr, int kb, int nb, int lane) {
    const int k0 = 64 * kb, n0 = 32 * nb;
#pragma unroll 8
    for (int i = 0; i < 32; ++i) { const int kk = 2 * i + (lane >> 5); scr[kk * 33 + (lane & 31)] = W[(size_t)(k0 + kk) * N + n0 + (lane & 31)]; }
    LDS_WAIT(); asm volatile("" ::: "memory");
    const int n = lane >> 1, kh = lane & 1; const LAS float* s = scr + (32 * kh) * 33 + n;
    unsigned o[8];
#pragma unroll
    for (int q = 0; q < 8; ++q) o[q] = pk4_fp8(s[(4 * q) * 33] * W8_SCALE, s[(4 * q + 1) * 33] * W8_SCALE, s[(4 * q + 2) * 33] * W8_SCALE, s[(4 * q + 3) * 33] * W8_SCALE);
    GAS v4u* dst = (GAS v4u*)(WT + (size_t)(n0 + n) * ldt + k0 + 32 * kh);
    dst[0] = (v4u){o[0], o[1], o[2], o[3]}; dst[1] = (v4u){o[4], o[5], o[6], o[7]};
    LDS_WAIT(); asm volatile("" ::: "memory");
}

__device__ __forceinline__ void phase_mod(Frame& F, const Args& a) {
    const float* c = a.in[IN_C]; const float* W = a.in[IN_ADAW]; const float* bia = a.in[IN_ADAB];
    PHASE_IDS();
    LAS float* cact = (LAS float*)F.lds;
    for (int i = tid; i < 4 * D; i += NTHREADS) { const float v = c[i]; cact[i] = v * fsigmoid(v); }
    __syncthreads();
    float* mod = (float*)(F.ctl + CW_MOD);
    LAS float* RED = (LAS float*)(F.lds + 32768);
    for (int cg = blockIdx.x; cg < 256; cg += F.G) {
        const int cq = tid % 12, dg = tid / 12, n = cg * 48 + cq * 4;
        if (dg < 42) {
            f32x4 acc[4];
#pragma unroll
            for (int b = 0; b < 4; ++b) acc[b] = (f32x4){0.f, 0.f, 0.f, 0.f};
            for (int d = dg; d < D; d += 42) {
                const f32x4 w = *(const GAS f32x4*)(W + (size_t)d * 12288 + n);
#pragma unroll
                for (int b = 0; b < 4; ++b) { const float cv = cact[b * D + d]; acc[b] += w * cv; }
            }
#pragma unroll
            for (int b = 0; b < 4; ++b) *(LAS f32x4*)(RED + (dg * 4 + b) * 48 + cq * 4) = acc[b];
        }
        __syncthreads();
        if (tid < 192) {
            const int b = tid / 48, cc = tid % 48;
            float s = bia[cg * 48 + cc];
            for (int g2 = 0; g2 < 42; ++g2) s += RED[(g2 * 4 + b) * 48 + cc];
            mod[b * 12288 + cg * 48 + cc] = s;
        }
        __syncthreads();
    }
    if (blockIdx.x == 0) {
        const float* lbl = a.in[IN_LBL];
        for (int k = tid; k < 1024; k += NTHREADS) { const float l0 = lbl[k], l1 = lbl[1024 + k]; const float m = fmaxf(l0, l1); const float e0 = __expf(l0 - m), e1 = __expf(l1 - m); F.vec[VW_LB + k] = e0 / (e0 + e1); }
        if (tid < 64) {
            const int l = tid;
            float s1 = a.in[IN_LQ1][l] * a.in[IN_LK1][l], s2 = a.in[IN_LQ2][l] * a.in[IN_LK2][l];
            s1 = wave_sum(s1); s2 = wave_sum(s2);
            float qg = fabsf(a.in[IN_QNG][l]), kg = fabsf(a.in[IN_KNG][l]);
#pragma unroll
            for (int o = 1; o < 64; o <<= 1) { qg = fmaxf(qg, __shfl_xor(qg, o)); kg = fmaxf(kg, __shfl_xor(kg, o)); }
            float mb = -1e30f;
            for (int i = l; i < 256; i += 64) mb = fmaxf(mb, a.in[IN_RELB][i]);
#pragma unroll
            for (int o = 1; o < 64; o <<= 1) mb = fmaxf(mb, __shfl_xor(mb, o));
            if (l == 0) { F.vec[VW_LAM] = __expf(s1) - __expf(s2) + LAMBDA_INIT; F.vec[VW_M2] = (8.0f * qg * kg * 1.01f + fmaxf(mb, 0.f)) * LOG2E; }
        }
        for (int i = tid; i < 8 * 256; i += NTHREADS) {
            const int h = i >> 8, dist = i & 255;
            int bucket;
            if (dist < 16) bucket = dist; else { const double v = log((double)dist / 16.0) / log(8.0) * 16.0; int lg = 16 + (int)v; bucket = lg < 31 ? lg : 31; }
            F.vec[VW_TBL + i] = a.in[IN_RELB][bucket * 8 + h] * LOG2E;
        }
    }
}

__device__ __forceinline__ void norm_mod_row(const float* xrow, const float* g, const float* shift, const float* scale, bf16* orow, unsigned char* orow8, int lane) {
    const GAS f32x4* xr = (const GAS f32x4*)xrow + lane;
    f32x4 v[8]; float s = 0.f;
#pragma unroll
    for (int j = 0; j < 8; ++j) { v[j] = xr[64 * j]; s += (v[j].x * v[j].x + v[j].y * v[j].y) + (v[j].z * v[j].z + v[j].w * v[j].w); }
    const float rstd = 1.f / sqrtf(wave_sum(s) * (1.f / D) + EPS);
    GAS v2u* o8 = (GAS v2u*)orow + lane;
#pragma unroll
    for (int j = 0; j < 8; ++j) {
        const int d = 4 * lane + 256 * j;
        const f32x4 gg = *(const f32x4*)(g + d), sh = *(const f32x4*)(shift + d), sc = *(const f32x4*)(scale + d);
        const f32x4 y = v[j] * rstd * gg * (sc + 1.0f) + sh;
        v2u o; o.x = pk2(y.x, y.y); o.y = pk2(y.z, y.w); o8[64 * j] = o;
        ((GAS unsigned*)orow8)[lane + 64 * j] = pk4_fp8(y.x, y.y, y.z, y.w);
    }
}
__device__ __forceinline__ void phase_prep1(Frame& F, const Args& a) {
    PHASE_IDS();
    LAS float* scr = (LAS float*)(F.lds + wid * 16384);
    const int gw = F.vcu * NWAVES + wid, NGW = F.G * NWAVES;
    constexpr int I_IN = (D / 64) * (INCOLS / 32), I_A = (1024 / 64) * (D / 32), I_O = (D / 64) * (D / 32), I_SG = (D / 64) * (DEXP / 32), I_SD = (DEXP / 64) * (D / 32);
    constexpr int NITEMS = I_IN + 2 * I_A + I_O + 2 * I_SG + I_SD;
    unsigned char* ws = F.ws;
#define PREP_DECODE(IT, idx) do { int r_ = (idx); \
        if (r_ < I_IN) { const int nblk = INCOLS / 32, kb = r_ / nblk, n0 = (r_ % nblk) * 32, k0 = 64 * kb; IT.src = a.in[IN_WIN] + (size_t)k0 * INCOLS + n0; IT.N = INCOLS; \
            if (n0 < 3072)      { IT.fp8 = 0; IT.ldb = D * 2; IT.dst = ws + WS_WIN + ((size_t)n0 * D + k0) * 2; }                         \
            else if (n0 < 4096) { IT.fp8 = 1; IT.ldb = D;     IT.dst = ws + WS_WIN8 + (size_t)(n0 - 3072) * D + k0; }                       \
            else if (n0 < 7168) { IT.fp8 = 0; IT.ldb = D * 2; IT.dst = ws + WS_WIN + ((size_t)(n0 - 1024) * D + k0) * 2; }                  \
            else                { IT.fp8 = 1; IT.ldb = D;     IT.dst = ws + WS_WIN8 + (size_t)(n0 - 7168 + 1024) * D + k0; } }              \
        else { r_ -= I_IN; \
        if (r_ < I_A) { const int kb = r_ / (D / 32), n0 = (r_ % (D / 32)) * 32, k0 = 64 * kb; IT.src = a.in[IN_WA] + (size_t)k0 * D + n0; IT.N = D; IT.fp8 = 0; IT.ldb = D * 2; IT.dst = ws + WS_WA + ((size_t)n0 * D + k0) * 2; } \
        else { r_ -= I_A; \
        if (r_ < I_A) { const int kb = r_ / (D / 32), n0 = (r_ % (D / 32)) * 32, k0 = 64 * kb; IT.src = a.in[IN_WB] + (size_t)k0 * D + n0; IT.N = D; IT.fp8 = 0; IT.ldb = D * 2; IT.dst = ws + WS_WA + ((size_t)n0 * D + 1024 + k0) * 2; } \
        else { r_ -= I_A; \
        if (r_ < I_O) { const int kb = r_ / (D / 32), n0 = (r_ % (D / 32)) * 32, k0 = 64 * kb; IT.src = a.in[IN_WOUT] + (size_t)k0 * D + n0; IT.N = D; IT.fp8 = 0; IT.ldb = D * 2; IT.dst = ws + WS_WOUT + ((size_t)n0 * D + k0) * 2; } \
        else { r_ -= I_O; \
        if (r_ < I_SG) { const int kb = r_ / (DEXP / 32), n0 = (r_ % (DEXP / 32)) * 32, k0 = 64 * kb; IT.src = a.in[IN_SG] + (size_t)k0 * DEXP + n0; IT.N = DEXP; IT.fp8 = 1; IT.ldb = D; IT.dst = ws + WS_WSH + (size_t)n0 * D + k0; } \
        else { r_ -= I_SG; \
        if (r_ < I_SG) { const int kb = r_ / (DEXP / 32), n0 = (r_ % (DEXP / 32)) * 32, k0 = 64 * kb; IT.src = a.in[IN_SU] + (size_t)k0 * DEXP + n0; IT.N = DEXP; IT.fp8 = 1; IT.ldb = D; IT.dst = ws + WS_WSH + 2 * MiB + (size_t)n0 * D + k0; } \
        else { r_ -= I_SG; const int kb = r_ / (D / 32), n0 = (r_ % (D / 32)) * 32, k0 = 64 * kb; IT.src = a.in[IN_SD] + (size_t)k0 * D + n0; IT.N = D; IT.fp8 = 1; IT.ldb = DEXP; IT.dst = ws + WS_WSH + 4 * MiB + (size_t)n0 * DEXP + k0; } } } } } } } while (0)
    for (int it = gw; it < NITEMS; it += 2 * NGW) {
        TrItem A_, B_; const bool hasB = (it + NGW < NITEMS);
        PREP_DECODE(A_, it); if (hasB) PREP_DECODE(B_, it + NGW); else B_ = A_;
        TR_PAIR(A_, hasB, B_, lane, scr);
    }
#undef PREP_DECODE
    { bf16* RH = (bf16*)(ws + WS_RWT_HI); bf16* RL = (bf16*)(ws + WS_RWT_LO); const float* rw = a.in[IN_RW];
      for (int i = (F.vcu * NWAVES + wid) * 64 + lane; i < 64 * D; i += F.G * NTHREADS) { const int e = i & 63, k = i >> 6; const float w = rw[i];
          const unsigned hb = f2bf(w); RH[e * D + k] = (bf16)hb; RL[e * D + k] = (bf16)f2bf(w - bf2f(hb)); } }
}
__device__ __forceinline__ void phase_hrows(Frame& F, const Args& a) {
    PHASE_IDS();
    const int gw = F.vcu * NWAVES + wid, NGW = F.G * NWAVES;
    unsigned char* ws = F.ws;
    const float* mod = (const float*)(F.ctl + CW_MOD);
    for (int m = gw; m < T; m += NGW) { const int b = m / SEQ;
        norm_mod_row(a.in[IN_X] + (size_t)m * D, a.in[IN_N1G], mod + b * 12288, mod + b * 12288 + 2048, (bf16*)(ws + WS_H) + (size_t)m * D, ws + WS_H8 + (size_t)m * D, lane); }
}

struct DenseGemm : pg8::DenseOrder {
    static constexpr bool GATHER = false;
    const char* A; const char* Bt; unsigned lda2, ldb2; int nt;
    __device__ __forceinline__ const char* aptr(const pg8::Unit& u) const { return A + (size_t)(u.pm * 256) * lda2; }
    __device__ __forceinline__ void aoffs(const pg8::Unit&, int, unsigned (&)[2][2]) const {}
    __device__ __forceinline__ void bptrs(const pg8::Unit& u, const char*& b0, const char*& b1) const { b0 = Bt + (size_t)(u.pn * 256) * ldb2; b1 = b0 + (size_t)128 * ldb2; }
};

template <int PART>
struct EpiInProj {
    static constexpr bool PERM = true, MIDK = false;
    unsigned char* ws;
    __device__ __forceinline__ void operator()(const f32x4 (&acc)[2][2][4][2], const pg8::Unit& u, int wr, int wc, int fr, int fq) const {
        bf16* base; int ldc, colt;
        if (PART == 0) { const int idx = u.pn >> 2, slot = idx < 3 ? idx : idx + 1; base = (bf16*)(ws + WS_PROJ + (size_t)slot * 32 * MiB); ldc = 1024; colt = (u.pn & 3) * 256; }
        else if (u.pn < 4) { base = (bf16*)(ws + WS_HG); ldc = 1024; colt = u.pn * 256; }
        else { const int q = u.pn - 4; base = (bf16*)(ws + WS_GA + (size_t)(q >> 3) * 64 * MiB); ldc = 2048; colt = (q & 7) * 256; }
        const int row0 = u.pm * 256 + wr * 64 + fr, col0 = colt + wc * 32 + 8 * fq;
#pragma unroll
        for (int ai = 0; ai < 2; ++ai)
#pragma unroll
            for (int m = 0; m < 4; ++m) { bf16* rowp = base + (size_t)(row0 + ai * 128 + m * 16) * ldc + col0;
#pragma unroll
                for (int bj = 0; bj < 2; ++bj) { const f32x4 v0 = acc[ai][bj][m][0], v1 = acc[ai][bj][m][1];
                    v4u w; w.x = pg8::cvt_pk_bf16(v0[0], v0[1]); w.y = pg8::cvt_pk_bf16(v0[2], v0[3]); w.z = pg8::cvt_pk_bf16(v1[0], v1[1]); w.w = pg8::cvt_pk_bf16(v1[2], v1[3]);
                    *(v4u*)(rowp + bj * 128) = w; } }
    }
};


constexpr int H1_TS = 272, H1_TS2 = 144;
constexpr int H1_QD = 0, H1_KD = 17408, H1_KI = 34816, H1_KBT = 60928, H1_VT = 79360, H1_AT = 97792, H1_TOT = 107008;
__device__ __forceinline__ void phase_h1(Frame& F) {
    unsigned char* ws = F.ws;
    const bf16* HQ = (const bf16*)(ws + WS_HQ); bf16* QT = (bf16*)(ws + WS_QT); const bf16* HF = (const bf16*)(ws + WS_HF); const bf16* HI = (const bf16*)(ws + WS_HI);
    bf16* STg = (bf16*)(ws + WS_ST); float* DEC = (float*)(ws + WS_DEC); float* OI = (float*)(ws + WS_OI);
    LAS unsigned char* L = F.lds;
    LAS float* TOT = (LAS float*)(L + H1_TOT);
    PHASE_IDS();
    const int kp = lane, seg = wid, qd = wid >> 1, r = lane & 15, g = lane >> 4;
    unsigned nq[8], nf[8], ni[8];
#define H1_LOAD(uu_) do { const int bh_ = (uu_) >> 6, n_ = (uu_) & 63; const size_t r0_ = (size_t)(bh_ >> 3) * SEQ + (size_t)n_ * 64 + 8 * seg; const int c_ = (bh_ & 7) * 128 + 2 * kp; \
        _Pragma("unroll") for (int i_ = 0; i_ < 8; ++i_) { const size_t idx_ = (r0_ + i_) * 1024 + c_; nq[i_] = *(const GAS unsigned*)(HQ + idx_); nf[i_] = *(const GAS unsigned*)(HF + idx_); ni[i_] = *(const GAS unsigned*)(HI + idx_); } } while (0)
    if (F.vcu < NCH_UNITS) H1_LOAD(F.vcu);
    for (int u = F.vcu; u < NCH_UNITS; u += F.G) {
        const int bh = u >> 6, n = u & 63, b = bh >> 3, h = bh & 7;
        const size_t row0 = (size_t)b * SEQ + (size_t)n * 64;
        const int col = h * 128 + 2 * kp;
        float cs0[8], cs1[8], kk0[8], kk1[8], qs0[8], qs1[8]; unsigned vv[8];
        const float lb0 = F.vec[VW_LB + col], lb1 = F.vec[VW_LB + col + 1];
        {
            float run0 = 0.f, run1 = 0.f;
#pragma unroll
            for (int uu = 0; uu < 8; ++uu) {
                const float q0 = bflo(nq[uu]), q1 = bfhi(nq[uu]), f0 = bflo(nf[uu]), f1 = bfhi(nf[uu]); vv[uu] = ni[uu];
                const float fg0 = lb0 + (1.f - lb0) * fsigmoid(f0), fg1 = lb1 + (1.f - lb1) * fsigmoid(f1);
                run0 += __logf(fg0); run1 += __logf(fg1); cs0[uu] = run0; cs1[uu] = run1; kk0[uu] = 1.f - fg0; kk1[uu] = 1.f - fg1;
                qs0[uu] = q0 * fsigmoid(q0) * 0.08838834764831845f; qs1[uu] = q1 * fsigmoid(q1) * 0.08838834764831845f;
            }
            *(LAS f32x2*)(TOT + seg * 128 + 2 * kp) = (f32x2){run0, run1};
        }
        __syncthreads();
        {
            float P0[9], P1[9]; P0[0] = 0.f; P1[0] = 0.f;
#pragma unroll
            for (int s = 0; s < 8; ++s) { const f32x2 tt = *(const LAS f32x2*)(TOT + s * 128 + 2 * kp); P0[s + 1] = P0[s] + tt.x; P1[s + 1] = P1[s] + tt.y; }
            float rq0 = 0.f, rq1 = 0.f, rs0 = 0.f, rs1 = 0.f;
#pragma unroll
            for (int s = 1; s < 8; ++s) if (seg == s) { rq0 = P0[s]; rq1 = P1[s]; rs0 = P0[s & ~1]; rs1 = P1[s & ~1]; }
            const float a0 = __expf(rq0 - rs0), a1 = __expf(rq1 - rs1), ai0 = __expf(fminf(rs0 - rq0, 40.f)), ai1 = __expf(fminf(rs1 - rq1, 40.f));
            const float e10 = __expf(P0[2] - rq0), e11 = __expf(P1[2] - rq1), e20 = __expf(P0[4] - rq0), e21 = __expf(P1[4] - rq1), e30 = __expf(P0[6] - rq0), e31 = __expf(P1[6] - rq1);
            const float eb0 = __expf(P0[8] - rq0), eb1 = __expf(P1[8] - rq1), eq0 = __expf(rq0), eq1 = __expf(rq1);
            float kb0[8], kb1[8];
#pragma unroll
            for (int uu = 0; uu < 8; ++uu) {
                const int t = 8 * seg + uu;
                const float qE0 = qs0[uu] * __expf(cs0[uu]), qE1 = qs1[uu] * __expf(cs1[uu]);
                const float kE0 = kk0[uu] * __expf(fminf(-cs0[uu], 40.f)), kE1 = kk1[uu] * __expf(fminf(-cs1[uu], 40.f));
                *(LAS unsigned*)(L + H1_QD + t * H1_TS + 4 * kp) = pg8::cvt_pk_bf16(qE0 * a0, qE1 * a1);
                *(LAS unsigned*)(L + H1_KD + t * H1_TS + 4 * kp) = pg8::cvt_pk_bf16(kE0 * ai0, kE1 * ai1);
                if (qd < 1) *(LAS unsigned*)(L + H1_KI + (0 + t) * H1_TS + 4 * kp) = pg8::cvt_pk_bf16(kE0 * e10, kE1 * e11);
                if (qd < 2) *(LAS unsigned*)(L + H1_KI + (16 + t) * H1_TS + 4 * kp) = pg8::cvt_pk_bf16(kE0 * e20, kE1 * e21);
                if (qd < 3) *(LAS unsigned*)(L + H1_KI + (48 + t) * H1_TS + 4 * kp) = pg8::cvt_pk_bf16(kE0 * e30, kE1 * e31);
                kb0[uu] = kE0 * eb0; kb1[uu] = kE1 * eb1;
                *(GAS unsigned*)(QT + (row0 + t) * 1024 + col) = pg8::cvt_pk_bf16(qE0 * eq0, qE1 * eq1);
            }
            *(LAS v4u*)(L + H1_KBT + (2 * kp) * H1_TS2 + 16 * seg) = (v4u){pg8::cvt_pk_bf16(kb0[0], kb0[1]), pg8::cvt_pk_bf16(kb0[2], kb0[3]), pg8::cvt_pk_bf16(kb0[4], kb0[5]), pg8::cvt_pk_bf16(kb0[6], kb0[7])};
            *(LAS v4u*)(L + H1_KBT + (2 * kp + 1) * H1_TS2 + 16 * seg) = (v4u){pg8::cvt_pk_bf16(kb1[0], kb1[1]), pg8::cvt_pk_bf16(kb1[2], kb1[3]), pg8::cvt_pk_bf16(kb1[4], kb1[5]), pg8::cvt_pk_bf16(kb1[6], kb1[7])};
            *(LAS v4u*)(L + H1_VT + (2 * kp) * H1_TS2 + 16 * seg) = (v4u){(vv[0] & 0xffffu) | (vv[1] << 16), (vv[2] & 0xffffu) | (vv[3] << 16), (vv[4] & 0xffffu) | (vv[5] << 16), (vv[6] & 0xffffu) | (vv[7] << 16)};
            *(LAS v4u*)(L + H1_VT + (2 * kp + 1) * H1_TS2 + 16 * seg) = (v4u){(vv[0] >> 16) | (vv[1] & 0xffff0000u), (vv[2] >> 16) | (vv[3] & 0xffff0000u), (vv[4] >> 16) | (vv[5] & 0xffff0000u), (vv[6] >> 16) | (vv[7] & 0xffff0000u)};
            if (seg == 0) *(GAS f32x2*)(DEC + (size_t)u * 128 + 2 * kp) = (f32x2){__expf(P0[8]), __expf(P1[8])};
        }
        __syncthreads();
        if (u + F.G < NCH_UNITS) H1_LOAD(u + F.G);
        for (int blk = wid; blk < 10; blk += 8) {
            const int i = blk >= 6 ? 3 : (blk >= 3 ? 2 : (blk >= 1 ? 1 : 0)), j = blk - (i * (i + 1)) / 2;
            const int kib = (i == 2) ? 16 : (i == 3 ? 48 : 0);
            const int krow_off = (j == i) ? (H1_KD + (16 * j + r) * H1_TS) : (H1_KI + (kib + 16 * j + r) * H1_TS);
            f32x4 acc = (f32x4){0.f, 0.f, 0.f, 0.f};
#pragma unroll
            for (int ks = 0; ks < 4; ++ks) {
                const bf16x8 af = *(const LAS bf16x8*)(L + H1_QD + (16 * i + r) * H1_TS + (32 * ks + 8 * g) * 2);
                const bf16x8 bfv = *(const LAS bf16x8*)(L + krow_off + (32 * ks + 8 * g) * 2);
                acc = __builtin_amdgcn_mfma_f32_16x16x32_bf16(af, bfv, acc, 0, 0, 0);
            }
#pragma unroll
            for (int rg = 0; rg < 4; ++rg) {
                const int tl = 4 * g + rg; float v = acc[rg];
                if (j == i && r > tl) v = 0.f;
                *(LAS bf16*)(L + H1_AT + (16 * i + tl) * H1_TS2 + (16 * j + r) * 2) = (bf16)f2bf(v);
            }
        }
        if (wid >= 2) {
            const int zb = wid - 2, zi = zb < 3 ? 0 : (zb < 5 ? 1 : 2), zj = zb < 3 ? zb + 1 : (zb < 5 ? zb - 1 : 3);
#pragma unroll
            for (int rg = 0; rg < 4; ++rg) *(LAS bf16*)(L + H1_AT + (16 * zi + 4 * g + rg) * H1_TS2 + (16 * zj + r) * 2) = (bf16)0;
        }
        __syncthreads();
        {
            bf16x8 vf[2];
#pragma unroll
            for (int ks = 0; ks < 2; ++ks) vf[ks] = *(const LAS bf16x8*)(L + H1_VT + (16 * wid + r) * H1_TS2 + (32 * ks + 8 * g) * 2);
#pragma unroll
            for (int rb = 0; rb < 4; ++rb) {
                f32x4 acc = (f32x4){0.f, 0.f, 0.f, 0.f};
#pragma unroll
                for (int ks = 0; ks < 2; ++ks) { const bf16x8 af = *(const LAS bf16x8*)(L + H1_AT + (16 * rb + r) * H1_TS2 + (32 * ks + 8 * g) * 2);
                    acc = __builtin_amdgcn_mfma_f32_16x16x32_bf16(vf[ks], af, acc, 0, 0, 0); }
                *(GAS f32x4*)(OI + (row0 + 16 * rb + r) * 1024 + h * 128 + 16 * wid + 4 * g) = acc;
            }
#pragma unroll
            for (int rb = 0; rb < 8; ++rb) {
                f32x4 acc = (f32x4){0.f, 0.f, 0.f, 0.f};
#pragma unroll
                for (int ks = 0; ks < 2; ++ks) { const bf16x8 af = *(const LAS bf16x8*)(L + H1_KBT + (16 * rb + r) * H1_TS2 + (32 * ks + 8 * g) * 2);
                    acc = __builtin_amdgcn_mfma_f32_16x16x32_bf16(af, vf[ks], acc, 0, 0, 0); }
                v2u o; o.x = pk2(acc[0], acc[1]); o.y = pk2(acc[2], acc[3]);
                *(GAS v2u*)(STg + (size_t)u * 16384 + (16 * wid + r) * 128 + 16 * rb + 4 * g) = o;
            }
        }
        __syncthreads();
    }
#undef H1_LOAD
}

__device__ __forceinline__ void phase_qkprep(Frame& F, const Args& a) {
    PHASE_IDS();
    const int gw = F.vcu * NWAVES + wid, NGW = F.G * NWAVES;
    float gq[16], gk[16];
#pragma unroll
    for (int e = 0; e < 16; ++e) { gq[e] = a.in[IN_QNG][16 * (lane & 3) + e] * (0.125f * LOG2E); gk[e] = a.in[IN_KNG][16 * (lane & 3) + e]; }
    for (int m = gw; m < T; m += NGW) {
#pragma unroll
        for (int which = 0; which < 2; ++which) {
            const bf16* p = (const bf16*)(F.ws + (which ? WS_DK : WS_DQ)) + (size_t)m * 1024 + 16 * lane;
            bf16* po = (bf16*)(F.ws + (which ? WS_DKN : WS_DQN)) + (size_t)m * 1024 + 16 * lane;
            const v4u w0 = *(const GAS v4u*)p, w1 = *(const GAS v4u*)(p + 8);
            float x[16];
            x[0] = bflo(w0.x); x[1] = bfhi(w0.x); x[2] = bflo(w0.y); x[3] = bfhi(w0.y); x[4] = bflo(w0.z); x[5] = bfhi(w0.z); x[6] = bflo(w0.w); x[7] = bfhi(w0.w);
            x[8] = bflo(w1.x); x[9] = bfhi(w1.x); x[10] = bflo(w1.y); x[11] = bfhi(w1.y); x[12] = bflo(w1.z); x[13] = bfhi(w1.z); x[14] = bflo(w1.w); x[15] = bfhi(w1.w);
            float ss = 0.f;
#pragma unroll
            for (int e = 0; e < 16; ++e) ss += x[e] * x[e];
            ss += __shfl_xor(ss, 1); ss += __shfl_xor(ss, 2);
            const float rstd = 1.f / sqrtf(ss * (1.f / 64.f) + EPS);
#pragma unroll
            for (int e = 0; e < 16; ++e) x[e] = x[e] * rstd * (which ? gk[e] : gq[e]);
            v4u o0, o1;
            o0.x = pk2(x[0], x[1]); o0.y = pk2(x[2], x[3]); o0.z = pk2(x[4], x[5]); o0.w = pk2(x[6], x[7]);
            o1.x = pk2(x[8], x[9]); o1.y = pk2(x[10], x[11]); o1.z = pk2(x[12], x[13]); o1.w = pk2(x[14], x[15]);
            *(GAS v4u*)po = o0; *(GAS v4u*)(po + 8) = o1;
        }
    }
}

__device__ __forceinline__ void phase_h2(Frame& F) {
    bf16* STg = (bf16*)(F.ws + WS_ST); const float* DEC = (const float*)(F.ws + WS_DEC);
    const int NIT = 32 * 128 * 32;
    PHASE_IDS();
    for (int it = F.vcu * NTHREADS + tid; it < NIT; it += F.G * NTHREADS) {
        const int bh = it >> 12, v = (it >> 5) & 127, kg = it & 31;
        float run0 = 0.f, run1 = 0.f, run2 = 0.f, run3 = 0.f;
        for (int n0 = 0; n0 < NCHUNK; n0 += 4) {
            v2u loc[4]; f32x4 dc[4];
#pragma unroll
            for (int j = 0; j < 4; ++j) { const size_t un = (size_t)bh * 64 + n0 + j;
                loc[j] = *(const GAS v2u*)(STg + un * 16384 + v * 128 + kg * 4); dc[j] = *(const GAS f32x4*)(DEC + un * 128 + kg * 4); }
#pragma unroll
            for (int j = 0; j < 4; ++j) { const size_t un = (size_t)bh * 64 + n0 + j;
                v2u o; o.x = pk2(run0, run1); o.y = pk2(run2, run3);
                *(GAS v2u*)(STg + un * 16384 + v * 128 + kg * 4) = o;
                run0 = dc[j].x * run0 + bflo(loc[j].x); run1 = dc[j].y * run1 + bfhi(loc[j].x); run2 = dc[j].z * run2 + bflo(loc[j].y); run3 = dc[j].w * run3 + bfhi(loc[j].y); }
        }
    }
}

__device__ __forceinline__ void phase_h3(Frame& F, const Args& a) {
    const bf16* HQ = (const bf16*)(F.ws + WS_QT); const bf16* HG = (const bf16*)(F.ws + WS_HG); const bf16* STg = (const bf16*)(F.ws + WS_ST);
    const float* OI = (const float*)(F.ws + WS_OI); bf16* BR = (bf16*)(F.ws + WS_BR);
    PHASE_IDS();
    const int r = lane & 15, g = lane >> 4, sub = wid >> 2, rb = wid & 3;
    f32x4 gn[8];
#pragma unroll
    for (int cb = 0; cb < 8; ++cb) gn[cb] = *(const GAS f32x4*)(a.in[IN_HGNG] + 16 * cb + 4 * g);
    for (int up = F.vcu; up < NCH_UNITS / 2; up += F.G) {
        const int u = up * 2 + sub, bh = u >> 6, n = u & 63, b = bh >> 3, h = bh & 7;
        const size_t m0 = (size_t)b * SEQ + (size_t)n * 64 + 16 * rb;
        bf16x8 af[4];
#pragma unroll
        for (int ks = 0; ks < 4; ++ks) af[ks] = *(const GAS bf16x8*)(HQ + (m0 + r) * 1024 + h * 128 + 32 * ks + 8 * g);
        f32x4 acc[8];
#pragma unroll
        for (int cb = 0; cb < 8; ++cb) {
            acc[cb] = (f32x4){0.f, 0.f, 0.f, 0.f};
#pragma unroll
            for (int ks = 0; ks < 4; ++ks) { const bf16x8 bfv = *(const GAS bf16x8*)(STg + (size_t)u * 16384 + (16 * cb + r) * 128 + 32 * ks + 8 * g);
                acc[cb] = __builtin_amdgcn_mfma_f32_16x16x32_bf16(bfv, af[ks], acc[cb], 0, 0, 0); }
        }
        float ss = 0.f;
#pragma unroll
        for (int cb = 0; cb < 8; ++cb) {
            const f32x4 o4 = *(const GAS f32x4*)(OI + (m0 + r) * 1024 + h * 128 + 16 * cb + 4 * g);
#pragma unroll
            for (int rg = 0; rg < 4; ++rg) { const float o = acc[cb][rg] + o4[rg]; acc[cb][rg] = o; ss += o * o; }
        }
        ss += __shfl_xor(ss, 16); ss += __shfl_xor(ss, 32);
        const float rstd = 1.f / sqrtf(ss * (1.f / 128.f) + EPS);
#pragma unroll
        for (int cb = 0; cb < 8; ++cb) {
            const v2u hg = *(const GAS v2u*)(HG + (m0 + r) * 1024 + h * 128 + 16 * cb + 4 * g);
            const float g0 = bflo(hg.x), g1 = bfhi(hg.x), g2 = bflo(hg.y), g3 = bfhi(hg.y);
            v2u o;
            o.x = pg8::cvt_pk_bf16(acc[cb][0] * rstd * gn[cb][0] * (g0 * fsigmoid(g0)), acc[cb][1] * rstd * gn[cb][1] * (g1 * fsigmoid(g1)));
            o.y = pg8::cvt_pk_bf16(acc[cb][2] * rstd * gn[cb][2] * (g2 * fsigmoid(g2)), acc[cb][3] * rstd * gn[cb][3] * (g3 * fsigmoid(g3)));
            *(GAS v2u*)(BR + (m0 + r) * 2048 + h * 128 + 16 * cb + 4 * g) = o;
        }
    }
}

__device__ __forceinline__ void phase_convert_experts(Frame& F, const Args& a) {
    PHASE_IDS();
    LAS float* scr = (LAS float*)(F.lds + wid * 16384);
    const int gw = F.vcu * NWAVES + wid, NGW = F.G * NWAVES;
    constexpr int IPM = 256, NITEMS = NEXP * 3 * IPM;
    for (int it = gw; it < NITEMS; it += NGW) {
        const int e = it / (3 * IPM), r = it % (3 * IPM), which = r / IPM, item = r % IPM;
        TrItem A_, B_; A_.fp8 = 1;
        if (which < 2) { const int kb2 = item / (DEXP / 32), n0 = (item % (DEXP / 32)) * 32, k0 = 128 * kb2;
            A_.src = a.in[which ? IN_EU : IN_EG] + (size_t)e * D * DEXP + (size_t)k0 * DEXP + n0; A_.N = DEXP; A_.ldb = D; A_.dst = F.ws + (which ? WS_WU : WS_WG) + (size_t)e * DEXP * D + (size_t)n0 * D + k0; }
        else { const int kb2 = item / (D / 32), n0 = (item % (D / 32)) * 32, k0 = 128 * kb2;
            A_.src = a.in[IN_ED] + (size_t)e * DEXP * D + (size_t)k0 * D + n0; A_.N = D; A_.ldb = DEXP; A_.dst = F.ws + WS_WDOWN + (size_t)e * D * DEXP + (size_t)n0 * DEXP + k0; }
        B_ = A_; B_.src = A_.src + (size_t)64 * A_.N; B_.dst = A_.dst + 64;
        TR_PAIR(A_, true, B_, lane, scr);
    }
}

constexpr int AT_KCH = 1040, AT_VDB = 4160, AT_STAGE = 33280, AT_TBL = 66560, AT_WSF = 67584, AT_QF = 68608;
__device__ __forceinline__ int crow(int r, int hi) { return (r & 3) + 8 * (r >> 2) + 4 * hi; }
__device__ __forceinline__ void phase_attn(Frame& F, const Args& a, const int pi_lo, const int pi_hi) {
    const bf16* DQ = (const bf16*)(F.ws + WS_DQN); const bf16* DK = (const bf16*)(F.ws + WS_DKN); const bf16* DV = (const bf16*)(F.ws + WS_DV);
    bf16* BR = (bf16*)(F.ws + WS_BR);
    LAS unsigned char* L = F.lds;
    LAS float* TBL = (LAS float*)(L + AT_TBL); LAS float* WSF = (LAS float*)(L + AT_WSF); LAS float* XB = (LAS float*)L;
    PHASE_IDS();
    const int c = wid >> 2, qblk = wid & 3, r32 = lane & 31, hi = lane >> 5;
    const float lam = F.vec[VW_LAM], M2 = F.vec[VW_M2];
    const int lrow0 = tid >> 4, lch = tid & 15, lrow1 = lrow0 + 32;
    const int kdst0 = lch * AT_KCH + lrow0 * 16, kdst1 = lch * AT_KCH + lrow1 * 16;
    const int vdst0 = 16640 + (lch >> 2) * AT_VDB + (lrow0 >> 4) * 1024 + (lrow0 & 15) * 64 + (lch & 3) * 16;
    const int vdst1 = 16640 + (lch >> 2) * AT_VDB + (lrow1 >> 4) * 1024 + (lrow1 & 15) * 64 + (lch & 3) * 16;
    const int vlane = 16640 + ((lane >> 4) & 1) * 32 + (lane & 3) * 8 + (4 * hi + ((lane & 15) >> 2)) * 64;
    float dg[4];
#pragma unroll
    for (int d0 = 0; d0 < 4; ++d0) dg[d0] = a.in[IN_DANG][32 * d0 + r32] * (1.0f - LAMBDA_INIT);
    for (int pi = pi_lo; pi < pi_hi; ++pi) {
        if (pi == (F.vcu & 3)) { phase_convert_experts(F, a); __syncthreads(); }
        const int pp = F.vcu * 2 + (pi >> 1);
        if (pp >= 512) break;
        const int bh = pp >> 4, s = pp & 15, qb = (pi & 1) ? 31 - s : s, b = bh >> 3, h = bh & 7;
        const int q0 = qb * 128, NT = 2 * qb + 2;
        const size_t rowb = (size_t)b * SEQ;
        if (tid < 256) TBL[tid] = F.vec[VW_TBL + h * 256 + tid];
        const int qfo = AT_QF + wid * 4096 + lane * 16;
#pragma unroll
        for (int d0 = 0; d0 < 4; ++d0) *(LAS bf16x8*)(L + qfo + d0 * 1024) = *(const GAS bf16x8*)(DQ + (rowb + q0 + 32 * qblk + r32) * 1024 + h * 128 + c * 64 + 16 * d0 + 8 * hi);
        const bf16* ksrc0 = DK + (rowb + lrow0) * 1024 + h * 128 + lch * 8; const bf16* ksrc1 = ksrc0 + (size_t)32 * 1024;
        const bf16* vsrc0 = DV + (rowb + lrow0) * 1024 + h * 128 + lch * 8; const bf16* vsrc1 = vsrc0 + (size_t)32 * 1024;
        v4u kr0, kr1, vr0, vr1;
        kr0 = *(const GAS v4u*)ksrc0; kr1 = *(const GAS v4u*)ksrc1; vr0 = *(const GAS v4u*)vsrc0; vr1 = *(const GAS v4u*)vsrc1;
        *(LAS v4u*)(L + kdst0) = kr0; *(LAS v4u*)(L + kdst1) = kr1; *(LAS v4u*)(L + vdst0) = vr0; *(LAS v4u*)(L + vdst1) = vr1;
        __syncthreads();
        const float tb31 = TBL[255];
        f32x16 o[4];
#pragma unroll
        for (int d0 = 0; d0 < 4; ++d0)
#pragma unroll
            for (int rr = 0; rr < 16; ++rr) o[d0][rr] = 0.f;
        float lsum = 0.f;
        const int qpos = q0 + 32 * qblk + r32;
        for (int j = 0; j < NT; ++j) {
            const int st = (j & 1) * AT_STAGE, sn = ((j + 1) & 1) * AT_STAGE;
            const bool more = (j + 1 < NT);
            if (more) { const size_t go = (size_t)(j + 1) * 64 * 1024;
                kr0 = *(const GAS v4u*)(ksrc0 + go); kr1 = *(const GAS v4u*)(ksrc1 + go); vr0 = *(const GAS v4u*)(vsrc0 + go); vr1 = *(const GAS v4u*)(vsrc1 + go); }
            const bool far = (j < NT - 4);
            const float cinit = far ? (tb31 - M2) : (-M2);
            f32x16 p0, p1;
#pragma unroll
            for (int rr = 0; rr < 16; ++rr) { p0[rr] = cinit; p1[rr] = cinit; }
#pragma unroll
            for (int d0 = 0; d0 < 4; ++d0) {
                const bf16x8 k0 = *(const LAS bf16x8*)(L + st + (8 * c + 2 * d0 + hi) * AT_KCH + r32 * 16);
                const bf16x8 k1 = *(const LAS bf16x8*)(L + st + (8 * c + 2 * d0 + hi) * AT_KCH + r32 * 16 + 512);
                const bf16x8 qf = *(const LAS bf16x8*)(L + qfo + d0 * 1024);
                p0 = __builtin_amdgcn_mfma_f32_32x32x16_bf16(k0, qf, p0, 0, 0, 0);
                p1 = __builtin_amdgcn_mfma_f32_32x32x16_bf16(k1, qf, p1, 0, 0, 0);
            }
            if (!far) {
                float tb0[16], tb1[16];
#pragma unroll
                for (int rr = 0; rr < 16; ++rr) { const int d0v = qpos - (64 * j + crow(rr, hi)), d1v = d0v - 32;
                    tb0[rr] = TBL[d0v < 0 ? 0 : (d0v > 255 ? 255 : d0v)]; tb1[rr] = TBL[d1v < 0 ? 0 : (d1v > 255 ? 255 : d1v)]; }
                asm volatile("s_waitcnt lgkmcnt(0)" ::: "memory");
#pragma unroll
                for (int rr = 0; rr < 16; ++rr) { const int d0v = qpos - (64 * j + crow(rr, hi)), d1v = d0v - 32;
                    p0[rr] = d0v >= 0 ? p0[rr] + tb0[rr] : -INFINITY; p1[rr] = d1v >= 0 ? p1[rr] + tb1[rr] : -INFINITY; }
            }
            float sacc = 0.f;
#pragma unroll
            for (int rr = 0; rr < 16; ++rr) { p0[rr] = __builtin_amdgcn_exp2f(p0[rr]); p1[rr] = __builtin_amdgcn_exp2f(p1[rr]); sacc += p0[rr] + p1[rr]; }
            lsum += sacc;
#define AT_VLD(dst, ks) do { _Pragma("unroll") for (int _d = 0; _d < 4; ++_d) { \
                const s16x4 _lo = __builtin_bit_cast(s16x4, __builtin_amdgcn_ds_read_tr16_b64_v4i16((LAS s16x4*)(L + st + vlane + _d * AT_VDB + (ks) * 1024))); \
                const s16x4 _hh = __builtin_bit_cast(s16x4, __builtin_amdgcn_ds_read_tr16_b64_v4i16((LAS s16x4*)(L + st + vlane + _d * AT_VDB + (ks) * 1024 + 512))); \
                dst[_d] = (bf16x8){_lo[0], _lo[1], _lo[2], _lo[3], _hh[0], _hh[1], _hh[2], _hh[3]}; } } while (0)
#define AT_PV(src, ks) do { v4u _w; if ((ks) < 2) { _w.x = pg8::cvt_pk_bf16(p0[8 * (ks) + 0], p0[8 * (ks) + 1]); _w.y = pg8::cvt_pk_bf16(p0[8 * (ks) + 2], p0[8 * (ks) + 3]); _w.z = pg8::cvt_pk_bf16(p0[8 * (ks) + 4], p0[8 * (ks) + 5]); _w.w = pg8::cvt_pk_bf16(p0[8 * (ks) + 6], p0[8 * (ks) + 7]); } \
                else { _w.x = pg8::cvt_pk_bf16(p1[8 * (ks) - 16], p1[8 * (ks) - 15]); _w.y = pg8::cvt_pk_bf16(p1[8 * (ks) - 14], p1[8 * (ks) - 13]); _w.z = pg8::cvt_pk_bf16(p1[8 * (ks) - 12], p1[8 * (ks) - 11]); _w.w = pg8::cvt_pk_bf16(p1[8 * (ks) - 10], p1[8 * (ks) - 9]); } \
                const bf16x8 _pa = __builtin_bit_cast(bf16x8, _w); \
                _Pragma("unroll") for (int _d = 0; _d < 4; ++_d) o[_d] = __builtin_amdgcn_mfma_f32_32x32x16_bf16(_pa, src[_d], o[_d], 0, 0, 0); } while (0)
            bf16x8 vfa[4], vfb[4];
            AT_VLD(vfa, 0);
            AT_VLD(vfb, 1); AT_PV(vfa, 0);
            AT_VLD(vfa, 2); AT_PV(vfb, 1);
            AT_VLD(vfb, 3); AT_PV(vfa, 2);
            AT_PV(vfb, 3);
#undef AT_VLD
#undef AT_PV
            if (more) { *(LAS v4u*)(L + sn + kdst0) = kr0; *(LAS v4u*)(L + sn + kdst1) = kr1; *(LAS v4u*)(L + sn + vdst0) = vr0; *(LAS v4u*)(L + sn + vdst1) = vr1; }
            __syncthreads();
        }
        lsum += __shfl_xor(lsum, 32);
        if (hi == 0) WSF[wid * 32 + r32] = lsum;
        LDS_WAIT();
        float rli[16];
#pragma unroll
        for (int rr = 0; rr < 16; ++rr) rli[rr] = 1.0f / WSF[wid * 32 + crow(rr, hi)];
        if (c == 1) {
#pragma unroll
            for (int d0 = 0; d0 < 4; ++d0)
#pragma unroll
                for (int rr = 0; rr < 16; ++rr) XB[(qblk * 32 + crow(rr, hi)) * 128 + 32 * d0 + r32] = o[d0][rr] * rli[rr] * lam;
        }
        __syncthreads();
        if (c == 0) {
            float ss[16];
#pragma unroll
            for (int rr = 0; rr < 16; ++rr) ss[rr] = 0.f;
#pragma unroll
            for (int d0 = 0; d0 < 4; ++d0)
#pragma unroll
                for (int rr = 0; rr < 16; ++rr) { const float df = o[d0][rr] * rli[rr] - XB[(qblk * 32 + crow(rr, hi)) * 128 + 32 * d0 + r32]; o[d0][rr] = df; ss[rr] += df * df; }
#pragma unroll
            for (int rr = 0; rr < 16; ++rr) { float s2 = ss[rr]; s2 += __shfl_xor(s2, 1); s2 += __shfl_xor(s2, 2); s2 += __shfl_xor(s2, 4); s2 += __shfl_xor(s2, 8); s2 += __shfl_xor(s2, 16);
                ss[rr] = 1.f / sqrtf(s2 * (1.f / 128.f) + EPS); }
#pragma unroll
            for (int d0 = 0; d0 < 4; ++d0)
#pragma unroll
                for (int rr = 0; rr < 16; ++rr)
                    BR[(rowb + q0 + 32 * qblk + crow(rr, hi)) * 2048 + 1024 + h * 128 + 32 * d0 + r32] = (bf16)f2bf_sw(o[d0][rr] * ss[rr] * dg[d0]);
        }
        __syncthreads();
    }
}

__device__ __forceinline__ void unpack8(const v4u w, float (&x)[8]) { x[0] = bflo(w.x); x[1] = bfhi(w.x); x[2] = bflo(w.y); x[3] = bfhi(w.y); x[4] = bflo(w.z); x[5] = bfhi(w.z); x[6] = bflo(w.w); x[7] = bfhi(w.w); }
struct EpiMergeF {
    static constexpr bool PERM = true, MIDK = true;
    unsigned char* ws;
    __device__ __forceinline__ void mid(f32x4 (&acc)[2][2][4][2], const pg8::Unit& u, int wr, int wc, int fr_, int fq_) const {
        int fr = fr_, fq = fq_; OPAQUE_V(fr); OPAQUE_V(fq);
        const bf16* GAp = (const bf16*)(ws + WS_GA); const bf16* GBp = (const bf16*)(ws + WS_GB);
        const int row0 = u.pm * 256 + wr * 64 + fr, col0 = u.pn * 256 + wc * 32 + 8 * fq;
#pragma unroll
        for (int ai = 0; ai < 2; ++ai)
#pragma unroll
            for (int m = 0; m < 4; ++m)
#pragma unroll
                for (int bj = 0; bj < 2; ++bj) {
                    const size_t off = (size_t)(row0 + ai * 128 + m * 16) * 2048 + col0 + bj * 128;
                    float ga[8], gb[8]; unpack8(*(const GAS v4u*)(GAp + off), ga); unpack8(*(const GAS v4u*)(GBp + off), gb);
#pragma unroll
                    for (int j = 0; j < 4; ++j) {
                        acc[ai][bj][m][0][j] *= (1.0f + __expf(-gb[j])) * __builtin_amdgcn_rcpf(1.0f + __expf(-ga[j]));
                        acc[ai][bj][m][1][j] *= (1.0f + __expf(-gb[4 + j])) * __builtin_amdgcn_rcpf(1.0f + __expf(-ga[4 + j])); }
                }
    }
    __device__ __forceinline__ void operator()(const f32x4 (&acc)[2][2][4][2], const pg8::Unit& u, int wr, int wc, int fr_, int fq_) const {
        int fr = fr_, fq = fq_; OPAQUE_V(fr); OPAQUE_V(fq);
        const bf16* GBp = (const bf16*)(ws + WS_GB); bf16* O = (bf16*)(ws + WS_MERGED);
        const int row0 = u.pm * 256 + wr * 64 + fr, col0 = u.pn * 256 + wc * 32 + 8 * fq;
#pragma unroll
        for (int ai = 0; ai < 2; ++ai)
#pragma unroll
            for (int m = 0; m < 4; ++m)
#pragma unroll
                for (int bj = 0; bj < 2; ++bj) {
                    const size_t off = (size_t)(row0 + ai * 128 + m * 16) * 2048 + col0 + bj * 128;
                    float gb[8], y[8]; unpack8(*(const GAS v4u*)(GBp + off), gb);
                    const f32x4 v0 = acc[ai][bj][m][0], v1 = acc[ai][bj][m][1];
#pragma unroll
                    for (int j = 0; j < 4; ++j) { y[j] = v0[j] * fsigmoid(gb[j]); y[4 + j] = v1[j] * fsigmoid(gb[4 + j]); }
                    v4u w; w.x = pk2(y[0], y[1]); w.y = pk2(y[2], y[3]); w.z = pk2(y[4], y[5]); w.w = pk2(y[6], y[7]);
                    *(GAS v4u*)(O + off) = w;
                }
    }
};
struct EpiOutProj {
    static constexpr bool PERM = true, MIDK = false;
    const float* x; bf16* x1b; const float* mod;
    __device__ __forceinline__ void operator()(const f32x4 (&acc)[2][2][4][2], const pg8::Unit& u, int wr, int wc, int fr_, int fq_) const {
        int fr = fr_, fq = fq_; OPAQUE_V(fr); OPAQUE_V(fq);
        const int row0 = u.pm * 256 + wr * 64 + fr, col0 = u.pn * 256 + wc * 32 + 8 * fq;
        const int b = (u.pm * 256) / SEQ;
#pragma unroll
        for (int ai = 0; ai < 2; ++ai)
#pragma unroll
            for (int m = 0; m < 4; ++m) { const size_t ro = (size_t)(row0 + ai * 128 + m * 16) * D + col0;
#pragma unroll
                for (int bj = 0; bj < 2; ++bj) {
                    const f32x4 x0 = *(const GAS f32x4*)(x + ro + bj * 128), x4 = *(const GAS f32x4*)(x + ro + bj * 128 + 4);
                    const f32x4 g0 = *(const GAS f32x4*)(mod + b * 12288 + 4096 + col0 + bj * 128), g4 = *(const GAS f32x4*)(mod + b * 12288 + 4096 + col0 + bj * 128 + 4);
                    const f32x4 y0 = x0 + g0 * acc[ai][bj][m][0], y1 = x4 + g4 * acc[ai][bj][m][1];
                    v4u w; w.x = pk2(y0[0], y0[1]); w.y = pk2(y0[2], y0[3]); w.z = pk2(y1[0], y1[1]); w.w = pk2(y1[2], y1[3]);
                    *(GAS v4u*)(x1b + ro + bj * 128) = w; } }
    }
};


constexpr int RT_XSLD = 2056;
constexpr int RT_XS = 0, RT_PART = 65792;
constexpr int RT_LCNT = 98560, RT_STOK = 98816, RT_SW = 107008;
constexpr int MOE_TB = MISC_OFF + 1024;
__device__ __forceinline__ void phase_router(Frame& F, const Args& a) {
    PHASE_IDS();
    LAS unsigned char* L = F.lds;
    LAS bf16* XS = (LAS bf16*)(L + RT_XS); LAS float* PART = (LAS float*)(L + RT_PART);
    const bf16* x1 = (const bf16*)(F.ws + WS_X1B); const float* mod = (const float*)(F.ctl + CW_MOD);
    unsigned char* H2 = F.ws + WS_H2;
    int* LTOK = (int*)(F.ws + WS_LTOK); float* LW = (float*)(F.ws + WS_LW);
    const float rbias = a.in[IN_RB][lane];
    if (tid < 64) ((LAS unsigned*)(L + RT_LCNT))[tid] = 0u;
    __syncthreads();
    int rounds = 0, round_row0 = 0;
    const bf16* RH = (const bf16*)(F.ws + WS_RWT_HI);
    const int r = lane & 15, g = lane >> 4;
    v2u xw0[8], xw1[8];
#define RT_LOADX(g_) do { const GAS v2u* xr_ = (const GAS v2u*)(x1 + (size_t)((g_) * 16 + 2 * wid) * D) + lane; \
        _Pragma("unroll") for (int j_ = 0; j_ < 8; ++j_) { xw0[j_] = xr_[64 * j_]; xw1[j_] = xr_[64 * j_ + 512]; } } while (0)
#define RT_LOADW(dst, ks_) do { _Pragma("unroll") for (int cb_ = 0; cb_ < 4; ++cb_) dst[cb_] = *(const GAS bf16x8*)(RH + (16 * cb_ + r) * D + 256 * wid + 32 * (ks_) + 8 * g); } while (0)
#define RT_STEP(src, ks_) do { const bf16x8 xf_ = *(const LAS bf16x8*)(XS + r * RT_XSLD + 256 * wid + 32 * (ks_) + 8 * g); \
        _Pragma("unroll") for (int cb_ = 0; cb_ < 4; ++cb_) acc[cb_] = __builtin_amdgcn_mfma_f32_16x16x32_bf16(xf_, src[cb_], acc[cb_], 0, 0, 0); } while (0)
#define RT_FENCE() asm volatile("" ::: "memory")
    const int RPW = (T / 16) / F.G, bq = (F.vcu * RPW * 16) / SEQ;
    f32x4 ga[8], sh[8];
#pragma unroll
    for (int j = 0; j < 8; ++j) { const int d = 4 * lane + 256 * j;
        const f32x4 gg = *(const f32x4*)(a.in[IN_N2G] + d), sc = *(const GAS f32x4*)(mod + bq * 12288 + 8192 + d); sh[j] = *(const GAS f32x4*)(mod + bq * 12288 + 6144 + d); ga[j] = gg * (sc + 1.0f); }
    RT_LOADX(F.vcu * RPW);
    for (int gi = 0; gi < RPW; ++gi) {
        const int grp = F.vcu * RPW + gi;
        if (rounds == 0) round_row0 = grp * 16;
#pragma unroll
        for (int rr2 = 0; rr2 < 2; ++rr2) {
            const int rloc = 2 * wid + rr2, m = grp * 16 + rloc;
            f32x4 v[8]; float s = 0.f;
#pragma unroll
            for (int j = 0; j < 8; ++j) { const v2u w = rr2 ? xw1[j] : xw0[j]; v[j] = (f32x4){bflo(w.x), bfhi(w.x), bflo(w.y), bfhi(w.y)}; s += (v[j].x * v[j].x + v[j].y * v[j].y) + (v[j].z * v[j].z + v[j].w * v[j].w); }
            const float rstd = 1.f / sqrtf(wave_sum(s) * (1.f / D) + EPS);
            GAS unsigned* o8 = (GAS unsigned*)(H2 + (size_t)m * D) + lane;
#pragma unroll
            for (int j = 0; j < 8; ++j) {
                const int d = 4 * lane + 256 * j;
                const f32x4 y = v[j] * rstd * ga[j] + sh[j];
                o8[64 * j] = pk4_fp8(y.x, y.y, y.z, y.w);
                v2u xb; xb.x = pk2(y.x, y.y); xb.y = pk2(y.z, y.w);
                *(LAS v2u*)(XS + rloc * RT_XSLD + d) = xb;
            }
        }
        {
            f32x4 acc[4];
#pragma unroll
            for (int cb = 0; cb < 4; ++cb) acc[cb] = (f32x4){0.f, 0.f, 0.f, 0.f};
            bf16x8 w0[4], w1[4], w2[4], w3[4];
            RT_LOADW(w0, 0); RT_LOADW(w1, 1); RT_LOADW(w2, 2); RT_LOADW(w3, 3);
            RT_FENCE();
            __syncthreads();
            RT_STEP(w0, 0); RT_LOADW(w0, 4); RT_FENCE();
            RT_STEP(w1, 1); RT_LOADW(w1, 5); RT_FENCE();
            RT_STEP(w2, 2); RT_LOADW(w2, 6); RT_FENCE();
            RT_STEP(w3, 3); RT_LOADW(w3, 7); RT_FENCE();
            if (gi + 1 < RPW) RT_LOADX(grp + 1);
            RT_FENCE();
            RT_STEP(w0, 4); RT_STEP(w1, 5); RT_STEP(w2, 6); RT_STEP(w3, 7);
#pragma unroll
            for (int cb = 0; cb < 4; ++cb)
#pragma unroll
                for (int rg = 0; rg < 4; ++rg) PART[(wid * 16 + 4 * g + rg) * 64 + 16 * cb + r] = acc[cb][rg];
        }
        __syncthreads();
#pragma unroll
        for (int rr2 = 0; rr2 < 2; ++rr2) {
            const int rloc = 2 * wid + rr2, m = grp * 16 + rloc;
            float logit = 0.f;
#pragma unroll
            for (int w2 = 0; w2 < 8; ++w2) logit += PART[(w2 * 16 + rloc) * 64 + lane];
            const float score = 1.0f / (1.0f + expf(-logit)), sel = score + rbias;
            const int eg = lane >> 3;
            float m1 = sel; m1 = fmaxf(m1, __shfl_xor(m1, 1)); m1 = fmaxf(m1, __shfl_xor(m1, 2)); m1 = fmaxf(m1, __shfl_xor(m1, 4));
            const unsigned long long bm = __ballot(sel == m1);
            const int first = __builtin_ctz((unsigned)((bm >> (8 * eg)) & 0xffull)) + 8 * eg;
            float m2 = (lane == first) ? -INFINITY : sel; m2 = fmaxf(m2, __shfl_xor(m2, 1)); m2 = fmaxf(m2, __shfl_xor(m2, 2)); m2 = fmaxf(m2, __shfl_xor(m2, 4));
            const float gs = m1 + m2;
            int grank = 0;
#pragma unroll
            for (int g2 = 0; g2 < 8; ++g2) { const float o = __shfl(gs, 8 * g2); grank += (o > gs || (o == gs && g2 < eg)) ? 1 : 0; }
            const float masked = grank < 4 ? sel : -INFINITY;
            int rank = 0;
#pragma unroll 8
            for (int e2 = 0; e2 < 64; ++e2) { const float o = __shfl(masked, e2); rank += (o > masked || (o == masked && e2 < lane)) ? 1 : 0; }
            const bool selected = rank < 8;
            const float ssum = wave_sum(selected ? score : 0.f);
            if (selected) {
                const unsigned pos = __hip_atomic_fetch_add((LAS unsigned*)(L + RT_LCNT) + lane, 1u, __ATOMIC_RELAXED, __HIP_MEMORY_SCOPE_WORKGROUP);
                ((LAS unsigned short*)(L + RT_STOK))[lane * 64 + pos] = (unsigned short)((rounds * 16 + rloc) * 8 + rank); ((LAS float*)(L + RT_SW))[lane * 64 + pos] = score / ssum * 2.5f;
            }
        }
        __syncthreads();
        ++rounds;
        if (rounds == 4 || gi + 1 == RPW) {
            const int e = tid >> 3, sub = tid & 7;
            const unsigned n = ((LAS unsigned*)(L + RT_LCNT))[e];
            unsigned base = 0u;
            if (sub == 0 && n) base = atomicAdd(F.ctl + CW_CNT + 64 * e, n);
            base = __shfl(base, lane & ~7);
            for (unsigned i = sub; i < n; i += 8) { const int sv = (int)((LAS unsigned short*)(L + RT_STOK))[e * 64 + i]; LTOK[e * 16384 + base + i] = (round_row0 + (sv >> 7) * 16 + ((sv >> 3) & 15)) * 8 + (sv & 7); LW[e * 16384 + base + i] = ((LAS float*)(L + RT_SW))[e * 64 + i]; }
            __syncthreads();
            if (tid < 64) ((LAS unsigned*)(L + RT_LCNT))[tid] = 0u;
            rounds = 0;
            __syncthreads();
        }
    }
}
#undef RT_LOADX
#undef RT_LOADW
#undef RT_STEP
#undef RT_FENCE
__device__ __forceinline__ void moe_build_table(Frame& F) {
    PHASE_IDS();
    LAS int* tb = (LAS int*)(F.lds + MOE_TB); LAS int* cn = tb + 68; LAS int* ab = cn + 68;
    if (tid == 0) {
        int t = 0, r = 0;
        for (int e = 0; e < NEXP; ++e) { const int c = (int)__hip_atomic_load(F.ctl + CW_CNT + 64 * e, RLX_AGENT); tb[e] = t; cn[e] = c; ab[e] = r; t += (c + 255) >> 8; r += c; }
        tb[64] = t; cn[64] = T; ab[64] = r;
    }
    __syncthreads();
}
template <int NP>
struct MoeOrder {
    LAS int* tb; int G, c;
    __device__ bool next(int i, pg8::Unit& u) const {
        const int ntr = tb[64]; const long L = (long)i * G + c;
        if (L >= (long)(64 + ntr) * NP) return false;
        int tt = (int)(L / NP); u.pn = (int)(L % NP);
        if (tt < 64) { u.e = 64; u.pm = tt; u.cnt = 256; return true; }
        tt -= 64;
        int lo = 0, hi = 64;
        while (hi - lo > 1) { const int mid = (lo + hi) >> 1; if (tb[mid] <= tt) lo = mid; else hi = mid; }
        u.e = lo; u.pm = tt - tb[lo]; const int rem = tb[68 + lo] - 256 * u.pm; u.cnt = rem < 256 ? rem : 256; return true;
    }
};
struct MoeGemm1 : MoeOrder<4> {
    static constexpr bool GATHER = true;
    unsigned char* ws; unsigned lda2, ldb2; int nt;
    __device__ __forceinline__ const char* aptr(const pg8::Unit&) const { return (const char*)(ws + WS_H2); }
    __device__ __forceinline__ void aoffs(const pg8::Unit& u, int tid, unsigned (&o)[2][2]) const {
        const int* LTOK = (const int*)(ws + WS_LTOK);
        OPAQUE_V(tid);
        int R0, C0, R1, C1; pg8::stage_rc(tid * 16, R0, C0); pg8::stage_rc(tid * 16 + 8192, R1, C1);
#pragma unroll
        for (int h = 0; h < 2; ++h) {
            const int p0 = h * 128 + R0, p1 = h * 128 + R1; int t0, t1;
            if (u.e == 64) { t0 = u.pm * 256 + p0; t1 = u.pm * 256 + p1; }
            else { t0 = p0 < u.cnt ? (LTOK[u.e * 16384 + u.pm * 256 + p0] >> 3) : 0; t1 = p1 < u.cnt ? (LTOK[u.e * 16384 + u.pm * 256 + p1] >> 3) : 0; }
            o[h][0] = (unsigned)t0 * 2048u + (unsigned)C0 * 2u; o[h][1] = (unsigned)t1 * 2048u + (unsigned)C1 * 2u;
        }
    }
    __device__ __forceinline__ void bptrs(const pg8::Unit& u, const char*& b0, const char*& b1) const {
        const char* g = (u.e == 64) ? (const char*)(ws + WS_WSH) : (const char*)(ws + WS_WG) + (size_t)u.e * DEXP * D;
        const char* up = (u.e == 64) ? (const char*)(ws + WS_WSH + 2 * MiB) : (const char*)(ws + WS_WU) + (size_t)u.e * DEXP * D;
        b0 = g + (size_t)(u.pn * 128) * 2048; b1 = up + (size_t)(u.pn * 128) * 2048;
    }
};
struct EpiSwiglu {
    static constexpr bool PERM = true, MIDK = false;
    unsigned char* ws; LAS int* tb;
    __device__ __forceinline__ void operator()(const f32x4 (&acc)[2][2][4][2], const pg8::Unit& u, int wr, int wc, int fr_, int fq_) const {
        int fr = fr_, fq = fq_; OPAQUE_V(fr); OPAQUE_V(fq);
        unsigned char* ACT = ws + WS_ACT;
        const int rbase = tb[136 + u.e] + u.pm * 256, col0 = u.pn * 128 + wc * 32 + 8 * fq;
#pragma unroll
        for (int ai = 0; ai < 2; ++ai)
#pragma unroll
            for (int m = 0; m < 4; ++m) {
                const int rt = ai * 128 + wr * 64 + m * 16 + fr;
                if (rt < u.cnt) {
                    float y[8];
#pragma unroll
                    for (int n = 0; n < 2; ++n)
#pragma unroll
                        for (int j = 0; j < 4; ++j) { const float gt = acc[ai][0][m][n][j], upv = acc[ai][1][m][n][j]; y[4 * n + j] = fminf(fmaxf(gt * fsigmoid(gt) * upv, -448.f), 448.f); }
                    v2u w; w.x = pk4_fp8(y[0], y[1], y[2], y[3]); w.y = pk4_fp8(y[4], y[5], y[6], y[7]);
                    *(GAS v2u*)(ACT + (size_t)(rbase + rt) * DEXP + col0) = w;
                }
            }
    }
};
struct MoeGemm2 : MoeOrder<8> {
    static constexpr bool GATHER = false;
    unsigned char* ws; unsigned lda2, ldb2; int nt;
    __device__ __forceinline__ const char* aptr(const pg8::Unit& u) const { return (const char*)(ws + WS_ACT) + (size_t)(tb[136 + u.e] + u.pm * 256) * 512; }
    __device__ __forceinline__ void aoffs(const pg8::Unit&, int, unsigned (&)[2][2]) const {}
    __device__ __forceinline__ void bptrs(const pg8::Unit& u, const char*& b0, const char*& b1) const {
        const char* dn = (u.e == 64) ? (const char*)(ws + WS_WSH + 4 * MiB) : (const char*)(ws + WS_WDOWN) + (size_t)u.e * D * DEXP;
        b0 = dn + (size_t)(u.pn * 256) * 512; b1 = b0 + (size_t)128 * 512;
    }
};
struct EpiDown {
    static constexpr bool PERM = true, MIDK = false;
    unsigned char* ws; float* out; const float* mod;
    __device__ __forceinline__ void operator()(const f32x4 (&acc)[2][2][4][2], const pg8::Unit& u, int wr, int wc, int fr_, int fq_) const {
        int fr = fr_, fq = fq_; OPAQUE_V(fr); OPAQUE_V(fq);
        const int* LTOK = (const int*)(ws + WS_LTOK); const float* LW = (const float*)(ws + WS_LW); unsigned char* Y = ws + WS_Y;
        const int col0 = u.pn * 256 + wc * 32 + 8 * fq;
#pragma unroll
        for (int ai = 0; ai < 2; ++ai)
#pragma unroll
            for (int m = 0; m < 4; ++m) {
                const int rt = ai * 128 + wr * 64 + m * 16 + fr;
                if (rt < u.cnt) {
                    if (u.e == 64) {
                        const int t = u.pm * 256 + rt; bf16* YSH = (bf16*)(ws + WS_YSH);
#pragma unroll
                        for (int bj = 0; bj < 2; ++bj) { const f32x4 v0 = acc[ai][bj][m][0], v1 = acc[ai][bj][m][1];
                            v4u pw; pw.x = pk2(v0[0], v0[1]); pw.y = pk2(v0[2], v0[3]); pw.z = pk2(v1[0], v1[1]); pw.w = pk2(v1[2], v1[3]);
                            *(GAS v4u*)(YSH + (size_t)t * D + col0 + bj * 128) = pw; }
                    } else {
                        const int pos = u.e * 16384 + u.pm * 256 + rt; const int tk = LTOK[pos]; const float w = LW[pos] * Y8_SCALE;
#pragma unroll
                        for (int bj = 0; bj < 2; ++bj) { f32x4 v0 = acc[ai][bj][m][0] * w, v1 = acc[ai][bj][m][1] * w;
#pragma unroll
                            for (int j = 0; j < 4; ++j) { v0[j] = fminf(fmaxf(v0[j], -448.f), 448.f); v1[j] = fminf(fmaxf(v1[j], -448.f), 448.f); }
                            v2u pw; pw.x = pk4_fp8(v0[0], v0[1], v0[2], v0[3]); pw.y = pk4_fp8(v1[0], v1[1], v1[2], v1[3]);
                            *(GAS v2u*)(Y + (size_t)tk * D + col0 + bj * 128) = pw; }
                    }
                }
            }
    }
};
__device__ __forceinline__ void phase_combine(Frame& F, const Args& a) {
    PHASE_IDS();
    const unsigned char* Y = F.ws + WS_Y; const float* mod = (const float*)(F.ctl + CW_MOD); float* out = a.out;
    const int NIT = T * (D / 8);
    const bool bad = xb_ld(F.ctl + CW_BAR + XB_TMO) != 0u;
    for (int it = F.vcu * NTHREADS + tid; it < NIT; it += F.G * NTHREADS) {
        const int t = it >> 8, c8 = (it & 255) * 8, b = t / SEQ;
        float s[8];
#pragma unroll
        for (int j = 0; j < 8; ++j) s[j] = 0.f;
#pragma unroll
        for (int k = 0; k < 8; ++k) { const v2u w = *(const GAS v2u*)(Y + ((size_t)t * 8 + k) * D + c8);
            const auto f0 = __builtin_amdgcn_cvt_pk_f32_fp8((int)w.x, false), f1 = __builtin_amdgcn_cvt_pk_f32_fp8((int)w.x, true), f2 = __builtin_amdgcn_cvt_pk_f32_fp8((int)w.y, false), f3 = __builtin_amdgcn_cvt_pk_f32_fp8((int)w.y, true);
            s[0] += f0[0]; s[1] += f0[1]; s[2] += f1[0]; s[3] += f1[1]; s[4] += f2[0]; s[5] += f2[1]; s[6] += f3[0]; s[7] += f3[1]; }
#pragma unroll
        for (int j = 0; j < 8; ++j) s[j] *= (1.0f / Y8_SCALE);
        const f32x4 g0 = *(const GAS f32x4*)(mod + b * 12288 + 10240 + c8), g1 = *(const GAS f32x4*)(mod + b * 12288 + 10240 + c8 + 4);
        GAS f32x4* o = (GAS f32x4*)(out + (size_t)t * D + c8);
        float xv[8], sh[8]; unpack8(*(const GAS v4u*)((const bf16*)(F.ws + WS_X1B) + (size_t)t * D + c8), xv); unpack8(*(const GAS v4u*)((const bf16*)(F.ws + WS_YSH) + (size_t)t * D + c8), sh);
#pragma unroll
        for (int j = 0; j < 8; ++j) s[j] += sh[j];
        const f32x4 o0 = (f32x4){xv[0], xv[1], xv[2], xv[3]}, o1 = (f32x4){xv[4], xv[5], xv[6], xv[7]};
        f32x4 r0 = o0 + g0 * (f32x4){s[0], s[1], s[2], s[3]}; const f32x4 r1 = o1 + g1 * (f32x4){s[4], s[5], s[6], s[7]};
        if (bad) r0.x = __builtin_nanf("");
        o[0] = r0; o[1] = r1;
    }
}

__global__ void __launch_bounds__(NTHREADS, 2) fwd_kernel(Args args) {
    extern __shared__ __attribute__((aligned(16))) unsigned char lds[];
    Frame F;
    F.lds = (LAS unsigned char*)lds;
    F.MISC = (volatile LAS unsigned*)(F.lds + MISC_OFF);
    F.tid = threadIdx.x; F.lane = F.tid & 63; F.wave = __builtin_amdgcn_readfirstlane(F.tid >> 6);
    F.G = gridDim.x; { const int bx = blockIdx.x; F.vcu = (F.G % 8 == 0) ? (bx % 8) * (F.G / 8) + bx / 8 : bx; }
    F.ws = args.ws; F.ctl = (unsigned*)(args.ws + WS_CTL); F.vec = (float*)(args.ws + WS_VEC);
    for (int u = F.tid; u < 256; u += NTHREADS) ((LAS unsigned*)(F.lds + MISC_OFF))[u] = 0u;
    __syncthreads();
    XcdBarrier bar = xcd_barrier_post(F.ctl + CW_BAR, F.MISC + 8);
    unsigned char* ws = args.ws;

#define PH_MOD()   do { phase_mod(F, args); } while (0)
#define PH_PREP1() do { phase_prep1(F, args); } while (0)
#define PH_HROWS() do { phase_hrows(F, args); } while (0)
#define PH_INPROJ() do { { DenseGemm g; g.init(T, 6144, F.G, (int)blockIdx.x); g.A = (const char*)(ws + WS_H); g.Bt = (const char*)(ws + WS_WIN); g.lda2 = D * 2; g.ldb2 = D * 2; g.nt = D / 64; \
          EpiInProj<0> E{ws}; pg8::gemm_phase<DenseGemm, EpiInProj<0>>(F.lds, g, E); } \
        { DenseGemm g; g.init(T, 5120, F.G, (int)blockIdx.x); g.A = (const char*)(ws + WS_H8); g.Bt = (const char*)(ws + WS_WIN8); g.lda2 = D; g.ldb2 = D; g.nt = D / 128; \
          EpiInProj<1> E{ws}; pg8::gemm_phase<DenseGemm, EpiInProj<1>, true>(F.lds, g, E); } } while (0)
#define PH_H1()    do { phase_h1(F); } while (0)
#define PH_QKP()   do { phase_qkprep(F, args); } while (0)
#define PH_H2()    do { phase_h2(F); } while (0)
#define PH_H3()    do { phase_h3(F, args); } while (0)
#define PH_ATTN()  do { phase_attn(F, args, 0, 4); } while (0)
#define PH_MERGE() do { DenseGemm g; g.init(T, D, F.G, (int)blockIdx.x); g.A = (const char*)(ws + WS_BR); g.Bt = (const char*)(ws + WS_WA); g.lda2 = D * 2; g.ldb2 = D * 2; g.nt = D / 64; \
        EpiMergeF E{ws}; pg8::gemm_phase<DenseGemm, EpiMergeF>(F.lds, g, E); } while (0)
#define PH_OUTPROJ() do { DenseGemm g; g.init(T, D, F.G, (int)blockIdx.x); g.A = (const char*)(ws + WS_MERGED); g.Bt = (const char*)(ws + WS_WOUT); g.lda2 = D * 2; g.ldb2 = D * 2; g.nt = D / 64; \
        EpiOutProj E{args.in[IN_X], (bf16*)(ws + WS_X1B), (const float*)(F.ctl + CW_MOD)}; pg8::gemm_phase<DenseGemm, EpiOutProj>(F.lds, g, E); } while (0)
#define PH_ROUTER() do { phase_router(F, args); } while (0)
#define PH_CONVX()  do { phase_convert_experts(F, args); } while (0)
#define PH_MOE1()  do { MoeGemm1 g; g.tb = (LAS int*)(F.lds + MOE_TB); g.G = F.G; g.c = F.vcu; g.ws = ws; g.lda2 = D; g.ldb2 = D; g.nt = D / 128; \
        EpiSwiglu E{ws, (LAS int*)(F.lds + MOE_TB)}; pg8::gemm_phase<MoeGemm1, EpiSwiglu, true>(F.lds, g, E); } while (0)
#define PH_MOE2()  do { MoeGemm2 g; g.tb = (LAS int*)(F.lds + MOE_TB); g.G = F.G; g.c = F.vcu; g.ws = ws; g.lda2 = DEXP; g.ldb2 = DEXP; g.nt = DEXP / 128; \
        EpiDown E{ws, args.out, (const float*)(F.ctl + CW_MOD)}; pg8::gemm_phase<MoeGemm2, EpiDown, true>(F.lds, g, E); } while (0)
#define PH_COMBINE() do { phase_combine(F, args); } while (0)
#ifndef REPEAT_PHASE
#define REPEAT_PHASE -1
#endif
#define RUN(k, X) do { X; if (REPEAT_PHASE == (k)) { xcd_barrier(bar); X; } } while (0)
    if (F.vcu & 1) { PH_PREP1(); __syncthreads(); PH_MOD(); } else { PH_MOD(); __syncthreads(); PH_PREP1(); }
    xcd_barrier(bar);
    RUN(1, PH_HROWS());    xcd_barrier(bar);
    RUN(2, PH_INPROJ());   xcd_barrier(bar);
    if (F.vcu & 1) { PH_QKP(); PH_H1(); } else { PH_H1(); PH_QKP(); }
    xcd_barrier(bar);
    PH_H2();
    xcd_barrier(bar);
    PH_H3(); phase_attn(F, args, 0, 4);
    xcd_barrier(bar);
    RUN(8, PH_MERGE());    xcd_barrier(bar);
    RUN(9, PH_OUTPROJ());  xcd_barrier(bar);
    PH_ROUTER();           xcd_barrier(bar);
    moe_build_table(F);
    RUN(11, PH_MOE1());    xcd_barrier(bar);
    PH_MOE2();             xcd_barrier(bar);
    PH_COMBINE();
}

extern "C" void kernel_launch(void* const* d_in, const int* in_sizes, int n_in, void* d_out, int out_size, void* d_ws, size_t ws_size, hipStream_t stream) {
    static int grid = 0;
    if (grid == 0) {
        int dev = 0, cus = 0;
        if (n_in != 28 || ws_size < WS_NEED || out_size != T * D) { fprintf(stderr, "kernel_launch: unexpected n_in %d / ws %zu / out %d\n", n_in, ws_size, out_size); grid = -1; return; }
        if (hipGetDevice(&dev) != hipSuccess || hipDeviceGetAttribute(&cus, hipDeviceAttributeMultiprocessorCount, dev) != hipSuccess) { grid = -1; return; }
        if (hipFuncSetAttribute((const void*)fwd_kernel, hipFuncAttributeMaxDynamicSharedMemorySize, LDS_BYTES) != hipSuccess) { grid = -1; return; }
        int per_cu = 0;
        (void)hipOccupancyMaxActiveBlocksPerMultiprocessor(&per_cu, (const void*)fwd_kernel, NTHREADS, LDS_BYTES);
        (void)hipGetLastError();
        grid = cus;
        if (cus != 256) { fprintf(stderr, "kernel_launch: built for a 256-CU MI355X (static work split), found %d CUs; nothing launched\n", cus); grid = -1; return; }
    }
    if (grid < 0) return;
    if (hipMemsetAsync((char*)d_ws + WS_CTL, 0, CTL_ZERO_BYTES, stream) != hipSuccess) return;
    Args a{};
    for (int i = 0; i < 28; ++i) a.in[i] = (const float*)d_in[i];
    a.out = (float*)d_out; a.ws = (unsigned char*)d_ws; a.ph_lo = 0; a.ph_hi = 100;
    hipLaunchKernelGGL(fwd_kernel, dim3(grid), dim3(NTHREADS), LDS_BYTES, stream, a);
}
```

```cpp
#include <hip/hip_runtime.h>
#include <cstdio>
#include <cstdint>

#define GAS __attribute__((address_space(1)))
#define LAS __attribute__((address_space(3)))
typedef unsigned short bf16;
typedef unsigned v4u __attribute__((ext_vector_type(4)));
typedef unsigned v2u __attribute__((ext_vector_type(2)));
typedef float f32x4 __attribute__((ext_vector_type(4)));
typedef float f32x2 __attribute__((ext_vector_type(2)));
typedef float f32x16 __attribute__((ext_vector_type(16)));
typedef short bf16x8 __attribute__((ext_vector_type(8)));
typedef short s16x4 __attribute__((ext_vector_type(4)));
typedef int i32x4 __attribute__((ext_vector_type(4)));
typedef int i32x8 __attribute__((ext_vector_type(8)));

#ifndef STAGE_MAX
#define STAGE_MAX 99
#endif

constexpr int D = 2048, BATCH = 4, SEQ = 4096, T = BATCH * SEQ;
constexpr int HGH = 8, HGD = 128, CHUNK = 64, NCHUNK = SEQ / CHUNK;
constexpr int NCH_UNITS = BATCH * HGH * NCHUNK;
constexpr int DAH = 8, DADH = 64, DADV = 128;
constexpr int INCOLS = 11264;
constexpr int NEXP = 64, TOPK = 8, DEXP = 512;
constexpr float EPS = 1e-6f;
constexpr float LOG2E = 1.4426950408889634f;
constexpr float LAMBDA_INIT = 0.2f;
constexpr int NWAVES = 8, NTHREADS = NWAVES * 64;
constexpr int LDS_BYTES = 147456;
constexpr int MISC_OFF = 131072;

constexpr size_t MiB = 1u << 20;
constexpr size_t WS_CTL = 0, CTL_ZERO_BYTES = 1 * MiB;
constexpr size_t WS_VEC = 1 * MiB;
constexpr size_t WS_LTOK = 2 * MiB, WS_LW = 6 * MiB;
constexpr size_t WS_WSH = 10 * MiB;
constexpr size_t WS_WIN = 16 * MiB;
constexpr size_t WS_WIN8 = 40 * MiB;
constexpr size_t WS_H8 = 848 * MiB;
constexpr size_t WS_WA = 60 * MiB, WS_WB = 64 * MiB;
constexpr size_t WS_WOUT = 68 * MiB;
constexpr size_t WS_H = 76 * MiB;
constexpr size_t WS_PROJ = 140 * MiB;
constexpr size_t WS_HQ = WS_PROJ, WS_HF = WS_PROJ + 32 * MiB, WS_HI = WS_PROJ + 64 * MiB, WS_HG = WS_PROJ + 96 * MiB;
constexpr size_t WS_DQ = WS_PROJ + 128 * MiB, WS_DK = WS_PROJ + 160 * MiB, WS_DV = WS_PROJ + 192 * MiB;
constexpr size_t WS_GA = WS_PROJ + 224 * MiB, WS_GB = WS_PROJ + 288 * MiB;
constexpr size_t WS_ST = 492 * MiB;
constexpr size_t WS_DEC = 556 * MiB;
constexpr size_t WS_OI = 560 * MiB;
constexpr size_t WS_BR = 624 * MiB;
constexpr size_t WS_MERGED = 688 * MiB;
constexpr size_t WS_QT = 752 * MiB;
constexpr size_t WS_DQN = 784 * MiB, WS_DKN = 816 * MiB;
constexpr size_t WS_WDOWN = 882 * MiB;
constexpr size_t WS_ACT = 144 * MiB;
constexpr size_t WS_WG = 946 * MiB, WS_WU = 1010 * MiB;
constexpr size_t WS_H2 = 546 * MiB;
constexpr size_t WS_Y = 290 * MiB;
constexpr float Y8_SCALE = 32.0f;
constexpr size_t WS_X1B = WS_H;
constexpr size_t WS_YSH = WS_BR;
constexpr size_t WS_NEED = 1074 * MiB;

constexpr int CW_BAR = 4096;
constexpr int CW_CNT = 8192;
constexpr int CW_MOD = 16384;
constexpr int VW_LB = 0;
constexpr int VW_LAM = 1024, VW_M2 = 1025;
constexpr int VW_TBL = 2048;
constexpr size_t WS_RWT_HI = WS_VEC + 65536, WS_RWT_LO = WS_VEC + 65536 + 262144;

#define RLX_AGENT __ATOMIC_RELAXED, __HIP_MEMORY_SCOPE_AGENT
#define LDS_WAIT() asm volatile("s_waitcnt lgkmcnt(0)" ::: "memory")
#define VM_WAIT() asm volatile("s_waitcnt vmcnt(0)" ::: "memory")
__device__ __forceinline__ unsigned f2bf_sw(float f) { unsigned u = __builtin_bit_cast(unsigned, f); return (u + 0x7fffu + ((u >> 16) & 1u)) >> 16; }
typedef __bf16 bf16x2v __attribute__((ext_vector_type(2)));
__device__ __forceinline__ unsigned pk2(float lo, float hi) { const f32x2 v = {lo, hi}; return __builtin_bit_cast(unsigned, __builtin_convertvector(v, bf16x2v)); }
__device__ __forceinline__ unsigned f2bf(float f) { return (unsigned)__builtin_bit_cast(unsigned short, (__bf16)f); }
__device__ __forceinline__ float bf2f(unsigned b) { return __builtin_bit_cast(float, b << 16); }
__device__ __forceinline__ float bflo(unsigned w) { return __builtin_bit_cast(float, w << 16); }
__device__ __forceinline__ float bfhi(unsigned w) { return __builtin_bit_cast(float, w & 0xffff0000u); }
__device__ __forceinline__ float fsigmoid(float x) { return __builtin_amdgcn_rcpf(1.0f + __expf(-x)); }
__device__ __forceinline__ float wave_sum(float v) {
#pragma unroll
    for (int o = 1; o < 64; o <<= 1) v += __shfl_xor(v, o);
    return v;
}

#define XB_TMO      128
#define XB_XCNT(j)  (256  + 64 * (j))
#define XB_XSUB(j)  (1280 + 64 * (j))
#define XB_XGEN(j)  (2304 + 64 * (j))
#define XB_TOP      3328
#define XB_TOPGEN   3392
#define XCD_BAR_WORDS 3456
#define XB_SPIN_CAP (1u << 18)
__device__ __forceinline__ unsigned xb_ld(unsigned* p)              { return __hip_atomic_load(p, __ATOMIC_RELAXED, __HIP_MEMORY_SCOPE_AGENT); }
__device__ __forceinline__ unsigned xb_add(unsigned* p, unsigned v) { return __hip_atomic_fetch_add(p, v, __ATOMIC_RELAXED, __HIP_MEMORY_SCOPE_AGENT); }
__device__ __forceinline__ unsigned xb_xcc_id() { return (unsigned)__builtin_amdgcn_s_getreg((3 << 11) | 20) & 0xFu; }
#define XB_SPIN(cond, bar) do { unsigned _sp = 0; while (cond) { __builtin_amdgcn_s_sleep(1); \
    if ((++_sp & 255u) == 0u) { if (xb_ld(&(bar)[XB_TMO])) break; if (_sp > XB_SPIN_CAP) { atomicAdd(&(bar)[XB_TMO], 1u); break; } } } } while (0)
struct XcdBarrier { unsigned* bar; unsigned x; volatile LAS unsigned* st; };
__device__ __forceinline__ XcdBarrier xcd_barrier_post(unsigned* bar, volatile LAS unsigned* st) {
    XcdBarrier b; b.bar = bar; b.x = xb_xcc_id(); b.st = st;
    if (threadIdx.x == 0) (void)xb_add(&bar[XB_XCNT(b.x)], 1u);
    return b;
}
__device__ __forceinline__ void xcd_barrier_complete(unsigned* bar, unsigned x, unsigned& nloc, unsigned& nx) {
    const unsigned G = gridDim.x * gridDim.y * gridDim.z;
    unsigned sum, cnt, mine, sp = 0u;
    for (;;) {
        sum = 0u; cnt = 0u; mine = 0u;
#pragma unroll
        for (unsigned j = 0; j < 16; ++j) { const unsigned c = xb_ld(&bar[XB_XCNT(j)]); sum += c; cnt += (c > 0u) ? 1u : 0u; mine = (j == x) ? c : mine; }
        if (sum == G) break;
        __builtin_amdgcn_s_sleep(1);
        if ((++sp & 255u) == 0u) { if (xb_ld(&bar[XB_TMO])) break; if (sp > XB_SPIN_CAP) { atomicAdd(&bar[XB_TMO], 1u); break; } }
    }
    nloc = mine > 0u ? mine : 1u; nx = cnt > 0u ? cnt : 1u;
}
__device__ __forceinline__ void xcd_barrier(const XcdBarrier& b) {
    asm volatile("s_waitcnt vmcnt(0)" ::: "memory");
    __syncthreads();
    if (threadIdx.x == 0) {
        unsigned* bar = b.bar;
        __builtin_amdgcn_s_waitcnt(0);
        unsigned nloc = b.st[0], nx = b.st[1];
        if (nloc == 0u) { xcd_barrier_complete(bar, b.x, nloc, nx); b.st[0] = nloc; b.st[1] = nx; }
        const unsigned old = xb_add(&bar[XB_XSUB(b.x)], 1u);
        const unsigned gen = old / nloc;
        if (old + 1u == (gen + 1u) * nloc) {
            __builtin_amdgcn_fence(__ATOMIC_RELEASE, "agent");
            asm volatile("s_waitcnt vmcnt(0)" ::: "memory");
            const unsigned og = xb_add(&bar[XB_TOP], 1u);
            const unsigned tg = og / nx;
            if (og + 1u == (tg + 1u) * nx) xb_add(&bar[XB_TOPGEN], 1u);
            else XB_SPIN(xb_ld(&bar[XB_TOPGEN]) == tg, bar);
            __builtin_amdgcn_fence(__ATOMIC_ACQUIRE, "agent");
            xb_add(&bar[XB_XGEN(b.x)], 1u);
            asm volatile("s_waitcnt vmcnt(0)" ::: "memory");
        } else {
            XB_SPIN(xb_ld(&bar[XB_XGEN(b.x)]) == gen, bar);
            __builtin_amdgcn_fence(__ATOMIC_ACQUIRE, "agent");
            asm volatile("s_waitcnt vmcnt(0)" ::: "memory");
        }
    }
    __syncthreads();
}

namespace pg8 {
constexpr int BM = 256, BK = 64, HALF = 128, HTB = HALF * BK * 2, STAGE_BYTES = 8 * HTB, NXCD = 8, WGM = 8;
__host__ __device__ __forceinline__ int lds_byte(int r, int c) { const int st = (r >> 4) * 2 + (c >> 5), rr = r & 15, cc = c & 31, ob = rr * 64 + cc * 2; return st * 1024 + (ob ^ (((ob >> 9) & 1) << 5)); }
__host__ __device__ __forceinline__ void stage_rc(int b, int& R, int& C) { const int st = b / 1024, sb = b % 1024, swz = sb ^ (((sb >> 9) & 1) << 5); R = (st >> 1) * 16 + swz / 64; C = (st & 1) * 32 + (swz % 64) / 2; }
__host__ __device__ __forceinline__ int perm32(int rho) { const int n = rho >> 4, i = rho & 15; return 8 * (i >> 2) + 4 * n + (i & 3); }
__device__ __forceinline__ unsigned cvt_pk_bf16(float lo, float hi) { unsigned r; asm volatile("v_cvt_pk_bf16_f32 %0, %1, %2" : "=v"(r) : "v"(lo), "v"(hi)); return r; }

struct Unit { int pm, pn, e, cnt; };

struct DenseOrder {
    int nM, nN, nwg, G, c;
    __device__ void init(int M, int N, int G_, int c_) { nM = M / BM; nN = N / BM; nwg = nM * nN; G = G_; c = c_; }
    __device__ bool next(int i, Unit& u) const {
        const long L = (long)i * G + c; if (L >= nwg) return false;
        int wgid = (int)L; { const int q = nwg / NXCD, r = nwg % NXCD, xcd = wgid % NXCD, off = wgid / NXCD; wgid = (xcd < r ? xcd * (q + 1) : r * (q + 1) + (xcd - r) * q) + off; }
        const int nig = WGM * nN, gid = wgid / nig, fm = gid * WGM, gsz = (nM - fm) < WGM ? (nM - fm) : WGM;
        u.pm = fm + ((wgid % nig) % gsz); u.pn = (wgid % nig) / gsz; u.e = 0; u.cnt = 256; return true;
    }
};

template <class P, class Epi, bool FP8 = false>
__device__ __forceinline__ void gemm_phase(LAS unsigned char* lds, const P& S, const Epi& E) {
    int tid_ = threadIdx.x; asm volatile("" : "+v"(tid_));
    const int tid = tid_, wid = __builtin_amdgcn_readfirstlane(tid >> 6), lane = tid & 63, wr = wid >> 2, wc = wid & 3, fr = lane & 15, fq = lane >> 4;
    const int nt = S.nt;
    unsigned voffA[2], voffB[2];
    { int R0, C0, R1, C1; stage_rc(tid * 16, R0, C0); stage_rc(tid * 16 + 8192, R1, C1);
      const int Rb0 = Epi::PERM ? ((R0 & ~31) + perm32(R0 & 31)) : R0, Rb1 = Epi::PERM ? ((R1 & ~31) + perm32(R1 & 31)) : R1;
      voffB[0] = (unsigned)Rb0 * S.ldb2 + (unsigned)C0 * 2u; voffB[1] = (unsigned)Rb1 * S.ldb2 + (unsigned)C1 * 2u;
      if constexpr (!P::GATHER) { voffA[0] = (unsigned)R0 * S.lda2 + (unsigned)C0 * 2u; voffA[1] = (unsigned)R1 * S.lda2 + (unsigned)C1 * 2u; } else { voffA[0] = 0u; voffA[1] = 0u; } }
    const unsigned ldsw = (unsigned)wid * 1024u;
    const int aoff = lds_byte(wr * 64 + fr, fq * 8), boff = lds_byte(wc * 32 + fr, fq * 8);
#define PG8_SA(b, h) (((b) * 2 + (h)) * HTB)
#define PG8_SB(b, h) ((4 + (b) * 2 + (h)) * HTB)
#define PG8_STAGE_A(bufoff, aptr, koff, h) do { _Pragma("unroll") for (int _i = 0; _i < 2; ++_i) { \
        const char* _src; if constexpr (P::GATHER) _src = (aptr) + (size_t)ga[h][_i] + (size_t)(koff); else _src = (aptr) + (size_t)(h) * hstepA + (size_t)voffA[_i] + (size_t)(koff); \
        __builtin_amdgcn_global_load_lds((const unsigned*)_src, (LAS unsigned*)(lds + (bufoff) + ldsw + _i * 8192), 16, 0, 0); } } while (0)
#define PG8_STAGE_B(bufoff, bptr) do { _Pragma("unroll") for (int _i = 0; _i < 2; ++_i) \
        __builtin_amdgcn_global_load_lds((const unsigned*)((bptr) + voffB[_i]), (LAS unsigned*)(lds + (bufoff) + ldsw + _i * 8192), 16, 0, 0); } while (0)
#define PG8_LD16(off) (*(const LAS i32x4*)(lds + (off)))
#define PG8_LDA(dst, b, h) do { _Pragma("unroll") for (int m = 0; m < 4; ++m) { \
        if constexpr (FP8) { const i32x4 _l = PG8_LD16(PG8_SA(b, h) + aoff + m * 2048), _h = PG8_LD16(PG8_SA(b, h) + aoff + m * 2048 + 1024); dst[m] = __builtin_shufflevector(_l, _h, 0, 1, 2, 3, 4, 5, 6, 7); } \
        else { dst##16[m][0] = *(const LAS bf16x8*)(lds + PG8_SA(b, h) + aoff + m * 2048); dst##16[m][1] = *(const LAS bf16x8*)(lds + PG8_SA(b, h) + aoff + m * 2048 + 1024); } } } while (0)
#define PG8_LDB(dst, b, h) do { _Pragma("unroll") for (int n = 0; n < 2; ++n) { \
        if constexpr (FP8) { const i32x4 _l = PG8_LD16(PG8_SB(b, h) + boff + n * 2048), _h = PG8_LD16(PG8_SB(b, h) + boff + n * 2048 + 1024); dst[n] = __builtin_shufflevector(_l, _h, 0, 1, 2, 3, 4, 5, 6, 7); } \
        else { dst##16[n][0] = *(const LAS bf16x8*)(lds + PG8_SB(b, h) + boff + n * 2048); dst##16[n][1] = *(const LAS bf16x8*)(lds + PG8_SB(b, h) + boff + n * 2048 + 1024); } } } while (0)
#define PG8_MMA(ai, bj, At, Bt) do { __builtin_amdgcn_s_setprio(1); _Pragma("unroll") for (int m = 0; m < 4; ++m) _Pragma("unroll") for (int n = 0; n < 2; ++n) { \
        if constexpr (FP8) {   \
            asm volatile("v_mfma_scale_f32_16x16x128_f8f6f4 %0, %1, %2, %0, %3, %4 op_sel_hi:[0,0,0]" : "+v"(acc[ai][bj][m][n]) : "v"(Bt[n]), "v"(At[m]), "v"(scw), "v"(scx)); \
        } else { _Pragma("unroll") for (int k = 0; k < 2; ++k) \
            acc[ai][bj][m][n] = __builtin_amdgcn_mfma_f32_16x16x32_bf16(Bt##16[n][k], At##16[m][k], acc[ai][bj][m][n], 0, 0, 0); } } \
        __builtin_amdgcn_s_setprio(0); } while (0)
#define PG8_WAIT_V(n) asm volatile("s_waitcnt vmcnt(" #n ")" ::: "memory")
#define PG8_WAIT_L(n) asm volatile("s_waitcnt lgkmcnt(" #n ")" ::: "memory")
#define PG8_BAR __builtin_amdgcn_s_barrier()
#define PG8_SCHED __builtin_amdgcn_sched_barrier(0)
    Unit cur, nxt; int ui = 0;
    if (!S.next(0, cur)) return;
    f32x4 acc[2][2][4][2];
#pragma unroll
    for (int a = 0; a < 2; ++a)
#pragma unroll
        for (int b = 0; b < 2; ++b)
#pragma unroll
            for (int m = 0; m < 4; ++m)
#pragma unroll
                for (int n = 0; n < 2; ++n) acc[a][b][m][n] = (f32x4){0.f, 0.f, 0.f, 0.f};
    const int scw = 0x7a7a7a7a, scx = 0x7f7f7f7f;
    i32x8 At[4], B0[2], B1[2]; bf16x8 At16[4][2], B016[2][2], B116[2][2];
    unsigned ga[2][2] = {{0u, 0u}, {0u, 0u}};
    const size_t hstepA = P::GATHER ? (size_t)0 : (size_t)128 * S.lda2;
    const char *cA, *nA, *cB0, *cB1, *nB0, *nB1;
    cA = S.aptr(cur); if constexpr (P::GATHER) S.aoffs(cur, tid, ga);
    S.bptrs(cur, cB0, cB1);
    const size_t kstep = (size_t)(BK * 2);
    PG8_STAGE_B(PG8_SB(0, 0), cB0); PG8_STAGE_B(PG8_SB(0, 1), cB1); PG8_STAGE_A(PG8_SA(0, 0), cA, 0, 0); PG8_STAGE_A(PG8_SA(0, 1), cA, 0, 1);
    if (wr == 1) PG8_BAR;
    PG8_WAIT_V(2); PG8_BAR;
    PG8_STAGE_B(PG8_SB(1, 0), cB0 + kstep); PG8_STAGE_A(PG8_SA(1, 0), cA, kstep, 0); PG8_STAGE_B(PG8_SB(1, 1), cB1 + kstep);
    PG8_WAIT_V(6); PG8_BAR;
    for (;;) {
        const bool has_next = S.next(ui + 1, nxt);
        if (has_next) { nA = S.aptr(nxt); S.bptrs(nxt, nB0, nB1); } else { nxt = cur; nA = cA; nB0 = cB0; nB1 = cB1; }
        for (int t = 0; t < nt; t += 2) {
            if constexpr (Epi::MIDK) { if (t == (nt >> 1)) E.mid(acc, cur, wr, wc, fr, fq); }
            const bool last = (t == nt - 2);
            const size_t k1 = (size_t)(t + 1) * kstep;
            const size_t k2 = last ? (size_t)0 : (size_t)(t + 2) * kstep, k3 = k2 + kstep;
            const char* a2 = last ? nA : cA;
            const char* b20 = (last ? nB0 : cB0) + k2; const char* b21 = (last ? nB1 : cB1) + k2;
            const char* b30 = b20 + kstep; const char* b31 = b21 + kstep;
            PG8_LDB(B0, 0, 0); PG8_LDB(B1, 0, 1); PG8_SCHED; PG8_LDA(At, 0, 0); PG8_STAGE_A(PG8_SA(1, 1), cA, k1, 1);
            if constexpr (P::GATHER) { if (last && has_next) S.aoffs(nxt, tid, ga); }
            PG8_WAIT_V(8); PG8_WAIT_L(0); PG8_BAR; PG8_MMA(0, 0, At, B0); PG8_MMA(0, 1, At, B1); PG8_BAR; PG8_SCHED;
            PG8_LDA(At, 0, 1); PG8_STAGE_B(PG8_SB(0, 0), b20); PG8_STAGE_B(PG8_SB(0, 1), b21); PG8_STAGE_A(PG8_SA(0, 0), a2, k2, 0);
            PG8_WAIT_V(8); PG8_WAIT_L(0); PG8_BAR; PG8_MMA(1, 0, At, B0); PG8_MMA(1, 1, At, B1); PG8_BAR; PG8_SCHED;
            PG8_LDB(B0, 1, 0); PG8_LDB(B1, 1, 1); PG8_SCHED; PG8_LDA(At, 1, 0); PG8_STAGE_A(PG8_SA(0, 1), a2, k2, 1);
            PG8_WAIT_V(8); PG8_WAIT_L(0); PG8_BAR; PG8_MMA(0, 0, At, B0); PG8_MMA(0, 1, At, B1); PG8_BAR; PG8_SCHED;
            PG8_LDA(At, 1, 1); PG8_STAGE_B(PG8_SB(1, 0), b30); PG8_STAGE_B(PG8_SB(1, 1), b31); PG8_STAGE_A(PG8_SA(1, 0), a2, k3, 0);
            PG8_WAIT_V(8); PG8_WAIT_L(0); PG8_BAR; PG8_MMA(1, 0, At, B0); PG8_MMA(1, 1, At, B1); PG8_BAR; PG8_SCHED;
        }
        if (wr == 0) PG8_BAR;
        if constexpr (FP8) asm volatile("s_nop 15\n\ts_nop 15" ::: "memory");
        E(acc, cur, wr, wc, fr, fq);
        if (!has_next) break;
#pragma unroll
        for (int a = 0; a < 2; ++a)
#pragma unroll
            for (int b = 0; b < 2; ++b)
#pragma unroll
                for (int m = 0; m < 4; ++m)
#pragma unroll
                    for (int n = 0; n < 2; ++n) acc[a][b][m][n] = (f32x4){0.f, 0.f, 0.f, 0.f};
        cur = nxt; cA = nA; cB0 = nB0; cB1 = nB1; ++ui;
        if (wr == 1) PG8_BAR;
    }
    PG8_WAIT_V(0);
    PG8_BAR;
#undef PG8_SA
#undef PG8_SB
#undef PG8_STAGE_A
#undef PG8_STAGE_B
#undef PG8_LD16
#undef PG8_LDA
#undef PG8_LDB
#undef PG8_MMA
#undef PG8_WAIT_V
#undef PG8_WAIT_L
#undef PG8_BAR
#undef PG8_SCHED
}
}

struct Args { const float* in[28]; float* out; unsigned char* ws; int ph_lo, ph_hi; };
enum { IN_X = 0, IN_C, IN_ADAW, IN_ADAB, IN_N1G, IN_WIN, IN_LBL, IN_HGNG, IN_QNG, IN_KNG, IN_LQ1, IN_LK1, IN_LQ2, IN_LK2, IN_DANG, IN_RELB, IN_WA, IN_WB, IN_WOUT,
       IN_N2G, IN_RW, IN_RB, IN_EG, IN_EU, IN_ED, IN_SG, IN_SU, IN_SD };

struct Frame {
    LAS unsigned char* lds;
    volatile LAS unsigned* MISC;
    unsigned* ctl; float* vec;
    int tid, lane, wave, vcu, G;
    unsigned char* ws;
};


__device__ __forceinline__ unsigned pk4_fp8(float a, float b, float c, float d) { int p = 0; p = __builtin_amdgcn_cvt_pk_fp8_f32(a, b, p, false); p = __builtin_amdgcn_cvt_pk_fp8_f32(c, d, p, true); return (unsigned)p; }
constexpr float W8_SCALE = 32.0f;
#define OPAQUE_V(x) asm volatile("" : "+v"(x))
#define PHASE_IDS() int tid_ = threadIdx.x; asm volatile("" : "+v"(tid_)); const int tid = tid_, lane = tid & 63, wid = __builtin_amdgcn_readfirstlane(tid >> 6); (void)lane; (void)wid
struct TrItem { const float* src; int N; unsigned char* dst; int ldb; int fp8; };
__device__ __forceinline__ void tr_load(const TrItem& it, int lane, f32x4 (&v)[8]) {
#pragma unroll
    for (int i = 0; i < 8; ++i) v[i] = *(const GAS f32x4*)(it.src + (size_t)(8 * i + (lane >> 3)) * it.N + 4 * (lane & 7));
}
__device__ __forceinline__ void tr_finish(const TrItem& it, int lane, LAS float* scr, const f32x4 (&v)[8]) {
    const int q = lane & 7;
#pragma unroll
    for (int i = 0; i < 8; ++i) { const int kk = 8 * i + (lane >> 3);
        scr[(4 * q + 0) * 68 + kk] = v[i].x; scr[(4 * q + 1) * 68 + kk] = v[i].y; scr[(4 * q + 2) * 68 + kk] = v[i].z; scr[(4 * q + 3) * 68 + kk] = v[i].w; }
    LDS_WAIT(); asm volatile("" ::: "memory");
    const int n = lane >> 1, kh = lane & 1; const LAS float* s = scr + n * 68 + 32 * kh;
    f32x4 x[8];
#pragma unroll
    for (int j = 0; j < 8; ++j) x[j] = *(const LAS f32x4*)(s + 4 * j);
    if (it.fp8) {
        unsigned o[8];
#pragma unroll
        for (int j = 0; j < 8; ++j) o[j] = pk4_fp8(x[j].x * W8_SCALE, x[j].y * W8_SCALE, x[j].z * W8_SCALE, x[j].w * W8_SCALE);
        GAS v4u* d = (GAS v4u*)(it.dst + (size_t)n * it.ldb + 32 * kh);
        d[0] = (v4u){o[0], o[1], o[2], o[3]}; d[1] = (v4u){o[4], o[5], o[6], o[7]};
    } else {
        unsigned o[16];
#pragma unroll
        for (int j = 0; j < 8; ++j) { o[2 * j] = pk2(x[j].x, x[j].y); o[2 * j + 1] = pk2(x[j].z, x[j].w); }
        GAS v4u* d = (GAS v4u*)(it.dst + (size_t)n * it.ldb + 64 * kh);
#pragma unroll
        for (int j = 0; j < 4; ++j) d[j] = (v4u){o[4 * j], o[4 * j + 1], o[4 * j + 2], o[4 * j + 3]};
    }
    LDS_WAIT(); asm volatile("" ::: "memory");
}
#define TR_PAIR(itA, hasB, itB, lane, scr) do { f32x4 _va[8], _vb[8]; tr_load(itA, lane, _va); if (hasB) tr_load(itB, lane, _vb); tr_finish(itA, lane, scr, _va); if (hasB) tr_finish(itB, lane, scr, _vb); } while (0)

__device__ __forceinline__ void transpose_item(const float* W, int N, bf16* WT, int ldt, int koff, int row_off, LAS float* scr, int item, int lane) {
    const int nblk = N / 32, kb = item / nblk, nb = item % nblk, k0 = 64 * kb, n0 = 32 * nb;
#pragma unroll 8
    for (int i = 0; i < 32; ++i) { const int kk = 2 * i + (lane >> 5); scr[kk * 33 + (lane & 31)] = W[(size_t)(k0 + kk) * N + n0 + (lane & 31)]; }
    LDS_WAIT(); asm volatile("" ::: "memory");
    const int c = lane & 7;
#pragma unroll
    for (int j = 0; j < 4; ++j) { const int n = (lane >> 3) + 8 * j; const LAS float* s = scr + (8 * c) * 33 + n;
        v4u o; o.x = pk2(s[0 * 33], s[1 * 33]); o.y = pk2(s[2 * 33], s[3 * 33]); o.z = pk2(s[4 * 33], s[5 * 33]); o.w = pk2(s[6 * 33], s[7 * 33]);
        *(GAS v4u*)(WT + (size_t)(row_off + n0 + n) * ldt + koff + k0 + 8 * c) = o; }
    LDS_WAIT(); asm volatile("" ::: "memory");
}

__device__ __forceinline__ void transpose_item_fp8(const float* W, int N, unsigned char* WT, int ldt, LAS float* scr, int kb, int nb, int lane) {
    const int k0 = 64 * kb, n0 = 32 * nb;
#pragma unroll 8
    for (int i = 0; i < 32; ++i) { const int kk = 2 * i + (lane >> 5); scr[kk * 33 + (lane & 31)] = W[(size_t)(k0 + kk) * N + n0 + (lane & 31)]; }
    LDS_WAIT(); asm volatile("" ::: "memory");
    const int n = lane >> 1, kh = lane & 1; const LAS float* s = scr + (32 * kh) * 33 + n;
    unsigned o[8];
#pragma unroll
    for (int q = 0; q < 8; ++q) o[q] = pk4_fp8(s[(4 * q) * 33] * W8_SCALE, s[(4 * q + 1) * 33] * W8_SCALE, s[(4 * q + 2) * 33] * W8_SCALE, s[(4 * q + 3) * 33] * W8_SCALE);
    GAS v4u* dst = (GAS v4u*)(WT + (size_t)(n0 + n) * ldt + k0 + 32 * kh);
    dst[0] = (v4u){o[0], o[1], o[2], o[3]}; dst[1] = (v4u){o[4], o[5], o[6], o[7]};
    LDS_WAIT(); asm volatile("" ::: "memory");
}

__device__ __forceinline__ void phase_mod(Frame& F, const Args& a) {
    const float* c = a.in[IN_C]; const float* W = a.in[IN_ADAW]; const float* bia = a.in[IN_ADAB];
    PHASE_IDS();
    LAS float* cact = (LAS float*)F.lds;
    for (int i = tid; i < 4 * D; i += NTHREADS) { const float v = c[i]; cact[i] = v * fsigmoid(v); }
    __syncthreads();
    float* mod = (float*)(F.ctl + CW_MOD);
    LAS float* RED = (LAS float*)(F.lds + 32768);
    for (int cg = blockIdx.x; cg < 256; cg += F.G) {
        const int cq = tid % 12, dg = tid / 12, n = cg * 48 + cq * 4;
        if (dg < 42) {
            f32x4 acc[4];
#pragma unroll
            for (int b = 0; b < 4; ++b) acc[b] = (f32x4){0.f, 0.f, 0.f, 0.f};
            for (int d = dg; d < D; d += 42) {
                const f32x4 w = *(const GAS f32x4*)(W + (size_t)d * 12288 + n);
#pragma unroll
                for (int b = 0; b < 4; ++b) { const float cv = cact[b * D + d]; acc[b] += w * cv; }
            }
#pragma unroll
            for (int b = 0; b < 4; ++b) *(LAS f32x4*)(RED + (dg * 4 + b) * 48 + cq * 4) = acc[b];
        }
        __syncthreads();
        if (tid < 192) {
            const int b = tid / 48, cc = tid % 48;
            float s = bia[cg * 48 + cc];
            for (int g2 = 0; g2 < 42; ++g2) s += RED[(g2 * 4 + b) * 48 + cc];
            mod[b * 12288 + cg * 48 + cc] = s;
        }
        __syncthreads();
    }
    if (blockIdx.x == 0) {
        const float* lbl = a.in[IN_LBL];
        for (int k = tid; k < 1024; k += NTHREADS) { const float l0 = lbl[k], l1 = lbl[1024 + k]; const float m = fmaxf(l0, l1); const float e0 = __expf(l0 - m), e1 = __expf(l1 - m); F.vec[VW_LB + k] = e0 / (e0 + e1); }
        if (tid < 64) {
            const int l = tid;
            float s1 = a.in[IN_LQ1][l] * a.in[IN_LK1][l], s2 = a.in[IN_LQ2][l] * a.in[IN_LK2][l];
            s1 = wave_sum(s1); s2 = wave_sum(s2);
            float qg = fabsf(a.in[IN_QNG][l]), kg = fabsf(a.in[IN_KNG][l]);
#pragma unroll
            for (int o = 1; o < 64; o <<= 1) { qg = fmaxf(qg, __shfl_xor(qg, o)); kg = fmaxf(kg, __shfl_xor(kg, o)); }
            float mb = -1e30f;
            for (int i = l; i < 256; i += 64) mb = fmaxf(mb, a.in[IN_RELB][i]);
#pragma unroll
            for (int o = 1; o < 64; o <<= 1) mb = fmaxf(mb, __shfl_xor(mb, o));
            if (l == 0) { F.vec[VW_LAM] = __expf(s1) - __expf(s2) + LAMBDA_INIT; F.vec[VW_M2] = (8.0f * qg * kg * 1.01f + fmaxf(mb, 0.f)) * LOG2E; }
        }
        for (int i = tid; i < 8 * 256; i += NTHREADS) {
            const int h = i >> 8, dist = i & 255;
            int bucket;
            if (dist < 16) bucket = dist; else { const double v = log((double)dist / 16.0) / log(8.0) * 16.0; int lg = 16 + (int)v; bucket = lg < 31 ? lg : 31; }
            F.vec[VW_TBL + i] = a.in[IN_RELB][bucket * 8 + h] * LOG2E;
        }
    }
}

__device__ __forceinline__ void norm_mod_row(const float* xrow, const float* g, const float* shift, const float* scale, bf16* orow, unsigned char* orow8, int lane) {
    const GAS f32x4* xr = (const GAS f32x4*)xrow + lane;
    f32x4 v[8]; float s = 0.f;
#pragma unroll
    for (int j = 0; j < 8; ++j) { v[j] = xr[64 * j]; s += (v[j].x * v[j].x + v[j].y * v[j].y) + (v[j].z * v[j].z + v[j].w * v[j].w); }
    const float rstd = 1.f / sqrtf(wave_sum(s) * (1.f / D) + EPS);
    GAS v2u* o8 = (GAS v2u*)orow + lane;
#pragma unroll
    for (int j = 0; j < 8; ++j) {
        const int d = 4 * lane + 256 * j;
        const f32x4 gg = *(const f32x4*)(g + d), sh = *(const f32x4*)(shift + d), sc = *(const f32x4*)(scale + d);
        const f32x4 y = v[j] * rstd * gg * (sc + 1.0f) + sh;
        v2u o; o.x = pk2(y.x, y.y); o.y = pk2(y.z, y.w); o8[64 * j] = o;
        ((GAS unsigned*)orow8)[lane + 64 * j] = pk4_fp8(y.x, y.y, y.z, y.w);
    }
}
__device__ __forceinline__ void phase_prep1(Frame& F, const Args& a) {
    PHASE_IDS();
    LAS float* scr = (LAS float*)(F.lds + wid * 16384);
    const int gw = F.vcu * NWAVES + wid, NGW = F.G * NWAVES;
    constexpr int I_IN = (D / 64) * (INCOLS / 32), I_A = (1024 / 64) * (D / 32), I_O = (D / 64) * (D / 32), I_SG = (D / 64) * (DEXP / 32), I_SD = (DEXP / 64) * (D / 32);
    constexpr int NITEMS = I_IN + 2 * I_A + I_O + 2 * I_SG + I_SD;
    unsigned char* ws = F.ws;
#define PREP_DECODE(IT, idx) do { int r_ = (idx); \
        if (r_ < I_IN) { const int nblk = INCOLS / 32, kb = r_ / nblk, n0 = (r_ % nblk) * 32, k0 = 64 * kb; IT.src = a.in[IN_WIN] + (size_t)k0 * INCOLS + n0; IT.N = INCOLS; \
            if (n0 < 3072)      { IT.fp8 = 0; IT.ldb = D * 2; IT.dst = ws + WS_WIN + ((size_t)n0 * D + k0) * 2; }                         \
            else if (n0 < 4096) { IT.fp8 = 1; IT.ldb = D;     IT.dst = ws + WS_WIN8 + (size_t)(n0 - 3072) * D + k0; }                       \
            else if (n0 < 7168) { IT.fp8 = 0; IT.ldb = D * 2; IT.dst = ws + WS_WIN + ((size_t)(n0 - 1024) * D + k0) * 2; }                  \
            else                { IT.fp8 = 1; IT.ldb = D;     IT.dst = ws + WS_WIN8 + (size_t)(n0 - 7168 + 1024) * D + k0; } }              \
        else { r_ -= I_IN; \
        if (r_ < I_A) { const int kb = r_ / (D / 32), n0 = (r_ % (D / 32)) * 32, k0 = 64 * kb; IT.src = a.in[IN_WA] + (size_t)k0 * D + n0; IT.N = D; IT.fp8 = 0; IT.ldb = D * 2; IT.dst = ws + WS_WA + ((size_t)n0 * D + k0) * 2; } \
        else { r_ -= I_A; \
        if (r_ < I_A) { const int kb = r_ / (D / 32), n0 = (r_ % (D / 32)) * 32, k0 = 64 * kb; IT.src = a.in[IN_WB] + (size_t)k0 * D + n0; IT.N = D; IT.fp8 = 0; IT.ldb = D * 2; IT.dst = ws + WS_WA + ((size_t)n0 * D + 1024 + k0) * 2; } \
        else { r_ -= I_A; \
        if (r_ < I_O) { const int kb = r_ / (D / 32), n0 = (r_ % (D / 32)) * 32, k0 = 64 * kb; IT.src = a.in[IN_WOUT] + (size_t)k0 * D + n0; IT.N = D; IT.fp8 = 0; IT.ldb = D * 2; IT.dst = ws + WS_WOUT + ((size_t)n0 * D + k0) * 2; } \
        else { r_ -= I_O; \
        if (r_ < I_SG) { const int kb = r_ / (DEXP / 32), n0 = (r_ % (DEXP / 32)) * 32, k0 = 64 * kb; IT.src = a.in[IN_SG] + (size_t)k0 * DEXP + n0; IT.N = DEXP; IT.fp8 = 1; IT.ldb = D; IT.dst = ws + WS_WSH + (size_t)n0 * D + k0; } \
        else { r_ -= I_SG; \
        if (r_ < I_SG) { const int kb = r_ / (DEXP / 32), n0 = (r_ % (DEXP / 32)) * 32, k0 = 64 * kb; IT.src = a.in[IN_SU] + (size_t)k0 * DEXP + n0; IT.N = DEXP; IT.fp8 = 1; IT.ldb = D; IT.dst = ws + WS_WSH + 2 * MiB + (size_t)n0 * D + k0; } \
        else { r_ -= I_SG; const int kb = r_ / (D / 32), n0 = (r_ % (D / 32)) * 32, k0 = 64 * kb; IT.src = a.in[IN_SD] + (size_t)k0 * D + n0; IT.N = D; IT.fp8 = 1; IT.ldb = DEXP; IT.dst = ws + WS_WSH + 4 * MiB + (size_t)n0 * DEXP + k0; } } } } } } } while (0)
    for (int it = gw; it < NITEMS; it += 2 * NGW) {
        TrItem A_, B_; const bool hasB = (it + NGW < NITEMS);
        PREP_DECODE(A_, it); if (hasB) PREP_DECODE(B_, it + NGW); else B_ = A_;
        TR_PAIR(A_, hasB, B_, lane, scr);
    }
#undef PREP_DECODE
    { bf16* RH = (bf16*)(ws + WS_RWT_HI); bf16* RL = (bf16*)(ws + WS_RWT_LO); const float* rw = a.in[IN_RW];
      for (int i = (F.vcu * NWAVES + wid) * 64 + lane; i < 64 * D; i += F.G * NTHREADS) { const int e = i & 63, k = i >> 6; const float w = rw[i];
          const unsigned hb = f2bf(w); RH[e * D + k] = (bf16)hb; RL[e * D + k] = (bf16)f2bf(w - bf2f(hb)); } }
}
__device__ __forceinline__ void phase_hrows(Frame& F, const Args& a) {
    PHASE_IDS();
    const int gw = F.vcu * NWAVES + wid, NGW = F.G * NWAVES;
    unsigned char* ws = F.ws;
    const float* mod = (const float*)(F.ctl + CW_MOD);
    for (int m = gw; m < T; m += NGW) { const int b = m / SEQ;
        norm_mod_row(a.in[IN_X] + (size_t)m * D, a.in[IN_N1G], mod + b * 12288, mod + b * 12288 + 2048, (bf16*)(ws + WS_H) + (size_t)m * D, ws + WS_H8 + (size_t)m * D, lane); }
}

struct DenseGemm : pg8::DenseOrder {
    static constexpr bool GATHER = false;
    const char* A; const char* Bt; unsigned lda2, ldb2; int nt;
    __device__ __forceinline__ const char* aptr(const pg8::Unit& u) const { return A + (size_t)(u.pm * 256) * lda2; }
    __device__ __forceinline__ void aoffs(const pg8::Unit&, int, unsigned (&)[2][2]) const {}
    __device__ __forceinline__ void bptrs(const pg8::Unit& u, const char*& b0, const char*& b1) const { b0 = Bt + (size_t)(u.pn * 256) * ldb2; b1 = b0 + (size_t)128 * ldb2; }
};

template <int PART>
struct EpiInProj {
    static constexpr bool PERM = true, MIDK = false;
    unsigned char* ws;
    __device__ __forceinline__ void operator()(const f32x4 (&acc)[2][2][4][2], const pg8::Unit& u, int wr, int wc, int fr, int fq) const {
        bf16* base; int ldc, colt;
        if (PART == 0) { const int idx = u.pn >> 2, slot = idx < 3 ? idx : idx + 1; base = (bf16*)(ws + WS_PROJ + (size_t)slot * 32 * MiB); ldc = 1024; colt = (u.pn & 3) * 256; }
        else if (u.pn < 4) { base = (bf16*)(ws + WS_HG); ldc = 1024; colt = u.pn * 256; }
        else { const int q = u.pn - 4; base = (bf16*)(ws + WS_GA + (size_t)(q >> 3) * 64 * MiB); ldc = 2048; colt = (q & 7) * 256; }
        const int row0 = u.pm * 256 + wr * 64 + fr, col0 = colt + wc * 32 + 8 * fq;
#pragma unroll
        for (int ai = 0; ai < 2; ++ai)
#pragma unroll
            for (int m = 0; m < 4; ++m) { bf16* rowp = base + (size_t)(row0 + ai * 128 + m * 16) * ldc + col0;
#pragma unroll
                for (int bj = 0; bj < 2; ++bj) { const f32x4 v0 = acc[ai][bj][m][0], v1 = acc[ai][bj][m][1];
                    v4u w; w.x = pg8::cvt_pk_bf16(v0[0], v0[1]); w.y = pg8::cvt_pk_bf16(v0[2], v0[3]); w.z = pg8::cvt_pk_bf16(v1[0], v1[1]); w.w = pg8::cvt_pk_bf16(v1[2], v1[3]);
                    *(v4u*)(rowp + bj * 128) = w; } }
    }
};


constexpr int H1_TS = 272, H1_TS2 = 144;
constexpr int H1_QD = 0, H1_KD = 17408, H1_KI = 34816, H1_KBT = 60928, H1_VT = 79360, H1_AT = 97792, H1_TOT = 107008;
__device__ __forceinline__ void phase_h1(Frame& F) {
    unsigned char* ws = F.ws;
    const bf16* HQ = (const bf16*)(ws + WS_HQ); bf16* QT = (bf16*)(ws + WS_QT); const bf16* HF = (const bf16*)(ws + WS_HF); const bf16* HI = (const bf16*)(ws + WS_HI);
    bf16* STg = (bf16*)(ws + WS_ST); float* DEC = (float*)(ws + WS_DEC); float* OI = (float*)(ws + WS_OI);
    LAS unsigned char* L = F.lds;
    LAS float* TOT = (LAS float*)(L + H1_TOT);
    PHASE_IDS();
    const int kp = lane, seg = wid, qd = wid >> 1, r = lane & 15, g = lane >> 4;
    unsigned nq[8], nf[8], ni[8];
#define H1_LOAD(uu_) do { const int bh_ = (uu_) >> 6, n_ = (uu_) & 63; const size_t r0_ = (size_t)(bh_ >> 3) * SEQ + (size_t)n_ * 64 + 8 * seg; const int c_ = (bh_ & 7) * 128 + 2 * kp; \
        _Pragma("unroll") for (int i_ = 0; i_ < 8; ++i_) { const size_t idx_ = (r0_ + i_) * 1024 + c_; nq[i_] = *(const GAS unsigned*)(HQ + idx_); nf[i_] = *(const GAS unsigned*)(HF + idx_); ni[i_] = *(const GAS unsigned*)(HI + idx_); } } while (0)
    if (F.vcu < NCH_UNITS) H1_LOAD(F.vcu);
    for (int u = F.vcu; u < NCH_UNITS; u += F.G) {
        const int bh = u >> 6, n = u & 63, b = bh >> 3, h = bh & 7;
        const size_t row0 = (size_t)b * SEQ + (size_t)n * 64;
        const int col = h * 128 + 2 * kp;
        float cs0[8], cs1[8], kk0[8], kk1[8], qs0[8], qs1[8]; unsigned vv[8];
        const float lb0 = F.vec[VW_LB + col], lb1 = F.vec[VW_LB + col + 1];
        {
            float run0 = 0.f, run1 = 0.f;
#pragma unroll
            for (int uu = 0; uu < 8; ++uu) {
                const float q0 = bflo(nq[uu]), q1 = bfhi(nq[uu]), f0 = bflo(nf[uu]), f1 = bfhi(nf[uu]); vv[uu] = ni[uu];
                const float fg0 = lb0 + (1.f - lb0) * fsigmoid(f0), fg1 = lb1 + (1.f - lb1) * fsigmoid(f1);
                run0 += __logf(fg0); run1 += __logf(fg1); cs0[uu] = run0; cs1[uu] = run1; kk0[uu] = 1.f - fg0; kk1[uu] = 1.f - fg1;
                qs0[uu] = q0 * fsigmoid(q0) * 0.08838834764831845f; qs1[uu] = q1 * fsigmoid(q1) * 0.08838834764831845f;
            }
            *(LAS f32x2*)(TOT + seg * 128 + 2 * kp) = (f32x2){run0, run1};
        }
        __syncthreads();
        {
            float P0[9], P1[9]; P0[0] = 0.f; P1[0] = 0.f;
#pragma unroll
            for (int s = 0; s < 8; ++s) { const f32x2 tt = *(const LAS f32x2*)(TOT + s * 128 + 2 * kp); P0[s + 1] = P0[s] + tt.x; P1[s + 1] = P1[s] + tt.y; }
            float rq0 = 0.f, rq1 = 0.f, rs0 = 0.f, rs1 = 0.f;
#pragma unroll
            for (int s = 1; s < 8; ++s) if (seg == s) { rq0 = P0[s]; rq1 = P1[s]; rs0 = P0[s & ~1]; rs1 = P1[s & ~1]; }
            const float a0 = __expf(rq0 - rs0), a1 = __expf(rq1 - rs1), ai0 = __expf(fminf(rs0 - rq0, 40.f)), ai1 = __expf(fminf(rs1 - rq1, 40.f));
            const float e10 = __expf(P0[2] - rq0), e11 = __expf(P1[2] - rq1), e20 = __expf(P0[4] - rq0), e21 = __expf(P1[4] - rq1), e30 = __expf(P0[6] - rq0), e31 = __expf(P1[6] - rq1);
            const float eb0 = __expf(P0[8] - rq0), eb1 = __expf(P1[8] - rq1), eq0 = __expf(rq0), eq1 = __expf(rq1);
            float kb0[8], kb1[8];
#pragma unroll
            for (int uu = 0; uu < 8; ++uu) {
                const int t = 8 * seg + uu;
                const float qE0 = qs0[uu] * __expf(cs0[uu]), qE1 = qs1[uu] * __expf(cs1[uu]);
                const float kE0 = kk0[uu] * __expf(fminf(-cs0[uu], 40.f)), kE1 = kk1[uu] * __expf(fminf(-cs1[uu], 40.f));
                *(LAS unsigned*)(L + H1_QD + t * H1_TS + 4 * kp) = pg8::cvt_pk_bf16(qE0 * a0, qE1 * a1);
                *(LAS unsigned*)(L + H1_KD + t * H1_TS + 4 * kp) = pg8::cvt_pk_bf16(kE0 * ai0, kE1 * ai1);
                if (qd < 1) *(LAS unsigned*)(L + H1_KI + (0 + t) * H1_TS + 4 * kp) = pg8::cvt_pk_bf16(kE0 * e10, kE1 * e11);
                if (qd < 2) *(LAS unsigned*)(L + H1_KI + (16 + t) * H1_TS + 4 * kp) = pg8::cvt_pk_bf16(kE0 * e20, kE1 * e21);
                if (qd < 3) *(LAS unsigned*)(L + H1_KI + (48 + t) * H1_TS + 4 * kp) = pg8::cvt_pk_bf16(kE0 * e30, kE1 * e31);
                kb0[uu] = kE0 * eb0; kb1[uu] = kE1 * eb1;
                *(GAS unsigned*)(QT + (row0 + t) * 1024 + col) = pg8::cvt_pk_bf16(qE0 * eq0, qE1 * eq1);
            }
            *(LAS v4u*)(L + H1_KBT + (2 * kp) * H1_TS2 + 16 * seg) = (v4u){pg8::cvt_pk_bf16(kb0[0], kb0[1]), pg8::cvt_pk_bf16(kb0[2], kb0[3]), pg8::cvt_pk_bf16(kb0[4], kb0[5]), pg8::cvt_pk_bf16(kb0[6], kb0[7])};
            *(LAS v4u*)(L + H1_KBT + (2 * kp + 1) * H1_TS2 + 16 * seg) = (v4u){pg8::cvt_pk_bf16(kb1[0], kb1[1]), pg8::cvt_pk_bf16(kb1[2], kb1[3]), pg8::cvt_pk_bf16(kb1[4], kb1[5]), pg8::cvt_pk_bf16(kb1[6], kb1[7])};
            *(LAS v4u*)(L + H1_VT + (2 * kp) * H1_TS2 + 16 * seg) = (v4u){(vv[0] & 0xffffu) | (vv[1] << 16), (vv[2] & 0xffffu) | (vv[3] << 16), (vv[4] & 0xffffu) | (vv[5] << 16), (vv[6] & 0xffffu) | (vv[7] << 16)};
            *(LAS v4u*)(L + H1_VT + (2 * kp + 1) * H1_TS2 + 16 * seg) = (v4u){(vv[0] >> 16) | (vv[1] & 0xffff0000u), (vv[2] >> 16) | (vv[3] & 0xffff0000u), (vv[4] >> 16) | (vv[5] & 0xffff0000u), (vv[6] >> 16) | (vv[7] & 0xffff0000u)};
            if (seg == 0) *(GAS f32x2*)(DEC + (size_t)u * 128 + 2 * kp) = (f32x2){__expf(P0[8]), __expf(P1[8])};
        }
        __syncthreads();
        if (u + F.G < NCH_UNITS) H1_LOAD(u + F.G);
        for (int blk = wid; blk < 10; blk += 8) {
            const int i = blk >= 6 ? 3 : (blk >= 3 ? 2 : (blk >= 1 ? 1 : 0)), j = blk - (i * (i + 1)) / 2;
            const int kib = (i == 2) ? 16 : (i == 3 ? 48 : 0);
            const int krow_off = (j == i) ? (H1_KD + (16 * j + r) * H1_TS) : (H1_KI + (kib + 16 * j + r) * H1_TS);
            f32x4 acc = (f32x4){0.f, 0.f, 0.f, 0.f};
#pragma unroll
            for (int ks = 0; ks < 4; ++ks) {
                const bf16x8 af = *(const LAS bf16x8*)(L + H1_QD + (16 * i + r) * H1_TS + (32 * ks + 8 * g) * 2);
                const bf16x8 bfv = *(const LAS bf16x8*)(L + krow_off + (32 * ks + 8 * g) * 2);
                acc = __builtin_amdgcn_mfma_f32_16x16x32_bf16(af, bfv, acc, 0, 0, 0);
            }
#pragma unroll
            for (int rg = 0; rg < 4; ++rg) {
                const int tl = 4 * g + rg; float v = acc[rg];
                if (j == i && r > tl) v = 0.f;
                *(LAS bf16*)(L + H1_AT + (16 * i + tl) * H1_TS2 + (16 * j + r) * 2) = (bf16)f2bf(v);
            }
        }
        if (wid >= 2) {
            const int zb = wid - 2, zi = zb < 3 ? 0 : (zb < 5 ? 1 : 2), zj = zb < 3 ? zb + 1 : (zb < 5 ? zb - 1 : 3);
#pragma unroll
            for (int rg = 0; rg < 4; ++rg) *(LAS bf16*)(L + H1_AT + (16 * zi + 4 * g + rg) * H1_TS2 + (16 * zj + r) * 2) = (bf16)0;
        }
        __syncthreads();
        {
            bf16x8 vf[2];
#pragma unroll
            for (int ks = 0; ks < 2; ++ks) vf[ks] = *(const LAS bf16x8*)(L + H1_VT + (16 * wid + r) * H1_TS2 + (32 * ks + 8 * g) * 2);
#pragma unroll
            for (int rb = 0; rb < 4; ++rb) {
                f32x4 acc = (f32x4){0.f, 0.f, 0.f, 0.f};
#pragma unroll
                for (int ks = 0; ks < 2; ++ks) { const bf16x8 af = *(const LAS bf16x8*)(L + H1_AT + (16 * rb + r) * H1_TS2 + (32 * ks + 8 * g) * 2);
                    acc = __builtin_amdgcn_mfma_f32_16x16x32_bf16(vf[ks], af, acc, 0, 0, 0); }
                *(GAS f32x4*)(OI + (row0 + 16 * rb + r) * 1024 + h * 128 + 16 * wid + 4 * g) = acc;
            }
#pragma unroll
            for (int rb = 0; rb < 8; ++rb) {
                f32x4 acc = (f32x4){0.f, 0.f, 0.f, 0.f};
#pragma unroll
                for (int ks = 0; ks < 2; ++ks) { const bf16x8 af = *(const LAS bf16x8*)(L + H1_KBT + (16 * rb + r) * H1_TS2 + (32 * ks + 8 * g) * 2);
                    acc = __builtin_amdgcn_mfma_f32_16x16x32_bf16(af, vf[ks], acc, 0, 0, 0); }
                v2u o; o.x = pk2(acc[0], acc[1]); o.y = pk2(acc[2], acc[3]);
                *(GAS v2u*)(STg + (size_t)u * 16384 + (16 * wid + r) * 128 + 16 * rb + 4 * g) = o;
            }
        }
        __syncthreads();
    }
#undef H1_LOAD
}

__device__ __forceinline__ void phase_qkprep(Frame& F, const Args& a) {
    PHASE_IDS();
    const int gw = F.vcu * NWAVES + wid, NGW = F.G * NWAVES;
    float gq[16], gk[16];
#pragma unroll
    for (int e = 0; e < 16; ++e) { gq[e] = a.in[IN_QNG][16 * (lane & 3) + e] * (0.125f * LOG2E); gk[e] = a.in[IN_KNG][16 * (lane & 3) + e]; }
    for (int m = gw; m < T; m += NGW) {
#pragma unroll
        for (int which = 0; which < 2; ++which) {
            const bf16* p = (const bf16*)(F.ws + (which ? WS_DK : WS_DQ)) + (size_t)m * 1024 + 16 * lane;
            bf16* po = (bf16*)(F.ws + (which ? WS_DKN : WS_DQN)) + (size_t)m * 1024 + 16 * lane;
            const v4u w0 = *(const GAS v4u*)p, w1 = *(const GAS v4u*)(p + 8);
            float x[16];
            x[0] = bflo(w0.x); x[1] = bfhi(w0.x); x[2] = bflo(w0.y); x[3] = bfhi(w0.y); x[4] = bflo(w0.z); x[5] = bfhi(w0.z); x[6] = bflo(w0.w); x[7] = bfhi(w0.w);
            x[8] = bflo(w1.x); x[9] = bfhi(w1.x); x[10] = bflo(w1.y); x[11] = bfhi(w1.y); x[12] = bflo(w1.z); x[13] = bfhi(w1.z); x[14] = bflo(w1.w); x[15] = bfhi(w1.w);
            float ss = 0.f;
#pragma unroll
            for (int e = 0; e < 16; ++e) ss += x[e] * x[e];
            ss += __shfl_xor(ss, 1); ss += __shfl_xor(ss, 2);
            const float rstd = 1.f / sqrtf(ss * (1.f / 64.f) + EPS);
#pragma unroll
            for (int e = 0; e < 16; ++e) x[e] = x[e] * rstd * (which ? gk[e] : gq[e]);
            v4u o0, o1;
            o0.x = pk2(x[0], x[1]); o0.y = pk2(x[2], x[3]); o0.z = pk2(x[4], x[5]); o0.w = pk2(x[6], x[7]);
            o1.x = pk2(x[8], x[9]); o1.y = pk2(x[10], x[11]); o1.z = pk2(x[12], x[13]); o1.w = pk2(x[14], x[15]);
            *(GAS v4u*)po = o0; *(GAS v4u*)(po + 8) = o1;
        }
    }
}

__device__ __forceinline__ void phase_h2(Frame& F) {
    bf16* STg = (bf16*)(F.ws + WS_ST); const float* DEC = (const float*)(F.ws + WS_DEC);
    const int NIT = 32 * 128 * 32;
    PHASE_IDS();
    for (int it = F.vcu * NTHREADS + tid; it < NIT; it += F.G * NTHREADS) {
        const int bh = it >> 12, v = (it >> 5) & 127, kg = it & 31;
        float run0 = 0.f, run1 = 0.f, run2 = 0.f, run3 = 0.f;
        for (int n0 = 0; n0 < NCHUNK; n0 += 4) {
            v2u loc[4]; f32x4 dc[4];
#pragma unroll
            for (int j = 0; j < 4; ++j) { const size_t un = (size_t)bh * 64 + n0 + j;
                loc[j] = *(const GAS v2u*)(STg + un * 16384 + v * 128 + kg * 4); dc[j] = *(const GAS f32x4*)(DEC + un * 128 + kg * 4); }
#pragma unroll
            for (int j = 0; j < 4; ++j) { const size_t un = (size_t)bh * 64 + n0 + j;
                v2u o; o.x = pk2(run0, run1); o.y = pk2(run2, run3);
                *(GAS v2u*)(STg + un * 16384 + v * 128 + kg * 4) = o;
                run0 = dc[j].x * run0 + bflo(loc[j].x); run1 = dc[j].y * run1 + bfhi(loc[j].x); run2 = dc[j].z * run2 + bflo(loc[j].y); run3 = dc[j].w * run3 + bfhi(loc[j].y); }
        }
    }
}

__device__ __forceinline__ void phase_h3(Frame& F, const Args& a) {
    const bf16* HQ = (const bf16*)(F.ws + WS_QT); const bf16* HG = (const bf16*)(F.ws + WS_HG); const bf16* STg = (const bf16*)(F.ws + WS_ST);
    const float* OI = (const float*)(F.ws + WS_OI); bf16* BR = (bf16*)(F.ws + WS_BR);
    PHASE_IDS();
    const int r = lane & 15, g = lane >> 4, sub = wid >> 2, rb = wid & 3;
    f32x4 gn[8];
#pragma unroll
    for (int cb = 0; cb < 8; ++cb) gn[cb] = *(const GAS f32x4*)(a.in[IN_HGNG] + 16 * cb + 4 * g);
    for (int up = F.vcu; up < NCH_UNITS / 2; up += F.G) {
        const int u = up * 2 + sub, bh = u >> 6, n = u & 63, b = bh >> 3, h = bh & 7;
        const size_t m0 = (size_t)b * SEQ + (size_t)n * 64 + 16 * rb;
        bf16x8 af[4];
#pragma unroll
        for (int ks = 0; ks < 4; ++ks) af[ks] = *(const GAS bf16x8*)(HQ + (m0 + r) * 1024 + h * 128 + 32 * ks + 8 * g);
        f32x4 acc[8];
#pragma unroll
        for (int cb = 0; cb < 8; ++cb) {
            acc[cb] = (f32x4){0.f, 0.f, 0.f, 0.f};
#pragma unroll
            for (int ks = 0; ks < 4; ++ks) { const bf16x8 bfv = *(const GAS bf16x8*)(STg + (size_t)u * 16384 + (16 * cb + r) * 128 + 32 * ks + 8 * g);
                acc[cb] = __builtin_amdgcn_mfma_f32_16x16x32_bf16(bfv, af[ks], acc[cb], 0, 0, 0); }
        }
        float ss = 0.f;
#pragma unroll
        for (int cb = 0; cb < 8; ++cb) {
            const f32x4 o4 = *(const GAS f32x4*)(OI + (m0 + r) * 1024 + h * 128 + 16 * cb + 4 * g);
#pragma unroll
            for (int rg = 0; rg < 4; ++rg) { const float o = acc[cb][rg] + o4[rg]; acc[cb][rg] = o; ss += o * o; }
        }
        ss += __shfl_xor(ss, 16); ss += __shfl_xor(ss, 32);
        const float rstd = 1.f / sqrtf(ss * (1.f / 128.f) + EPS);
#pragma unroll
        for (int cb = 0; cb < 8; ++cb) {
            const v2u hg = *(const GAS v2u*)(HG + (m0 + r) * 1024 + h * 128 + 16 * cb + 4 * g);
            const float g0 = bflo(hg.x), g1 = bfhi(hg.x), g2 = bflo(hg.y), g3 = bfhi(hg.y);
            v2u o;
            o.x = pg8::cvt_pk_bf16(acc[cb][0] * rstd * gn[cb][0] * (g0 * fsigmoid(g0)), acc[cb][1] * rstd * gn[cb][1] * (g1 * fsigmoid(g1)));
            o.y = pg8::cvt_pk_bf16(acc[cb][2] * rstd * gn[cb][2] * (g2 * fsigmoid(g2)), acc[cb][3] * rstd * gn[cb][3] * (g3 * fsigmoid(g3)));
            *(GAS v2u*)(BR + (m0 + r) * 2048 + h * 128 + 16 * cb + 4 * g) = o;
        }
    }
}

__device__ __forceinline__ void phase_convert_experts(Frame& F, const Args& a) {
    PHASE_IDS();
    LAS float* scr = (LAS float*)(F.lds + wid * 16384);
    const int gw = F.vcu * NWAVES + wid, NGW = F.G * NWAVES;
    constexpr int IPM = 256, NITEMS = NEXP * 3 * IPM;
    for (int it = gw; it < NITEMS; it += NGW) {
        const int e = it / (3 * IPM), r = it % (3 * IPM), which = r / IPM, item = r % IPM;
        TrItem A_, B_; A_.fp8 = 1;
        if (which < 2) { const int kb2 = item / (DEXP / 32), n0 = (item % (DEXP / 32)) * 32, k0 = 128 * kb2;
            A_.src = a.in[which ? IN_EU : IN_EG] + (size_t)e * D * DEXP + (size_t)k0 * DEXP + n0; A_.N = DEXP; A_.ldb = D; A_.dst = F.ws + (which ? WS_WU : WS_WG) + (size_t)e * DEXP * D + (size_t)n0 * D + k0; }
        else { const int kb2 = item / (D / 32), n0 = (item % (D / 32)) * 32, k0 = 128 * kb2;
            A_.src = a.in[IN_ED] + (size_t)e * DEXP * D + (size_t)k0 * D + n0; A_.N = D; A_.ldb = DEXP; A_.dst = F.ws + WS_WDOWN + (size_t)e * D * DEXP + (size_t)n0 * DEXP + k0; }
        B_ = A_; B_.src = A_.src + (size_t)64 * A_.N; B_.dst = A_.dst + 64;
        TR_PAIR(A_, true, B_, lane, scr);
    }
}

constexpr int AT_KCH = 1040, AT_VDB = 4160, AT_STAGE = 33280, AT_TBL = 66560, AT_WSF = 67584, AT_QF = 68608;
__device__ __forceinline__ int crow(int r, int hi) { return (r & 3) + 8 * (r >> 2) + 4 * hi; }
__device__ __forceinline__ void phase_attn(Frame& F, const Args& a, const int pi_lo, const int pi_hi) {
    const bf16* DQ = (const bf16*)(F.ws + WS_DQN); const bf16* DK = (const bf16*)(F.ws + WS_DKN); const bf16* DV = (const bf16*)(F.ws + WS_DV);
    bf16* BR = (bf16*)(F.ws + WS_BR);
    LAS unsigned char* L = F.lds;
    LAS float* TBL = (LAS float*)(L + AT_TBL); LAS float* WSF = (LAS float*)(L + AT_WSF); LAS float* XB = (LAS float*)L;
    PHASE_IDS();
    const int c = wid >> 2, qblk = wid & 3, r32 = lane & 31, hi = lane >> 5;
    const float lam = F.vec[VW_LAM], M2 = F.vec[VW_M2];
    const int lrow0 = tid >> 4, lch = tid & 15, lrow1 = lrow0 + 32;
    const int kdst0 = lch * AT_KCH + lrow0 * 16, kdst1 = lch * AT_KCH + lrow1 * 16;
    const int vdst0 = 16640 + (lch >> 2) * AT_VDB + (lrow0 >> 4) * 1024 + (lrow0 & 15) * 64 + (lch & 3) * 16;
    const int vdst1 = 16640 + (lch >> 2) * AT_VDB + (lrow1 >> 4) * 1024 + (lrow1 & 15) * 64 + (lch & 3) * 16;
    const int vlane = 16640 + ((lane >> 4) & 1) * 32 + (lane & 3) * 8 + (4 * hi + ((lane & 15) >> 2)) * 64;
    float dg[4];
#pragma unroll
    for (int d0 = 0; d0 < 4; ++d0) dg[d0] = a.in[IN_DANG][32 * d0 + r32] * (1.0f - LAMBDA_INIT);
    for (int pi = pi_lo; pi < pi_hi; ++pi) {
        if (pi == (F.vcu & 3)) { phase_convert_experts(F, a); __syncthreads(); }
        const int pp = F.vcu * 2 + (pi >> 1);
        if (pp >= 512) break;
        const int bh = pp >> 4, s = pp & 15, qb = (pi & 1) ? 31 - s : s, b = bh >> 3, h = bh & 7;
        const int q0 = qb * 128, NT = 2 * qb + 2;
        const size_t rowb = (size_t)b * SEQ;
        if (tid < 256) TBL[tid] = F.vec[VW_TBL + h * 256 + tid];
        const int qfo = AT_QF + wid * 4096 + lane * 16;
#pragma unroll
        for (int d0 = 0; d0 < 4; ++d0) *(LAS bf16x8*)(L + qfo + d0 * 1024) = *(const GAS bf16x8*)(DQ + (rowb + q0 + 32 * qblk + r32) * 1024 + h * 128 + c * 64 + 16 * d0 + 8 * hi);
        const bf16* ksrc0 = DK + (rowb + lrow0) * 1024 + h * 128 + lch * 8; const bf16* ksrc1 = ksrc0 + (size_t)32 * 1024;
        const bf16* vsrc0 = DV + (rowb + lrow0) * 1024 + h * 128 + lch * 8; const bf16* vsrc1 = vsrc0 + (size_t)32 * 1024;
        v4u kr0, kr1, vr0, vr1;
        kr0 = *(const GAS v4u*)ksrc0; kr1 = *(const GAS v4u*)ksrc1; vr0 = *(const GAS v4u*)vsrc0; vr1 = *(const GAS v4u*)vsrc1;
        *(LAS v4u*)(L + kdst0) = kr0; *(LAS v4u*)(L + kdst1) = kr1; *(LAS v4u*)(L + vdst0) = vr0; *(LAS v4u*)(L + vdst1) = vr1;
        __syncthreads();
        const float tb31 = TBL[255];
        f32x16 o[4];
#pragma unroll
        for (int d0 = 0; d0 < 4; ++d0)
#pragma unroll
            for (int rr = 0; rr < 16; ++rr) o[d0][rr] = 0.f;
        float lsum = 0.f;
        const int qpos = q0 + 32 * qblk + r32;
        for (int j = 0; j < NT; ++j) {
            const int st = (j & 1) * AT_STAGE, sn = ((j + 1) & 1) * AT_STAGE;
            const bool more = (j + 1 < NT);
            if (more) { const size_t go = (size_t)(j + 1) * 64 * 1024;
                kr0 = *(const GAS v4u*)(ksrc0 + go); kr1 = *(const GAS v4u*)(ksrc1 + go); vr0 = *(const GAS v4u*)(vsrc0 + go); vr1 = *(const GAS v4u*)(vsrc1 + go); }
            const bool far = (j < NT - 4);
            const float cinit = far ? (tb31 - M2) : (-M2);
            f32x16 p0, p1;
#pragma unroll
            for (int rr = 0; rr < 16; ++rr) { p0[rr] = cinit; p1[rr] = cinit; }
#pragma unroll
            for (int d0 = 0; d0 < 4; ++d0) {
                const bf16x8 k0 = *(const LAS bf16x8*)(L + st + (8 * c + 2 * d0 + hi) * AT_KCH + r32 * 16);
                const bf16x8 k1 = *(const LAS bf16x8*)(L + st + (8 * c + 2 * d0 + hi) * AT_KCH + r32 * 16 + 512);
                const bf16x8 qf = *(const LAS bf16x8*)(L + qfo + d0 * 1024);
                p0 = __builtin_amdgcn_mfma_f32_32x32x16_bf16(k0, qf, p0, 0, 0, 0);
                p1 = __builtin_amdgcn_mfma_f32_32x32x16_bf16(k1, qf, p1, 0, 0, 0);
            }
            if (!far) {
                float tb0[16], tb1[16];
#pragma unroll
                for (int rr = 0; rr < 16; ++rr) { const int d0v = qpos - (64 * j + crow(rr, hi)), d1v = d0v - 32;
                    tb0[rr] = TBL[d0v < 0 ? 0 : (d0v > 255 ? 255 : d0v)]; tb1[rr] = TBL[d1v < 0 ? 0 : (d1v > 255 ? 255 : d1v)]; }
                asm volatile("s_waitcnt lgkmcnt(0)" ::: "memory");
#pragma unroll
                for (int rr = 0; rr < 16; ++rr) { const int d0v = qpos - (64 * j + crow(rr, hi)), d1v = d0v - 32;
                    p0[rr] = d0v >= 0 ? p0[rr] + tb0[rr] : -INFINITY; p1[rr] = d1v >= 0 ? p1[rr] + tb1[rr] : -INFINITY; }
            }
            float sacc = 0.f;
#pragma unroll
            for (int rr = 0; rr < 16; ++rr) { p0[rr] = __builtin_amdgcn_exp2f(p0[rr]); p1[rr] = __builtin_amdgcn_exp2f(p1[rr]); sacc += p0[rr] + p1[rr]; }
            lsum += sacc;
#define AT_VLD(dst, ks) do { _Pragma("unroll") for (int _d = 0; _d < 4; ++_d) { \
                const s16x4 _lo = __builtin_bit_cast(s16x4, __builtin_amdgcn_ds_read_tr16_b64_v4i16((LAS s16x4*)(L + st + vlane + _d * AT_VDB + (ks) * 1024))); \
                const s16x4 _hh = __builtin_bit_cast(s16x4, __builtin_amdgcn_ds_read_tr16_b64_v4i16((LAS s16x4*)(L + st + vlane + _d * AT_VDB + (ks) * 1024 + 512))); \
                dst[_d] = (bf16x8){_lo[0], _lo[1], _lo[2], _lo[3], _hh[0], _hh[1], _hh[2], _hh[3]}; } } while (0)
#define AT_PV(src, ks) do { v4u _w; if ((ks) < 2) { _w.x = pg8::cvt_pk_bf16(p0[8 * (ks) + 0], p0[8 * (ks) + 1]); _w.y = pg8::cvt_pk_bf16(p0[8 * (ks) + 2], p0[8 * (ks) + 3]); _w.z = pg8::cvt_pk_bf16(p0[8 * (ks) + 4], p0[8 * (ks) + 5]); _w.w = pg8::cvt_pk_bf16(p0[8 * (ks) + 6], p0[8 * (ks) + 7]); } \
                else { _w.x = pg8::cvt_pk_bf16(p1[8 * (ks) - 16], p1[8 * (ks) - 15]); _w.y = pg8::cvt_pk_bf16(p1[8 * (ks) - 14], p1[8 * (ks) - 13]); _w.z = pg8::cvt_pk_bf16(p1[8 * (ks) - 12], p1[8 * (ks) - 11]); _w.w = pg8::cvt_pk_bf16(p1[8 * (ks) - 10], p1[8 * (ks) - 9]); } \
                const bf16x8 _pa = __builtin_bit_cast(bf16x8, _w); \
                _Pragma("unroll") for (int _d = 0; _d < 4; ++_d) o[_d] = __builtin_amdgcn_mfma_f32_32x32x16_bf16(_pa, src[_d], o[_d], 0, 0, 0); } while (0)
            bf16x8 vfa[4], vfb[4];
            AT_VLD(vfa, 0);
            AT_VLD(vfb, 1); AT_PV(vfa, 0);
            AT_VLD(vfa, 2); AT_PV(vfb, 1);
            AT_VLD(vfb, 3); AT_PV(vfa, 2);
            AT_PV(vfb, 3);
#undef AT_VLD
#undef AT_PV
            if (more) { *(LAS v4u*)(L + sn + kdst0) = kr0; *(LAS v4u*)(L + sn + kdst1) = kr1; *(LAS v4u*)(L + sn + vdst0) = vr0; *(LAS v4u*)(L + sn + vdst1) = vr1; }
            __syncthreads();
        }
        lsum += __shfl_xor(lsum, 32);
        if (hi == 0) WSF[wid * 32 + r32] = lsum;
        LDS_WAIT();
        float rli[16];
#pragma unroll
        for (int rr = 0; rr < 16; ++rr) rli[rr] = 1.0f / WSF[wid * 32 + crow(rr, hi)];
        if (c == 1) {
#pragma unroll
            for (int d0 = 0; d0 < 4; ++d0)
#pragma unroll
                for (int rr = 0; rr < 16; ++rr) XB[(qblk * 32 + crow(rr, hi)) * 128 + 32 * d0 + r32] = o[d0][rr] * rli[rr] * lam;
        }
        __syncthreads();
        if (c == 0) {
            float ss[16];
#pragma unroll
            for (int rr = 0; rr < 16; ++rr) ss[rr] = 0.f;
#pragma unroll
            for (int d0 = 0; d0 < 4; ++d0)
#pragma unroll
                for (int rr = 0; rr < 16; ++rr) { const float df = o[d0][rr] * rli[rr] - XB[(qblk * 32 + crow(rr, hi)) * 128 + 32 * d0 + r32]; o[d0][rr] = df; ss[rr] += df * df; }
#pragma unroll
            for (int rr = 0; rr < 16; ++rr) { float s2 = ss[rr]; s2 += __shfl_xor(s2, 1); s2 += __shfl_xor(s2, 2); s2 += __shfl_xor(s2, 4); s2 += __shfl_xor(s2, 8); s2 += __shfl_xor(s2, 16);
                ss[rr] = 1.f / sqrtf(s2 * (1.f / 128.f) + EPS); }
#pragma unroll
            for (int d0 = 0; d0 < 4; ++d0)
#pragma unroll
                for (int rr = 0; rr < 16; ++rr)
                    BR[(rowb + q0 + 32 * qblk + crow(rr, hi)) * 2048 + 1024 + h * 128 + 32 * d0 + r32] = (bf16)f2bf_sw(o[d0][rr] * ss[rr] * dg[d0]);
        }
        __syncthreads();
    }
}

__device__ __forceinline__ void unpack8(const v4u w, float (&x)[8]) { x[0] = bflo(w.x); x[1] = bfhi(w.x); x[2] = bflo(w.y); x[3] = bfhi(w.y); x[4] = bflo(w.z); x[5] = bfhi(w.z); x[6] = bflo(w.w); x[7] = bfhi(w.w); }
struct EpiMergeF {
    static constexpr bool PERM = true, MIDK = true;
    unsigned char* ws;
    __device__ __forceinline__ void mid(f32x4 (&acc)[2][2][4][2], const pg8::Unit& u, int wr, int wc, int fr_, int fq_) const {
        int fr = fr_, fq = fq_; OPAQUE_V(fr); OPAQUE_V(fq);
        const bf16* GAp = (const bf16*)(ws + WS_GA); const bf16* GBp = (const bf16*)(ws + WS_GB);
        const int row0 = u.pm * 256 + wr * 64 + fr, col0 = u.pn * 256 + wc * 32 + 8 * fq;
#pragma unroll
        for (int ai = 0; ai < 2; ++ai)
#pragma unroll
            for (int m = 0; m < 4; ++m)
#pragma unroll
                for (int bj = 0; bj < 2; ++bj) {
                    const size_t off = (size_t)(row0 + ai * 128 + m * 16) * 2048 + col0 + bj * 128;
                    float ga[8], gb[8]; unpack8(*(const GAS v4u*)(GAp + off), ga); unpack8(*(const GAS v4u*)(GBp + off), gb);
#pragma unroll
                    for (int j = 0; j < 4; ++j) {
                        acc[ai][bj][m][0][j] *= (1.0f + __expf(-gb[j])) * __builtin_amdgcn_rcpf(1.0f + __expf(-ga[j]));
                        acc[ai][bj][m][1][j] *= (1.0f + __expf(-gb[4 + j])) * __builtin_amdgcn_rcpf(1.0f + __expf(-ga[4 + j])); }
                }
    }
    __device__ __forceinline__ void operator()(const f32x4 (&acc)[2][2][4][2], const pg8::Unit& u, int wr, int wc, int fr_, int fq_) const {
        int fr = fr_, fq = fq_; OPAQUE_V(fr); OPAQUE_V(fq);
        const bf16* GBp = (const bf16*)(ws + WS_GB); bf16* O = (bf16*)(ws + WS_MERGED);
        const int row0 = u.pm * 256 + wr * 64 + fr, col0 = u.pn * 256 + wc * 32 + 8 * fq;
#pragma unroll
        for (int ai = 0; ai < 2; ++ai)
#pragma unroll
            for (int m = 0; m < 4; ++m)
#pragma unroll
                for (int bj = 0; bj < 2; ++bj) {
                    const size_t off = (size_t)(row0 + ai * 128 + m * 16) * 2048 + col0 + bj * 128;
                    float gb[8], y[8]; unpack8(*(const GAS v4u*)(GBp + off), gb);
                    const f32x4 v0 = acc[ai][bj][m][0], v1 = acc[ai][bj][m][1];
#pragma unroll
                    for (int j = 0; j < 4; ++j) { y[j] = v0[j] * fsigmoid(gb[j]); y[4 + j] = v1[j] * fsigmoid(gb[4 + j]); }
                    v4u w; w.x = pk2(y[0], y[1]); w.y = pk2(y[2], y[3]); w.z = pk2(y[4], y[5]); w.w = pk2(y[6], y[7]);
                    *(GAS v4u*)(O + off) = w;
                }
    }
};
struct EpiOutProj {
    static constexpr bool PERM = true, MIDK = false;
    const float* x; bf16* x1b; const float* mod;
    __device__ __forceinline__ void operator()(const f32x4 (&acc)[2][2][4][2], const pg8::Unit& u, int wr, int wc, int fr_, int fq_) const {
        int fr = fr_, fq = fq_; OPAQUE_V(fr); OPAQUE_V(fq);
        const int row0 = u.pm * 256 + wr * 64 + fr, col0 = u.pn * 256 + wc * 32 + 8 * fq;
        const int b = (u.pm * 256) / SEQ;
#pragma unroll
        for (int ai = 0; ai < 2; ++ai)
#pragma unroll
            for (int m = 0; m < 4; ++m) { const size_t ro = (size_t)(row0 + ai * 128 + m * 16) * D + col0;
#pragma unroll
                for (int bj = 0; bj < 2; ++bj) {
                    const f32x4 x0 = *(const GAS f32x4*)(x + ro + bj * 128), x4 = *(const GAS f32x4*)(x + ro + bj * 128 + 4);
                    const f32x4 g0 = *(const GAS f32x4*)(mod + b * 12288 + 4096 + col0 + bj * 128), g4 = *(const GAS f32x4*)(mod + b * 12288 + 4096 + col0 + bj * 128 + 4);
                    const f32x4 y0 = x0 + g0 * acc[ai][bj][m][0], y1 = x4 + g4 * acc[ai][bj][m][1];
                    v4u w; w.x = pk2(y0[0], y0[1]); w.y = pk2(y0[2], y0[3]); w.z = pk2(y1[0], y1[1]); w.w = pk2(y1[2], y1[3]);
                    *(GAS v4u*)(x1b + ro + bj * 128) = w; } }
    }
};


constexpr int RT_XSLD = 2056;
constexpr int RT_XS = 0, RT_PART = 65792;
constexpr int RT_LCNT = 98560, RT_STOK = 98816, RT_SW = 107008;
constexpr int MOE_TB = MISC_OFF + 1024;
__device__ __forceinline__ void phase_router(Frame& F, const Args& a) {
    PHASE_IDS();
    LAS unsigned char* L = F.lds;
    LAS bf16* XS = (LAS bf16*)(L + RT_XS); LAS float* PART = (LAS float*)(L + RT_PART);
    const bf16* x1 = (const bf16*)(F.ws + WS_X1B); const float* mod = (const float*)(F.ctl + CW_MOD);
    unsigned char* H2 = F.ws + WS_H2;
    int* LTOK = (int*)(F.ws + WS_LTOK); float* LW = (float*)(F.ws + WS_LW);
    const float rbias = a.in[IN_RB][lane];
    if (tid < 64) ((LAS unsigned*)(L + RT_LCNT))[tid] = 0u;
    __syncthreads();
    int rounds = 0, round_row0 = 0;
    const bf16* RH = (const bf16*)(F.ws + WS_RWT_HI);
    const int r = lane & 15, g = lane >> 4;
    v2u xw0[8], xw1[8];
#define RT_LOADX(g_) do { const GAS v2u* xr_ = (const GAS v2u*)(x1 + (size_t)((g_) * 16 + 2 * wid) * D) + lane; \
        _Pragma("unroll") for (int j_ = 0; j_ < 8; ++j_) { xw0[j_] = xr_[64 * j_]; xw1[j_] = xr_[64 * j_ + 512]; } } while (0)
#define RT_LOADW(dst, ks_) do { _Pragma("unroll") for (int cb_ = 0; cb_ < 4; ++cb_) dst[cb_] = *(const GAS bf16x8*)(RH + (16 * cb_ + r) * D + 256 * wid + 32 * (ks_) + 8 * g); } while (0)
#define RT_STEP(src, ks_) do { const bf16x8 xf_ = *(const LAS bf16x8*)(XS + r * RT_XSLD + 256 * wid + 32 * (ks_) + 8 * g); \
        _Pragma("unroll") for (int cb_ = 0; cb_ < 4; ++cb_) acc[cb_] = __builtin_amdgcn_mfma_f32_16x16x32_bf16(xf_, src[cb_], acc[cb_], 0, 0, 0); } while (0)
#define RT_FENCE() asm volatile("" ::: "memory")
    const int RPW = (T / 16) / F.G, bq = (F.vcu * RPW * 16) / SEQ;
    f32x4 ga[8], sh[8];
#pragma unroll
    for (int j = 0; j < 8; ++j) { const int d = 4 * lane + 256 * j;
        const f32x4 gg = *(const f32x4*)(a.in[IN_N2G] + d), sc = *(const GAS f32x4*)(mod + bq * 12288 + 8192 + d); sh[j] = *(const GAS f32x4*)(mod + bq * 12288 + 6144 + d); ga[j] = gg * (sc + 1.0f); }
    RT_LOADX(F.vcu * RPW);
    for (int gi = 0; gi < RPW; ++gi) {
        const int grp = F.vcu * RPW + gi;
        if (rounds == 0) round_row0 = grp * 16;
#pragma unroll
        for (int rr2 = 0; rr2 < 2; ++rr2) {
            const int rloc = 2 * wid + rr2, m = grp * 16 + rloc;
            f32x4 v[8]; float s = 0.f;
#pragma unroll
            for (int j = 0; j < 8; ++j) { const v2u w = rr2 ? xw1[j] : xw0[j]; v[j] = (f32x4){bflo(w.x), bfhi(w.x), bflo(w.y), bfhi(w.y)}; s += (v[j].x * v[j].x + v[j].y * v[j].y) + (v[j].z * v[j].z + v[j].w * v[j].w); }
            const float rstd = 1.f / sqrtf(wave_sum(s) * (1.f / D) + EPS);
            GAS unsigned* o8 = (GAS unsigned*)(H2 + (size_t)m * D) + lane;
#pragma unroll
            for (int j = 0; j < 8; ++j) {
                const int d = 4 * lane + 256 * j;
                const f32x4 y = v[j] * rstd * ga[j] + sh[j];
                o8[64 * j] = pk4_fp8(y.x, y.y, y.z, y.w);
                v2u xb; xb.x = pk2(y.x, y.y); xb.y = pk2(y.z, y.w);
                *(LAS v2u*)(XS + rloc * RT_XSLD + d) = xb;
            }
        }
        {
            f32x4 acc[4];
#pragma unroll
            for (int cb = 0; cb < 4; ++cb) acc[cb] = (f32x4){0.f, 0.f, 0.f, 0.f};
            bf16x8 w0[4], w1[4], w2[4], w3[4];
            RT_LOADW(w0, 0); RT_LOADW(w1, 1); RT_LOADW(w2, 2); RT_LOADW(w3, 3);
            RT_FENCE();
            __syncthreads();
            RT_STEP(w0, 0); RT_LOADW(w0, 4); RT_FENCE();
            RT_STEP(w1, 1); RT_LOADW(w1, 5); RT_FENCE();
            RT_STEP(w2, 2); RT_LOADW(w2, 6); RT_FENCE();
            RT_STEP(w3, 3); RT_LOADW(w3, 7); RT_FENCE();
            if (gi + 1 < RPW) RT_LOADX(grp + 1);
            RT_FENCE();
            RT_STEP(w0, 4); RT_STEP(w1, 5); RT_STEP(w2, 6); RT_STEP(w3, 7);
#pragma unroll
            for (int cb = 0; cb < 4; ++cb)
#pragma unroll
                for (int rg = 0; rg < 4; ++rg) PART[(wid * 16 + 4 * g + rg) * 64 + 16 * cb + r] = acc[cb][rg];
        }
        __syncthreads();
#pragma unroll
        for (int rr2 = 0; rr2 < 2; ++rr2) {
            const int rloc = 2 * wid + rr2, m = grp * 16 + rloc;
            float logit = 0.f;
#pragma unroll
            for (int w2 = 0; w2 < 8; ++w2) logit += PART[(w2 * 16 + rloc) * 64 + lane];
            const float score = 1.0f / (1.0f + expf(-logit)), sel = score + rbias;
            const int eg = lane >> 3;
            float m1 = sel; m1 = fmaxf(m1, __shfl_xor(m1, 1)); m1 = fmaxf(m1, __shfl_xor(m1, 2)); m1 = fmaxf(m1, __shfl_xor(m1, 4));
            const unsigned long long bm = __ballot(sel == m1);
            const int first = __builtin_ctz((unsigned)((bm >> (8 * eg)) & 0xffull)) + 8 * eg;
            float m2 = (lane == first) ? -INFINITY : sel; m2 = fmaxf(m2, __shfl_xor(m2, 1)); m2 = fmaxf(m2, __shfl_xor(m2, 2)); m2 = fmaxf(m2, __shfl_xor(m2, 4));
            const float gs = m1 + m2;
            int grank = 0;
#pragma unroll
            for (int g2 = 0; g2 < 8; ++g2) { const float o = __shfl(gs, 8 * g2); grank += (o > gs || (o == gs && g2 < eg)) ? 1 : 0; }
            const float masked = grank < 4 ? sel : -INFINITY;
            int rank = 0;
#pragma unroll 8
            for (int e2 = 0; e2 < 64; ++e2) { const float o = __shfl(masked, e2); rank += (o > masked || (o == masked && e2 < lane)) ? 1 : 0; }
            const bool selected = rank < 8;
            const float ssum = wave_sum(selected ? score : 0.f);
            if (selected) {
                const unsigned pos = __hip_atomic_fetch_add((LAS unsigned*)(L + RT_LCNT) + lane, 1u, __ATOMIC_RELAXED, __HIP_MEMORY_SCOPE_WORKGROUP);
                ((LAS unsigned short*)(L + RT_STOK))[lane * 64 + pos] = (unsigned short)((rounds * 16 + rloc) * 8 + rank); ((LAS float*)(L + RT_SW))[lane * 64 + pos] = score / ssum * 2.5f;
            }
        }
        __syncthreads();
        ++rounds;
        if (rounds == 4 || gi + 1 == RPW) {
            const int e = tid >> 3, sub = tid & 7;
            const unsigned n = ((LAS unsigned*)(L + RT_LCNT))[e];
            unsigned base = 0u;
            if (sub == 0 && n) base = atomicAdd(F.ctl + CW_CNT + 64 * e, n);
            base = __shfl(base, lane & ~7);
            for (unsigned i = sub; i < n; i += 8) { const int sv = (int)((LAS unsigned short*)(L + RT_STOK))[e * 64 + i]; LTOK[e * 16384 + base + i] = (round_row0 + (sv >> 7) * 16 + ((sv >> 3) & 15)) * 8 + (sv & 7); LW[e * 16384 + base + i] = ((LAS float*)(L + RT_SW))[e * 64 + i]; }
            __syncthreads();
            if (tid < 64) ((LAS unsigned*)(L + RT_LCNT))[tid] = 0u;
            rounds = 0;
            __syncthreads();
        }
    }
}
#undef RT_LOADX
#undef RT_LOADW
#undef RT_STEP
#undef RT_FENCE
__device__ __forceinline__ void moe_build_table(Frame& F) {
    PHASE_IDS();
    LAS int* tb = (LAS int*)(F.lds + MOE_TB); LAS int* cn = tb + 68; LAS int* ab = cn + 68;
    if (tid == 0) {
        int t = 0, r = 0;
        for (int e = 0; e < NEXP; ++e) { const int c = (int)__hip_atomic_load(F.ctl + CW_CNT + 64 * e, RLX_AGENT); tb[e] = t; cn[e] = c; ab[e] = r; t += (c + 255) >> 8; r += c; }
        tb[64] = t; cn[64] = T; ab[64] = r;
    }
    __syncthreads();
}
template <int NP>
struct MoeOrder {
    LAS int* tb; int G, c;
    __device__ bool next(int i, pg8::Unit& u) const {
        const int ntr = tb[64]; const long L = (long)i * G + c;
        if (L >= (long)(64 + ntr) * NP) return false;
        int tt = (int)(L / NP); u.pn = (int)(L % NP);
        if (tt < 64) { u.e = 64; u.pm = tt; u.cnt = 256; return true; }
        tt -= 64;
        int lo = 0, hi = 64;
        while (hi - lo > 1) { const int mid = (lo + hi) >> 1; if (tb[mid] <= tt) lo = mid; else hi = mid; }
        u.e = lo; u.pm = tt - tb[lo]; const int rem = tb[68 + lo] - 256 * u.pm; u.cnt = rem < 256 ? rem : 256; return true;
    }
};
struct MoeGemm1 : MoeOrder<4> {
    static constexpr bool GATHER = true;
    unsigned char* ws; unsigned lda2, ldb2; int nt;
    __device__ __forceinline__ const char* aptr(const pg8::Unit&) const { return (const char*)(ws + WS_H2); }
    __device__ __forceinline__ void aoffs(const pg8::Unit& u, int tid, unsigned (&o)[2][2]) const {
        const int* LTOK = (const int*)(ws + WS_LTOK);
        OPAQUE_V(tid);
        int R0, C0, R1, C1; pg8::stage_rc(tid * 16, R0, C0); pg8::stage_rc(tid * 16 + 8192, R1, C1);
#pragma unroll
        for (int h = 0; h < 2; ++h) {
            const int p0 = h * 128 + R0, p1 = h * 128 + R1; int t0, t1;
            if (u.e == 64) { t0 = u.pm * 256 + p0; t1 = u.pm * 256 + p1; }
            else { t0 = p0 < u.cnt ? (LTOK[u.e * 16384 + u.pm * 256 + p0] >> 3) : 0; t1 = p1 < u.cnt ? (LTOK[u.e * 16384 + u.pm * 256 + p1] >> 3) : 0; }
            o[h][0] = (unsigned)t0 * 2048u + (unsigned)C0 * 2u; o[h][1] = (unsigned)t1 * 2048u + (unsigned)C1 * 2u;
        }
    }
    __device__ __forceinline__ void bptrs(const pg8::Unit& u, const char*& b0, const char*& b1) const {
        const char* g = (u.e == 64) ? (const char*)(ws + WS_WSH) : (const char*)(ws + WS_WG) + (size_t)u.e * DEXP * D;
        const char* up = (u.e == 64) ? (const char*)(ws + WS_WSH + 2 * MiB) : (const char*)(ws + WS_WU) + (size_t)u.e * DEXP * D;
        b0 = g + (size_t)(u.pn * 128) * 2048; b1 = up + (size_t)(u.pn * 128) * 2048;
    }
};
struct EpiSwiglu {
    static constexpr bool PERM = true, MIDK = false;
    unsigned char* ws; LAS int* tb;
    __device__ __forceinline__ void operator()(const f32x4 (&acc)[2][2][4][2], const pg8::Unit& u, int wr, int wc, int fr_, int fq_) const {
        int fr = fr_, fq = fq_; OPAQUE_V(fr); OPAQUE_V(fq);
        unsigned char* ACT = ws + WS_ACT;
        const int rbase = tb[136 + u.e] + u.pm * 256, col0 = u.pn * 128 + wc * 32 + 8 * fq;
#pragma unroll
        for (int ai = 0; ai < 2; ++ai)
#pragma unroll
            for (int m = 0; m < 4; ++m) {
                const int rt = ai * 128 + wr * 64 + m * 16 + fr;
                if (rt < u.cnt) {
                    float y[8];
#pragma unroll
                    for (int n = 0; n < 2; ++n)
#pragma unroll
                        for (int j = 0; j < 4; ++j) { const float gt = acc[ai][0][m][n][j], upv = acc[ai][1][m][n][j]; y[4 * n + j] = fminf(fmaxf(gt * fsigmoid(gt) * upv, -448.f), 448.f); }
                    v2u w; w.x = pk4_fp8(y[0], y[1], y[2], y[3]); w.y = pk4_fp8(y[4], y[5], y[6], y[7]);
                    *(GAS v2u*)(ACT + (size_t)(rbase + rt) * DEXP + col0) = w;
                }
            }
    }
};
struct MoeGemm2 : MoeOrder<8> {
    static constexpr bool GATHER = false;
    unsigned char* ws; unsigned lda2, ldb2; int nt;
    __device__ __forceinline__ const char* aptr(const pg8::Unit& u) const { return (const char*)(ws + WS_ACT) + (size_t)(tb[136 + u.e] + u.pm * 256) * 512; }
    __device__ __forceinline__ void aoffs(const pg8::Unit&, int, unsigned (&)[2][2]) const {}
    __device__ __forceinline__ void bptrs(const pg8::Unit& u, const char*& b0, const char*& b1) const {
        const char* dn = (u.e == 64) ? (const char*)(ws + WS_WSH + 4 * MiB) : (const char*)(ws + WS_WDOWN) + (size_t)u.e * D * DEXP;
        b0 = dn + (size_t)(u.pn * 256) * 512; b1 = b0 + (size_t)128 * 512;
    }
};
struct EpiDown {
    static constexpr bool PERM = true, MIDK = false;
    unsigned char* ws; float* out; const float* mod;
    __device__ __forceinline__ void operator()(const f32x4 (&acc)[2][2][4][2], const pg8::Unit& u, int wr, int wc, int fr_, int fq_) const {
        int fr = fr_, fq = fq_; OPAQUE_V(fr); OPAQUE_V(fq);
        const int* LTOK = (const int*)(ws + WS_LTOK); const float* LW = (const float*)(ws + WS_LW); unsigned char* Y = ws + WS_Y;
        const int col0 = u.pn * 256 + wc * 32 + 8 * fq;
        if (u.e == 64) {
            bf16* YSH = (bf16*)(ws + WS_YSH);
#pragma unroll
            for (int ai = 0; ai < 2; ++ai)
#pragma unroll
                for (int m = 0; m < 4; ++m) {
                    const int rt = ai * 128 + wr * 64 + m * 16 + fr, t = u.pm * 256 + rt;
#pragma unroll
                    for (int bj = 0; bj < 2; ++bj) { const f32x4 v0 = acc[ai][bj][m][0], v1 = acc[ai][bj][m][1];
                        v4u pw; pw.x = pk2(v0[0], v0[1]); pw.y = pk2(v0[2], v0[3]); pw.z = pk2(v1[0], v1[1]); pw.w = pk2(v1[2], v1[3]);
                        *(GAS v4u*)(YSH + (size_t)t * D + col0 + bj * 128) = pw; }
                }
        } else {
            const int r2 = (fr + 16 * fq) >> 2, c2 = fr & 3, bsrc = ((c2 << 4) | r2) << 2;
            int tk[8]; float w8[8];
            const int pbase = u.e * 16384 + u.pm * 256, lastr = u.cnt - 1;
#pragma unroll
            for (int i = 0; i < 8; ++i) { const int rb = (i >> 2) * 128 + wr * 64 + (i & 3) * 16, ro = rb + fr, rn = rb + r2;
                w8[i] = *(const GAS float*)(LW + pbase + (ro < lastr ? ro : lastr)) * Y8_SCALE; tk[i] = *(const GAS int*)(LTOK + pbase + (rn < lastr ? rn : lastr)); }
            const int colw = u.pn * 256 + wc * 32 + 8 * c2;
#pragma unroll
            for (int ai = 0; ai < 2; ++ai)
#pragma unroll
                for (int m = 0; m < 4; ++m) {
                    const int rn = ai * 128 + wr * 64 + m * 16 + r2; const float w = w8[ai * 4 + m];
#pragma unroll
                    for (int bj = 0; bj < 2; ++bj) { f32x4 v0 = acc[ai][bj][m][0] * w, v1 = acc[ai][bj][m][1] * w;
#pragma unroll
                        for (int j = 0; j < 4; ++j) { v0[j] = fminf(fmaxf(v0[j], -448.f), 448.f); v1[j] = fminf(fmaxf(v1[j], -448.f), 448.f); }
                        v2u pw; pw.x = (unsigned)__builtin_amdgcn_ds_bpermute(bsrc, (int)pk4_fp8(v0[0], v0[1], v0[2], v0[3])); pw.y = (unsigned)__builtin_amdgcn_ds_bpermute(bsrc, (int)pk4_fp8(v1[0], v1[1], v1[2], v1[3]));
                        if (rn < u.cnt) *(GAS v2u*)(Y + (size_t)tk[ai * 4 + m] * D + colw + bj * 128) = pw; }
                }
        }
    }
};
__device__ __forceinline__ void phase_combine(Frame& F, const Args& a) {
    PHASE_IDS();
    const unsigned char* Y = F.ws + WS_Y; const float* mod = (const float*)(F.ctl + CW_MOD); float* out = a.out;
    const int NIT = T * (D / 8);
    const bool bad = xb_ld(F.ctl + CW_BAR + XB_TMO) != 0u;
    for (int it = F.vcu * NTHREADS + tid; it < NIT; it += F.G * NTHREADS) {
        const int t = it >> 8, c8 = (it & 255) * 8, b = t / SEQ;
        float s[8];
#pragma unroll
        for (int j = 0; j < 8; ++j) s[j] = 0.f;
#pragma unroll
        for (int k = 0; k < 8; ++k) { const v2u w = *(const GAS v2u*)(Y + ((size_t)t * 8 + k) * D + c8);
            const auto f0 = __builtin_amdgcn_cvt_pk_f32_fp8((int)w.x, false), f1 = __builtin_amdgcn_cvt_pk_f32_fp8((int)w.x, true), f2 = __builtin_amdgcn_cvt_pk_f32_fp8((int)w.y, false), f3 = __builtin_amdgcn_cvt_pk_f32_fp8((int)w.y, true);
            s[0] += f0[0]; s[1] += f0[1]; s[2] += f1[0]; s[3] += f1[1]; s[4] += f2[0]; s[5] += f2[1]; s[6] += f3[0]; s[7] += f3[1]; }
#pragma unroll
        for (int j = 0; j < 8; ++j) s[j] *= (1.0f / Y8_SCALE);
        const f32x4 g0 = *(const GAS f32x4*)(mod + b * 12288 + 10240 + c8), g1 = *(const GAS f32x4*)(mod + b * 12288 + 10240 + c8 + 4);
        GAS f32x4* o = (GAS f32x4*)(out + (size_t)t * D + c8);
        float xv[8], sh[8]; unpack8(*(const GAS v4u*)((const bf16*)(F.ws + WS_X1B) + (size_t)t * D + c8), xv); unpack8(*(const GAS v4u*)((const bf16*)(F.ws + WS_YSH) + (size_t)t * D + c8), sh);
#pragma unroll
        for (int j = 0; j < 8; ++j) s[j] += sh[j];
        const f32x4 o0 = (f32x4){xv[0], xv[1], xv[2], xv[3]}, o1 = (f32x4){xv[4], xv[5], xv[6], xv[7]};
        f32x4 r0 = o0 + g0 * (f32x4){s[0], s[1], s[2], s[3]}; const f32x4 r1 = o1 + g1 * (f32x4){s[4], s[5], s[6], s[7]};
        if (bad) r0.x = __builtin_nanf("");
        o[0] = r0; o[1] = r1;
    }
}

__global__ void __launch_bounds__(NTHREADS, 2) fwd_kernel(Args args) {
    extern __shared__ __attribute__((aligned(16))) unsigned char lds[];
    Frame F;
    F.lds = (LAS unsigned char*)lds;
    F.MISC = (volatile LAS unsigned*)(F.lds + MISC_OFF);
    F.tid = threadIdx.x; F.lane = F.tid & 63; F.wave = __builtin_amdgcn_readfirstlane(F.tid >> 6);
    F.G = gridDim.x; { const int bx = blockIdx.x; F.vcu = (F.G % 8 == 0) ? (bx % 8) * (F.G / 8) + bx / 8 : bx; }
    F.ws = args.ws; F.ctl = (unsigned*)(args.ws + WS_CTL); F.vec = (float*)(args.ws + WS_VEC);
    for (int u = F.tid; u < 256; u += NTHREADS) ((LAS unsigned*)(F.lds + MISC_OFF))[u] = 0u;
    __syncthreads();
    XcdBarrier bar = xcd_barrier_post(F.ctl + CW_BAR, F.MISC + 8);
    unsigned char* ws = args.ws;

#define PH_MOD()   do { phase_mod(F, args); } while (0)
#define PH_PREP1() do { phase_prep1(F, args); } while (0)
#define PH_HROWS() do { phase_hrows(F, args); } while (0)
#define PH_INPROJ() do { { DenseGemm g; g.init(T, 6144, F.G, (int)blockIdx.x); g.A = (const char*)(ws + WS_H); g.Bt = (const char*)(ws + WS_WIN); g.lda2 = D * 2; g.ldb2 = D * 2; g.nt = D / 64; \
          EpiInProj<0> E{ws}; pg8::gemm_phase<DenseGemm, EpiInProj<0>>(F.lds, g, E); } \
        { DenseGemm g; g.init(T, 5120, F.G, (int)blockIdx.x); g.A = (const char*)(ws + WS_H8); g.Bt = (const char*)(ws + WS_WIN8); g.lda2 = D; g.ldb2 = D; g.nt = D / 128; \
          EpiInProj<1> E{ws}; pg8::gemm_phase<DenseGemm, EpiInProj<1>, true>(F.lds, g, E); } } while (0)
#define PH_H1()    do { phase_h1(F); } while (0)
#define PH_QKP()   do { phase_qkprep(F, args); } while (0)
#define PH_H2()    do { phase_h2(F); } while (0)
#define PH_H3()    do { phase_h3(F, args); } while (0)
#define PH_ATTN()  do { phase_attn(F, args, 0, 4); } while (0)
#define PH_MERGE() do { DenseGemm g; g.init(T, D, F.G, (int)blockIdx.x); g.A = (const char*)(ws + WS_BR); g.Bt = (const char*)(ws + WS_WA); g.lda2 = D * 2; g.ldb2 = D * 2; g.nt = D / 64; \
        EpiMergeF E{ws}; pg8::gemm_phase<DenseGemm, EpiMergeF>(F.lds, g, E); } while (0)
#define PH_OUTPROJ() do { DenseGemm g; g.init(T, D, F.G, (int)blockIdx.x); g.A = (const char*)(ws + WS_MERGED); g.Bt = (const char*)(ws + WS_WOUT); g.lda2 = D * 2; g.ldb2 = D * 2; g.nt = D / 64; \
        EpiOutProj E{args.in[IN_X], (bf16*)(ws + WS_X1B), (const float*)(F.ctl + CW_MOD)}; pg8::gemm_phase<DenseGemm, EpiOutProj>(F.lds, g, E); } while (0)
#define PH_ROUTER() do { phase_router(F, args); } while (0)
#define PH_CONVX()  do { phase_convert_experts(F, args); } while (0)
#define PH_MOE1()  do { MoeGemm1 g; g.tb = (LAS int*)(F.lds + MOE_TB); g.G = F.G; g.c = F.vcu; g.ws = ws; g.lda2 = D; g.ldb2 = D; g.nt = D / 128; \
        EpiSwiglu E{ws, (LAS int*)(F.lds + MOE_TB)}; pg8::gemm_phase<MoeGemm1, EpiSwiglu, true>(F.lds, g, E); } while (0)
#define PH_MOE2()  do { MoeGemm2 g; g.tb = (LAS int*)(F.lds + MOE_TB); g.G = F.G; g.c = F.vcu; g.ws = ws; g.lda2 = DEXP; g.ldb2 = DEXP; g.nt = DEXP / 128; \
        EpiDown E{ws, args.out, (const float*)(F.ctl + CW_MOD)}; pg8::gemm_phase<MoeGemm2, EpiDown, true>(F.lds, g, E); } while (0)
#define PH_COMBINE() do { phase_combine(F, args); } while (0)
#ifndef REPEAT_PHASE
#define REPEAT_PHASE -1
#endif
#define RUN(k, X) do { X; if (REPEAT_PHASE == (k)) { xcd_barrier(bar); X; } } while (0)
    if (F.vcu & 1) { PH_PREP1(); __syncthreads(); PH_MOD(); } else { PH_MOD(); __syncthreads(); PH_PREP1(); }
    xcd_barrier(bar);
    RUN(1, PH_HROWS());    xcd_barrier(bar);
    RUN(2, PH_INPROJ());   xcd_barrier(bar);
    if (F.vcu & 1) { PH_QKP(); PH_H1(); } else { PH_H1(); PH_QKP(); }
    xcd_barrier(bar);
    PH_H2();
    xcd_barrier(bar);
    PH_H3(); phase_attn(F, args, 0, 4);
    xcd_barrier(bar);
    RUN(8, PH_MERGE());    xcd_barrier(bar);
    RUN(9, PH_OUTPROJ());  xcd_barrier(bar);
    PH_ROUTER();           xcd_barrier(bar);
    moe_build_table(F);
    RUN(11, PH_MOE1());    xcd_barrier(bar);
    PH_MOE2();             xcd_barrier(bar);
    PH_COMBINE();
}

extern "C" void kernel_launch(void* const* d_in, const int* in_sizes, int n_in, void* d_out, int out_size, void* d_ws, size_t ws_size, hipStream_t stream) {
    static int grid = 0;
    if (grid == 0) {
        int dev = 0, cus = 0;
        if (n_in != 28 || ws_size < WS_NEED || out_size != T * D) { fprintf(stderr, "kernel_launch: unexpected n_in %d / ws %zu / out %d\n", n_in, ws_size, out_size); grid = -1; return; }
        if (hipGetDevice(&dev) != hipSuccess || hipDeviceGetAttribute(&cus, hipDeviceAttributeMultiprocessorCount, dev) != hipSuccess) { grid = -1; return; }
        if (hipFuncSetAttribute((const void*)fwd_kernel, hipFuncAttributeMaxDynamicSharedMemorySize, LDS_BYTES) != hipSuccess) { grid = -1; return; }
        int per_cu = 0;
        (void)hipOccupancyMaxActiveBlocksPerMultiprocessor(&per_cu, (const void*)fwd_kernel, NTHREADS, LDS_BYTES);
        (void)hipGetLastError();
        grid = cus;
        if (cus != 256) { fprintf(stderr, "kernel_launch: built for a 256-CU MI355X (static work split), found %d CUs; nothing launched\n", cus); grid = -1; return; }
    }
    if (grid < 0) return;
    if (hipMemsetAsync((char*)d_ws + WS_CTL, 0, CTL_ZERO_BYTES, stream) != hipSuccess) return;
    Args a{};
    for (int i = 0; i < 28; ++i) a.in[i] = (const float*)d_in[i];
    a.out = (float*)d_out; a.ws = (unsigned char*)d_ws; a.ph_lo = 0; a.ph_hi = 100;
    hipLaunchKernelGGL(fwd_kernel, dim3(grid), dim3(NTHREADS), LDS_BYTES, stream, a);
}
```

```cpp
#include <hip/hip_runtime.h>
#include <cstdio>
#include <cstdint>

#define GAS __attribute__((address_space(1)))
#define LAS __attribute__((address_space(3)))
typedef unsigned short bf16;
typedef unsigned v4u __attribute__((ext_vector_type(4)));
typedef unsigned v2u __attribute__((ext_vector_type(2)));
typedef float f32x4 __attribute__((ext_vector_type(4)));
typedef float f32x2 __attribute__((ext_vector_type(2)));
typedef float f32x16 __attribute__((ext_vector_type(16)));
typedef short bf16x8 __attribute__((ext_vector_type(8)));
typedef short s16x4 __attribute__((ext_vector_type(4)));
typedef int i32x4 __attribute__((ext_vector_type(4)));
typedef int i32x8 __attribute__((ext_vector_type(8)));

#ifndef STAGE_MAX
#define STAGE_MAX 99
#endif

constexpr int D = 2048, BATCH = 4, SEQ = 4096, T = BATCH * SEQ;
constexpr int HGH = 8, HGD = 128, CHUNK = 64, NCHUNK = SEQ / CHUNK;
constexpr int NCH_UNITS = BATCH * HGH * NCHUNK;
constexpr int DAH = 8, DADH = 64, DADV = 128;
constexpr int INCOLS = 11264;
constexpr int NEXP = 64, TOPK = 8, DEXP = 512;
constexpr float EPS = 1e-6f;
constexpr float LOG2E = 1.4426950408889634f;
constexpr float LAMBDA_INIT = 0.2f;
constexpr int NWAVES = 8, NTHREADS = NWAVES * 64;
constexpr int LDS_BYTES = 147456;
constexpr int MISC_OFF = 131072;

constexpr size_t MiB = 1u << 20;
constexpr size_t WS_CTL = 0, CTL_ZERO_BYTES = 1 * MiB;
constexpr size_t WS_VEC = 1 * MiB;
constexpr size_t WS_LTOK = 2 * MiB, WS_LW = 6 * MiB;
constexpr size_t WS_WSH = 10 * MiB;
constexpr size_t WS_WIN = 16 * MiB;
constexpr size_t WS_WIN8 = 40 * MiB;
constexpr size_t WS_H8 = 848 * MiB;
constexpr size_t WS_WA = 60 * MiB, WS_WB = 64 * MiB;
constexpr size_t WS_WOUT = 68 * MiB;
constexpr size_t WS_H = 76 * MiB;
constexpr size_t WS_PROJ = 140 * MiB;
constexpr size_t WS_HQ = WS_PROJ, WS_HF = WS_PROJ + 32 * MiB, WS_HI = WS_PROJ + 64 * MiB, WS_HG = WS_PROJ + 96 * MiB;
constexpr size_t WS_DQ = WS_PROJ + 128 * MiB, WS_DK = WS_PROJ + 160 * MiB, WS_DV = WS_PROJ + 192 * MiB;
constexpr size_t WS_GA = WS_PROJ + 224 * MiB, WS_GB = WS_PROJ + 288 * MiB;
constexpr size_t WS_ST = 492 * MiB;
constexpr size_t WS_DEC = 556 * MiB;
constexpr size_t WS_OI = 560 * MiB;
constexpr size_t WS_BR = 624 * MiB;
constexpr size_t WS_MERGED = 688 * MiB;
constexpr size_t WS_QT = 752 * MiB;
constexpr size_t WS_DQN = 784 * MiB, WS_DKN = 816 * MiB;
constexpr size_t WS_WDOWN = 882 * MiB;
constexpr size_t WS_ACT = 144 * MiB;
constexpr size_t WS_WG = 946 * MiB, WS_WU = 1010 * MiB;
constexpr size_t WS_H2 = 546 * MiB;
constexpr size_t WS_Y = 290 * MiB;
constexpr float Y8_SCALE = 32.0f;
constexpr size_t WS_X1B = WS_H;
constexpr size_t WS_YSH = WS_BR;
constexpr size_t WS_NEED = 1074 * MiB;

constexpr int CW_BAR = 4096;
constexpr int CW_CNT = 8192;
constexpr int CW_MOD = 16384;
constexpr int VW_LB = 0;
constexpr int VW_LAM = 1024, VW_M2 = 1025;
constexpr int VW_TBL = 2048;
constexpr size_t WS_RWT_HI = WS_VEC + 65536, WS_RWT_LO = WS_VEC + 65536 + 262144;

#define RLX_AGENT __ATOMIC_RELAXED, __HIP_MEMORY_SCOPE_AGENT
#define LDS_WAIT() asm volatile("s_waitcnt lgkmcnt(0)" ::: "memory")
#define VM_WAIT() asm volatile("s_waitcnt vmcnt(0)" ::: "memory")
__device__ __forceinline__ unsigned f2bf_sw(float f) { unsigned u = __builtin_bit_cast(unsigned, f); return (u + 0x7fffu + ((u >> 16) & 1u)) >> 16; }
typedef __bf16 bf16x2v __attribute__((ext_vector_type(2)));
__device__ __forceinline__ unsigned pk2(float lo, float hi) { const f32x2 v = {lo, hi}; return __builtin_bit_cast(unsigned, __builtin_convertvector(v, bf16x2v)); }
__device__ __forceinline__ unsigned f2bf(float f) { return (unsigned)__builtin_bit_cast(unsigned short, (__bf16)f); }
__device__ __forceinline__ float bf2f(unsigned b) { return __builtin_bit_cast(float, b << 16); }
__device__ __forceinline__ float bflo(unsigned w) { return __builtin_bit_cast(float, w << 16); }
__device__ __forceinline__ float bfhi(unsigned w) { return __builtin_bit_cast(float, w & 0xffff0000u); }
__device__ __forceinline__ float fsigmoid(float x) { return __builtin_amdgcn_rcpf(1.0f + __expf(-x)); }
__device__ __forceinline__ float wave_sum(float v) {
#pragma unroll
    for (int o = 1; o < 64; o <<= 1) v += __shfl_xor(v, o);
    return v;
}

#define XB_TMO      128
#define XB_XCNT(j)  (256  + 64 * (j))
#define XB_XSUB(j)  (1280 + 64 * (j))
#define XB_XGEN(j)  (2304 + 64 * (j))
#define XB_TOP      3328
#define XB_TOPGEN   3392
#define XCD_BAR_WORDS 3456
#define XB_SPIN_CAP (1u << 18)
__device__ __forceinline__ unsigned xb_ld(unsigned* p)              { return __hip_atomic_load(p, __ATOMIC_RELAXED, __HIP_MEMORY_SCOPE_AGENT); }
__device__ __forceinline__ unsigned xb_add(unsigned* p, unsigned v) { return __hip_atomic_fetch_add(p, v, __ATOMIC_RELAXED, __HIP_MEMORY_SCOPE_AGENT); }
__device__ __forceinline__ unsigned xb_xcc_id() { return (unsigned)__builtin_amdgcn_s_getreg((3 << 11) | 20) & 0xFu; }
#define XB_SPIN(cond, bar) do { unsigned _sp = 0; while (cond) { __builtin_amdgcn_s_sleep(1); \
    if ((++_sp & 255u) == 0u) { if (xb_ld(&(bar)[XB_TMO])) break; if (_sp > XB_SPIN_CAP) { atomicAdd(&(bar)[XB_TMO], 1u); break; } } } } while (0)
struct XcdBarrier { unsigned* bar; unsigned x; volatile LAS unsigned* st; };
__device__ __forceinline__ XcdBarrier xcd_barrier_post(unsigned* bar, volatile LAS unsigned* st) {
    XcdBarrier b; b.bar = bar; b.x = xb_xcc_id(); b.st = st;
    if (threadIdx.x == 0) (void)xb_add(&bar[XB_XCNT(b.x)], 1u);
    return b;
}
__device__ __forceinline__ void xcd_barrier_complete(unsigned* bar, unsigned x, unsigned& nloc, unsigned& nx) {
    const unsigned G = gridDim.x * gridDim.y * gridDim.z;
    unsigned sum, cnt, mine, sp = 0u;
    for (;;) {
        sum = 0u; cnt = 0u; mine = 0u;
#pragma unroll
        for (unsigned j = 0; j < 16; ++j) { const unsigned c = xb_ld(&bar[XB_XCNT(j)]); sum += c; cnt += (c > 0u) ? 1u : 0u; mine = (j == x) ? c : mine; }
        if (sum == G) break;
        __builtin_amdgcn_s_sleep(1);
        if ((++sp & 255u) == 0u) { if (xb_ld(&bar[XB_TMO])) break; if (sp > XB_SPIN_CAP) { atomicAdd(&bar[XB_TMO], 1u); break; } }
    }
    nloc = mine > 0u ? mine : 1u; nx = cnt > 0u ? cnt : 1u;
}
__device__ __forceinline__ void xcd_barrier(const XcdBarrier& b) {
    asm volatile("s_waitcnt vmcnt(0)" ::: "memory");
    __syncthreads();
    if (threadIdx.x == 0) {
        unsigned* bar = b.bar;
        __builtin_amdgcn_s_waitcnt(0);
        unsigned nloc = b.st[0], nx = b.st[1];
        if (nloc == 0u) { xcd_barrier_complete(bar, b.x, nloc, nx); b.st[0] = nloc; b.st[1] = nx; }
        const unsigned old = xb_add(&bar[XB_XSUB(b.x)], 1u);
        const unsigned gen = old / nloc;
        if (old + 1u == (gen + 1u) * nloc) {
            __builtin_amdgcn_fence(__ATOMIC_RELEASE, "agent");
            asm volatile("s_waitcnt vmcnt(0)" ::: "memory");
            const unsigned og = xb_add(&bar[XB_TOP], 1u);
            const unsigned tg = og / nx;
            if (og + 1u == (tg + 1u) * nx) xb_add(&bar[XB_TOPGEN], 1u);
            else XB_SPIN(xb_ld(&bar[XB_TOPGEN]) == tg, bar);
            __builtin_amdgcn_fence(__ATOMIC_ACQUIRE, "agent");
            xb_add(&bar[XB_XGEN(b.x)], 1u);
            asm volatile("s_waitcnt vmcnt(0)" ::: "memory");
        } else {
            XB_SPIN(xb_ld(&bar[XB_XGEN(b.x)]) == gen, bar);
            __builtin_amdgcn_fence(__ATOMIC_ACQUIRE, "agent");
            asm volatile("s_waitcnt vmcnt(0)" ::: "memory");
        }
    }
    __syncthreads();
}

namespace pg8 {
constexpr int BM = 256, BK = 64, HALF = 128, HTB = HALF * BK * 2, STAGE_BYTES = 8 * HTB, NXCD = 8, WGM = 8;
__host__ __device__ __forceinline__ int lds_byte(int r, int c) { const int st = (r >> 4) * 2 + (c >> 5), rr = r & 15, cc = c & 31, ob = rr * 64 + cc * 2; return st * 1024 + (ob ^ (((ob >> 9) & 1) << 5)); }
__host__ __device__ __forceinline__ void stage_rc(int b, int& R, int& C) { const int st = b / 1024, sb = b % 1024, swz = sb ^ (((sb >> 9) & 1) << 5); R = (st >> 1) * 16 + swz / 64; C = (st & 1) * 32 + (swz % 64) / 2; }
__host__ __device__ __forceinline__ int perm32(int rho) { const int n = rho >> 4, i = rho & 15; return 8 * (i >> 2) + 4 * n + (i & 3); }
__device__ __forceinline__ unsigned cvt_pk_bf16(float lo, float hi) { unsigned r; asm volatile("v_cvt_pk_bf16_f32 %0, %1, %2" : "=v"(r) : "v"(lo), "v"(hi)); return r; }

struct Unit { int pm, pn, e, cnt; };

struct DenseOrder {
    int nM, nN, nwg, G, c;
    __device__ void init(int M, int N, int G_, int c_) { nM = M / BM; nN = N / BM; nwg = nM * nN; G = G_; c = c_; }
    __device__ bool next(int i, Unit& u) const {
        const long L = (long)i * G + c; if (L >= nwg) return false;
        int wgid = (int)L; { const int q = nwg / NXCD, r = nwg % NXCD, xcd = wgid % NXCD, off = wgid / NXCD; wgid = (xcd < r ? xcd * (q + 1) : r * (q + 1) + (xcd - r) * q) + off; }
        const int nig = WGM * nN, gid = wgid / nig, fm = gid * WGM, gsz = (nM - fm) < WGM ? (nM - fm) : WGM;
        u.pm = fm + ((wgid % nig) % gsz); u.pn = (wgid % nig) / gsz; u.e = 0; u.cnt = 256; return true;
    }
};

template <class P, class Epi, bool FP8 = false>
__device__ __forceinline__ void gemm_phase(LAS unsigned char* lds, const P& S, const Epi& E) {
    int tid_ = threadIdx.x; asm volatile("" : "+v"(tid_));
    const int tid = tid_, wid = __builtin_amdgcn_readfirstlane(tid >> 6), lane = tid & 63, wr = wid >> 2, wc = wid & 3, fr = lane & 15, fq = lane >> 4;
    const int nt = S.nt;
    unsigned voffA[2], voffB[2];
    { int R0, C0, R1, C1; stage_rc(tid * 16, R0, C0); stage_rc(tid * 16 + 8192, R1, C1);
      const int Rb0 = Epi::PERM ? ((R0 & ~31) + perm32(R0 & 31)) : R0, Rb1 = Epi::PERM ? ((R1 & ~31) + perm32(R1 & 31)) : R1;
      voffB[0] = (unsigned)Rb0 * S.ldb2 + (unsigned)C0 * 2u; voffB[1] = (unsigned)Rb1 * S.ldb2 + (unsigned)C1 * 2u;
      if constexpr (!P::GATHER) { voffA[0] = (unsigned)R0 * S.lda2 + (unsigned)C0 * 2u; voffA[1] = (unsigned)R1 * S.lda2 + (unsigned)C1 * 2u; } else { voffA[0] = 0u; voffA[1] = 0u; } }
    const unsigned ldsw = (unsigned)wid * 1024u;
    const int aoff = lds_byte(wr * 64 + fr, fq * 8), boff = lds_byte(wc * 32 + fr, fq * 8);
#define PG8_SA(b, h) (((b) * 2 + (h)) * HTB)
#define PG8_SB(b, h) ((4 + (b) * 2 + (h)) * HTB)
#define PG8_STAGE_A(bufoff, aptr, koff, h) do { _Pragma("unroll") for (int _i = 0; _i < 2; ++_i) { \
        const char* _src; if constexpr (P::GATHER) _src = (aptr) + (size_t)ga[h][_i] + (size_t)(koff); else _src = (aptr) + (size_t)(h) * hstepA + (size_t)voffA[_i] + (size_t)(koff); \
        __builtin_amdgcn_global_load_lds((const unsigned*)_src, (LAS unsigned*)(lds + (bufoff) + ldsw + _i * 8192), 16, 0, 0); } } while (0)
#define PG8_STAGE_B(bufoff, bptr) do { _Pragma("unroll") for (int _i = 0; _i < 2; ++_i) \
        __builtin_amdgcn_global_load_lds((const unsigned*)((bptr) + voffB[_i]), (LAS unsigned*)(lds + (bufoff) + ldsw + _i * 8192), 16, 0, 0); } while (0)
#define PG8_LD16(off) (*(const LAS i32x4*)(lds + (off)))
#define PG8_LDA(dst, b, h) do { _Pragma("unroll") for (int m = 0; m < 4; ++m) { \
        if constexpr (FP8) { const i32x4 _l = PG8_LD16(PG8_SA(b, h) + aoff + m * 2048), _h = PG8_LD16(PG8_SA(b, h) + aoff + m * 2048 + 1024); dst[m] = __builtin_shufflevector(_l, _h, 0, 1, 2, 3, 4, 5, 6, 7); } \
        else { dst##16[m][0] = *(const LAS bf16x8*)(lds + PG8_SA(b, h) + aoff + m * 2048); dst##16[m][1] = *(const LAS bf16x8*)(lds + PG8_SA(b, h) + aoff + m * 2048 + 1024); } } } while (0)
#define PG8_LDB(dst, b, h) do { _Pragma("unroll") for (int n = 0; n < 2; ++n) { \
        if constexpr (FP8) { const i32x4 _l = PG8_LD16(PG8_SB(b, h) + boff + n * 2048), _h = PG8_LD16(PG8_SB(b, h) + boff + n * 2048 + 1024); dst[n] = __builtin_shufflevector(_l, _h, 0, 1, 2, 3, 4, 5, 6, 7); } \
        else { dst##16[n][0] = *(const LAS bf16x8*)(lds + PG8_SB(b, h) + boff + n * 2048); dst##16[n][1] = *(const LAS bf16x8*)(lds + PG8_SB(b, h) + boff + n * 2048 + 1024); } } } while (0)
#define PG8_MMA(ai, bj, At, Bt) do { __builtin_amdgcn_s_setprio(1); _Pragma("unroll") for (int m = 0; m < 4; ++m) _Pragma("unroll") for (int n = 0; n < 2; ++n) { \
        if constexpr (FP8) {   \
            asm volatile("v_mfma_scale_f32_16x16x128_f8f6f4 %0, %1, %2, %0, %3, %4 op_sel_hi:[0,0,0]" : "+v"(acc[ai][bj][m][n]) : "v"(Bt[n]), "v"(At[m]), "v"(scw), "v"(scx)); \
        } else { _Pragma("unroll") for (int k = 0; k < 2; ++k) \
            acc[ai][bj][m][n] = __builtin_amdgcn_mfma_f32_16x16x32_bf16(Bt##16[n][k], At##16[m][k], acc[ai][bj][m][n], 0, 0, 0); } } \
        __builtin_amdgcn_s_setprio(0); } while (0)
#define PG8_WAIT_V(n) asm volatile("s_waitcnt vmcnt(" #n ")" ::: "memory")
#define PG8_WAIT_L(n) asm volatile("s_waitcnt lgkmcnt(" #n ")" ::: "memory")
#define PG8_BAR __builtin_amdgcn_s_barrier()
#define PG8_SCHED __builtin_amdgcn_sched_barrier(0)
    Unit cur, nxt; int ui = 0;
    if (!S.next(0, cur)) return;
    f32x4 acc[2][2][4][2];
#pragma unroll
    for (int a = 0; a < 2; ++a)
#pragma unroll
        for (int b = 0; b < 2; ++b)
#pragma unroll
            for (int m = 0; m < 4; ++m)
#pragma unroll
                for (int n = 0; n < 2; ++n) acc[a][b][m][n] = (f32x4){0.f, 0.f, 0.f, 0.f};
    const int scw = 0x7a7a7a7a, scx = 0x7f7f7f7f;
    i32x8 At[4], B0[2], B1[2]; bf16x8 At16[4][2], B016[2][2], B116[2][2];
    unsigned ga[2][2] = {{0u, 0u}, {0u, 0u}};
    const size_t hstepA = P::GATHER ? (size_t)0 : (size_t)128 * S.lda2;
    const char *cA, *nA, *cB0, *cB1, *nB0, *nB1;
    cA = S.aptr(cur); if constexpr (P::GATHER) S.aoffs(cur, tid, ga);
    S.bptrs(cur, cB0, cB1);
    const size_t kstep = (size_t)(BK * 2);
    PG8_STAGE_B(PG8_SB(0, 0), cB0); PG8_STAGE_B(PG8_SB(0, 1), cB1); PG8_STAGE_A(PG8_SA(0, 0), cA, 0, 0); PG8_STAGE_A(PG8_SA(0, 1), cA, 0, 1);
    if (wr == 1) PG8_BAR;
    PG8_WAIT_V(2); PG8_BAR;
    PG8_STAGE_B(PG8_SB(1, 0), cB0 + kstep); PG8_STAGE_A(PG8_SA(1, 0), cA, kstep, 0); PG8_STAGE_B(PG8_SB(1, 1), cB1 + kstep);
    PG8_WAIT_V(6); PG8_BAR;
    for (;;) {
        const bool has_next = S.next(ui + 1, nxt);
        if (has_next) { nA = S.aptr(nxt); S.bptrs(nxt, nB0, nB1); } else { nxt = cur; nA = cA; nB0 = cB0; nB1 = cB1; }
        for (int t = 0; t < nt; t += 2) {
            if constexpr (Epi::MIDK) { if (t == (nt >> 1)) E.mid(acc, cur, wr, wc, fr, fq); }
            const bool last = (t == nt - 2);
            const size_t k1 = (size_t)(t + 1) * kstep;
            const size_t k2 = last ? (size_t)0 : (size_t)(t + 2) * kstep, k3 = k2 + kstep;
            const char* a2 = last ? nA : cA;
            const char* b20 = (last ? nB0 : cB0) + k2; const char* b21 = (last ? nB1 : cB1) + k2;
            const char* b30 = b20 + kstep; const char* b31 = b21 + kstep;
            PG8_LDB(B0, 0, 0); PG8_LDB(B1, 0, 1); PG8_SCHED; PG8_LDA(At, 0, 0); PG8_STAGE_A(PG8_SA(1, 1), cA, k1, 1);
            if constexpr (P::GATHER) { if (last && has_next) S.aoffs(nxt, tid, ga); }
            PG8_WAIT_V(8); PG8_WAIT_L(0); PG8_BAR; PG8_MMA(0, 0, At, B0); PG8_MMA(0, 1, At, B1); PG8_BAR; PG8_SCHED;
            PG8_LDA(At, 0, 1); PG8_STAGE_B(PG8_SB(0, 0), b20); PG8_STAGE_B(PG8_SB(0, 1), b21); PG8_STAGE_A(PG8_SA(0, 0), a2, k2, 0);
            PG8_WAIT_V(8); PG8_WAIT_L(0); PG8_BAR; PG8_MMA(1, 0, At, B0); PG8_MMA(1, 1, At, B1); PG8_BAR; PG8_SCHED;
            PG8_LDB(B0, 1, 0); PG8_LDB(B1, 1, 1); PG8_SCHED; PG8_LDA(At, 1, 0); PG8_STAGE_A(PG8_SA(0, 1), a2, k2, 1);
            PG8_WAIT_V(8); PG8_WAIT_L(0); PG8_BAR; PG8_MMA(0, 0, At, B0); PG8_MMA(0, 1, At, B1); PG8_BAR; PG8_SCHED;
            PG8_LDA(At, 1, 1); PG8_STAGE_B(PG8_SB(1, 0), b30); PG8_STAGE_B(PG8_SB(1, 1), b31); PG8_STAGE_A(PG8_SA(1, 0), a2, k3, 0);
            PG8_WAIT_V(8); PG8_WAIT_L(0); PG8_BAR; PG8_MMA(1, 0, At, B0); PG8_MMA(1, 1, At, B1); PG8_BAR; PG8_SCHED;
        }
        if (wr == 0) PG8_BAR;
        if constexpr (FP8) asm volatile("s_nop 15\n\ts_nop 15" ::: "memory");
        E(acc, cur, wr, wc, fr, fq);
        if (!has_next) break;
#pragma unroll
        for (int a = 0; a < 2; ++a)
#pragma unroll
            for (int b = 0; b < 2; ++b)
#pragma unroll
                for (int m = 0; m < 4; ++m)
#pragma unroll
                    for (int n = 0; n < 2; ++n) acc[a][b][m][n] = (f32x4){0.f, 0.f, 0.f, 0.f};
        cur = nxt; cA = nA; cB0 = nB0; cB1 = nB1; ++ui;
        if (wr == 1) PG8_BAR;
    }
    PG8_WAIT_V(0);
    PG8_BAR;
#undef PG8_SA
#undef PG8_SB
#undef PG8_STAGE_A
#undef PG8_STAGE_B
#undef PG8_LD16
#undef PG8_LDA
#undef PG8_LDB
#undef PG8_MMA
#undef PG8_WAIT_V
#undef PG8_WAIT_L
#undef PG8_BAR
#undef PG8_SCHED
}
}

struct Args { const float* in[28]; float* out; unsigned char* ws; int ph_lo, ph_hi; };
enum { IN_X = 0, IN_C, IN_ADAW, IN_ADAB, IN_N1G, IN_WIN, IN_LBL, IN_HGNG, IN_QNG, IN_KNG, IN_LQ1, IN_LK1, IN_LQ2, IN_LK2, IN_DANG, IN_RELB, IN_WA, IN_WB, IN_WOUT,
       IN_N2G, IN_RW, IN_RB, IN_EG, IN_EU, IN_ED, IN_SG, IN_SU, IN_SD };

struct Frame {
    LAS unsigned char* lds;
    volatile LAS unsigned* MISC;
    unsigned* ctl; float* vec;
    int tid, lane, wave, vcu, G;
    unsigned char* ws;
};


__device__ __forceinline__ unsigned pk4_fp8(float a, float b, float c, float d) { int p = 0; p = __builtin_amdgcn_cvt_pk_fp8_f32(a, b, p, false); p = __builtin_amdgcn_cvt_pk_fp8_f32(c, d, p, true); return (unsigned)p; }
constexpr float W8_SCALE = 32.0f;
#define OPAQUE_V(x) asm volatile("" : "+v"(x))
struct LaneT { int r2, c2, bsrc;
    __device__ __forceinline__ LaneT(int fr, int fq) { const int L = fr + 16 * fq; r2 = L >> 2; c2 = L & 3; bsrc = ((c2 << 4) | r2) << 2; }
    __device__ __forceinline__ unsigned t1(unsigned w) const { return (unsigned)__builtin_amdgcn_ds_bpermute(bsrc, (int)w); }
    __device__ __forceinline__ v2u t2(const v2u w) const { v2u r; r.x = t1(w.x); r.y = t1(w.y); return r; }
    __device__ __forceinline__ v4u t4(const v4u w) const { v4u r; r.x = t1(w.x); r.y = t1(w.y); r.z = t1(w.z); r.w = t1(w.w); return r; }
};
#define PHASE_IDS() int tid_ = threadIdx.x; asm volatile("" : "+v"(tid_)); const int tid = tid_, lane = tid & 63, wid = __builtin_amdgcn_readfirstlane(tid >> 6); (void)lane; (void)wid
struct TrItem { const float* src; int N; unsigned char* dst; int ldb; int fp8; };
__device__ __forceinline__ void tr_load(const TrItem& it, int lane, f32x4 (&v)[8]) {
#pragma unroll
    for (int i = 0; i < 8; ++i) v[i] = *(const GAS f32x4*)(it.src + (size_t)(8 * i + (lane >> 3)) * it.N + 4 * (lane & 7));
}
__device__ __forceinline__ void tr_finish(const TrItem& it, int lane, LAS float* scr, const f32x4 (&v)[8]) {
    const int q = lane & 7;
#pragma unroll
    for (int i = 0; i < 8; ++i) { const int kk = 8 * i + (lane >> 3);
        scr[(4 * q + 0) * 68 + kk] = v[i].x; scr[(4 * q + 1) * 68 + kk] = v[i].y; scr[(4 * q + 2) * 68 + kk] = v[i].z; scr[(4 * q + 3) * 68 + kk] = v[i].w; }
    LDS_WAIT(); asm volatile("" ::: "memory");
    const int n = lane >> 1, kh = lane & 1; const LAS float* s = scr + n * 68 + 32 * kh;
    f32x4 x[8];
#pragma unroll
    for (int j = 0; j < 8; ++j) x[j] = *(const LAS f32x4*)(s + 4 * j);
    if (it.fp8) {
        unsigned o[8];
#pragma unroll
        for (int j = 0; j < 8; ++j) o[j] = pk4_fp8(x[j].x * W8_SCALE, x[j].y * W8_SCALE, x[j].z * W8_SCALE, x[j].w * W8_SCALE);
        GAS v4u* d = (GAS v4u*)(it.dst + (size_t)n * it.ldb + 32 * kh);
        d[0] = (v4u){o[0], o[1], o[2], o[3]}; d[1] = (v4u){o[4], o[5], o[6], o[7]};
    } else {
        unsigned o[16];
#pragma unroll
        for (int j = 0; j < 8; ++j) { o[2 * j] = pk2(x[j].x, x[j].y); o[2 * j + 1] = pk2(x[j].z, x[j].w); }
        GAS v4u* d = (GAS v4u*)(it.dst + (size_t)n * it.ldb + 64 * kh);
#pragma unroll
        for (int j = 0; j < 4; ++j) d[j] = (v4u){o[4 * j], o[4 * j + 1], o[4 * j + 2], o[4 * j + 3]};
    }
    LDS_WAIT(); asm volatile("" ::: "memory");
}
#define TR_PAIR(itA, hasB, itB, lane, scr) do { f32x4 _va[8], _vb[8]; tr_load(itA, lane, _va); if (hasB) tr_load(itB, lane, _vb); tr_finish(itA, lane, scr, _va); if (hasB) tr_finish(itB, lane, scr, _vb); } while (0)

__device__ __forceinline__ void transpose_item(const float* W, int N, bf16* WT, int ldt, int koff, int row_off, LAS float* scr, int item, int lane) {
    const int nblk = N / 32, kb = item / nblk, nb = item % nblk, k0 = 64 * kb, n0 = 32 * nb;
#pragma unroll 8
    for (int i = 0; i < 32; ++i) { const int kk = 2 * i + (lane >> 5); scr[kk * 33 + (lane & 31)] = W[(size_t)(k0 + kk) * N + n0 + (lane & 31)]; }
    LDS_WAIT(); asm volatile("" ::: "memory");
    const int c = lane & 7;
#pragma unroll
    for (int j = 0; j < 4; ++j) { const int n = (lane >> 3) + 8 * j; const LAS float* s = scr + (8 * c) * 33 + n;
        v4u o; o.x = pk2(s[0 * 33], s[1 * 33]); o.y = pk2(s[2 * 33], s[3 * 33]); o.z = pk2(s[4 * 33], s[5 * 33]); o.w = pk2(s[6 * 33], s[7 * 33]);
        *(GAS v4u*)(WT + (size_t)(row_off + n0 + n) * ldt + koff + k0 + 8 * c) = o; }
    LDS_WAIT(); asm volatile("" ::: "memory");
}

__device__ __forceinline__ void transpose_item_fp8(const float* W, int N, unsigned char* WT, int ldt, LAS float* scr, int kb, int nb, int lane) {
    const int k0 = 64 * kb, n0 = 32 * nb;
#pragma unroll 8
    for (int i = 0; i < 32; ++i) { const int kk = 2 * i + (lane >> 5); scr[kk * 33 + (lane & 31)] = W[(size_t)(k0 + kk) * N + n0 + (lane & 31)]; }
    LDS_WAIT(); asm volatile("" ::: "memory");
    const int n = lane >> 1, kh = lane & 1; const LAS float* s = scr + (32 * kh) * 33 + n;
    unsigned o[8];
#pragma unroll
    for (int q = 0; q < 8; ++q) o[q] = pk4_fp8(s[(4 * q) * 33] * W8_SCALE, s[(4 * q + 1) * 33] * W8_SCALE, s[(4 * q + 2) * 33] * W8_SCALE, s[(4 * q + 3) * 33] * W8_SCALE);
    GAS v4u* dst = (GAS v4u*)(WT + (size_t)(n0 + n) * ldt + k0 + 32 * kh);
    dst[0] = (v4u){o[0], o[1], o[2], o[3]}; dst[1] = (v4u){o[4], o[5], o[6], o[7]};
    LDS_WAIT(); asm volatile("" ::: "memory");
}

__device__ __forceinline__ void phase_mod(Frame& F, const Args& a) {
    const float* c = a.in[IN_C]; const float* W = a.in[IN_ADAW]; const float* bia = a.in[IN_ADAB];
    PHASE_IDS();
    LAS float* cact = (LAS float*)F.lds;
    for (int i = tid; i < 4 * D; i += NTHREADS) { const float v = c[i]; cact[i] = v * fsigmoid(v); }
    __syncthreads();
    float* mod = (float*)(F.ctl + CW_MOD);
    LAS float* RED = (LAS float*)(F.lds + 32768);
    for (int cg = blockIdx.x; cg < 256; cg += F.G) {
        const int cq = tid % 12, dg = tid / 12, n = cg * 48 + cq * 4;
        if (dg < 42) {
            f32x4 acc[4];
#pragma unroll
            for (int b = 0; b < 4; ++b) acc[b] = (f32x4){0.f, 0.f, 0.f, 0.f};
            for (int d = dg; d < D; d += 42) {
                const f32x4 w = *(const GAS f32x4*)(W + (size_t)d * 12288 + n);
#pragma unroll
                for (int b = 0; b < 4; ++b) { const float cv = cact[b * D + d]; acc[b] += w * cv; }
            }
#pragma unroll
            for (int b = 0; b < 4; ++b) *(LAS f32x4*)(RED + (dg * 4 + b) * 48 + cq * 4) = acc[b];
        }
        __syncthreads();
        if (tid < 192) {
            const int b = tid / 48, cc = tid % 48;
            float s = bia[cg * 48 + cc];
            for (int g2 = 0; g2 < 42; ++g2) s += RED[(g2 * 4 + b) * 48 + cc];
            mod[b * 12288 + cg * 48 + cc] = s;
        }
        __syncthreads();
    }
    if (blockIdx.x == 0) {
        const float* lbl = a.in[IN_LBL];
        for (int k = tid; k < 1024; k += NTHREADS) { const float l0 = lbl[k], l1 = lbl[1024 + k]; const float m = fmaxf(l0, l1); const float e0 = __expf(l0 - m), e1 = __expf(l1 - m); F.vec[VW_LB + k] = e0 / (e0 + e1); }
        if (tid < 64) {
            const int l = tid;
            float s1 = a.in[IN_LQ1][l] * a.in[IN_LK1][l], s2 = a.in[IN_LQ2][l] * a.in[IN_LK2][l];
            s1 = wave_sum(s1); s2 = wave_sum(s2);
            float qg = fabsf(a.in[IN_QNG][l]), kg = fabsf(a.in[IN_KNG][l]);
#pragma unroll
            for (int o = 1; o < 64; o <<= 1) { qg = fmaxf(qg, __shfl_xor(qg, o)); kg = fmaxf(kg, __shfl_xor(kg, o)); }
            float mb = -1e30f;
            for (int i = l; i < 256; i += 64) mb = fmaxf(mb, a.in[IN_RELB][i]);
#pragma unroll
            for (int o = 1; o < 64; o <<= 1) mb = fmaxf(mb, __shfl_xor(mb, o));
            if (l == 0) { F.vec[VW_LAM] = __expf(s1) - __expf(s2) + LAMBDA_INIT; F.vec[VW_M2] = (8.0f * qg * kg * 1.01f + fmaxf(mb, 0.f)) * LOG2E; }
        }
        for (int i = tid; i < 8 * 256; i += NTHREADS) {
            const int h = i >> 8, dist = i & 255;
            int bucket;
            if (dist < 16) bucket = dist; else { const double v = log((double)dist / 16.0) / log(8.0) * 16.0; int lg = 16 + (int)v; bucket = lg < 31 ? lg : 31; }
            F.vec[VW_TBL + i] = a.in[IN_RELB][bucket * 8 + h] * LOG2E;
        }
    }
}

__device__ __forceinline__ void norm_mod_row(const float* xrow, const float* g, const float* shift, const float* scale, bf16* orow, unsigned char* orow8, int lane) {
    const GAS f32x4* xr = (const GAS f32x4*)xrow + lane;
    f32x4 v[8]; float s = 0.f;
#pragma unroll
    for (int j = 0; j < 8; ++j) { v[j] = xr[64 * j]; s += (v[j].x * v[j].x + v[j].y * v[j].y) + (v[j].z * v[j].z + v[j].w * v[j].w); }
    const float rstd = 1.f / sqrtf(wave_sum(s) * (1.f / D) + EPS);
    GAS v2u* o8 = (GAS v2u*)orow + lane;
#pragma unroll
    for (int j = 0; j < 8; ++j) {
        const int d = 4 * lane + 256 * j;
        const f32x4 gg = *(const f32x4*)(g + d), sh = *(const f32x4*)(shift + d), sc = *(const f32x4*)(scale + d);
        const f32x4 y = v[j] * rstd * gg * (sc + 1.0f) + sh;
        v2u o; o.x = pk2(y.x, y.y); o.y = pk2(y.z, y.w); o8[64 * j] = o;
        ((GAS unsigned*)orow8)[lane + 64 * j] = pk4_fp8(y.x, y.y, y.z, y.w);
    }
}
__device__ __forceinline__ void phase_prep1(Frame& F, const Args& a) {
    PHASE_IDS();
    LAS float* scr = (LAS float*)(F.lds + wid * 16384);
    const int gw = F.vcu * NWAVES + wid, NGW = F.G * NWAVES;
    constexpr int I_IN = (D / 64) * (INCOLS / 32), I_A = (1024 / 64) * (D / 32), I_O = (D / 64) * (D / 32), I_SG = (D / 64) * (DEXP / 32), I_SD = (DEXP / 64) * (D / 32);
    constexpr int NITEMS = I_IN + 2 * I_A + I_O + 2 * I_SG + I_SD;
    unsigned char* ws = F.ws;
#define PREP_DECODE(IT, idx) do { int r_ = (idx); \
        if (r_ < I_IN) { const int nblk = INCOLS / 32, kb = r_ / nblk, n0 = (r_ % nblk) * 32, k0 = 64 * kb; IT.src = a.in[IN_WIN] + (size_t)k0 * INCOLS + n0; IT.N = INCOLS; \
            if (n0 < 3072)      { IT.fp8 = 0; IT.ldb = D * 2; IT.dst = ws + WS_WIN + ((size_t)n0 * D + k0) * 2; }                         \
            else if (n0 < 4096) { IT.fp8 = 1; IT.ldb = D;     IT.dst = ws + WS_WIN8 + (size_t)(n0 - 3072) * D + k0; }                       \
            else if (n0 < 7168) { IT.fp8 = 0; IT.ldb = D * 2; IT.dst = ws + WS_WIN + ((size_t)(n0 - 1024) * D + k0) * 2; }                  \
            else                { IT.fp8 = 1; IT.ldb = D;     IT.dst = ws + WS_WIN8 + (size_t)(n0 - 7168 + 1024) * D + k0; } }              \
        else { r_ -= I_IN; \
        if (r_ < I_A) { const int kb = r_ / (D / 32), n0 = (r_ % (D / 32)) * 32, k0 = 64 * kb; IT.src = a.in[IN_WA] + (size_t)k0 * D + n0; IT.N = D; IT.fp8 = 0; IT.ldb = D * 2; IT.dst = ws + WS_WA + ((size_t)n0 * D + k0) * 2; } \
        else { r_ -= I_A; \
        if (r_ < I_A) { const int kb = r_ / (D / 32), n0 = (r_ % (D / 32)) * 32, k0 = 64 * kb; IT.src = a.in[IN_WB] + (size_t)k0 * D + n0; IT.N = D; IT.fp8 = 0; IT.ldb = D * 2; IT.dst = ws + WS_WA + ((size_t)n0 * D + 1024 + k0) * 2; } \
        else { r_ -= I_A; \
        if (r_ < I_O) { const int kb = r_ / (D / 32), n0 = (r_ % (D / 32)) * 32, k0 = 64 * kb; IT.src = a.in[IN_WOUT] + (size_t)k0 * D + n0; IT.N = D; IT.fp8 = 0; IT.ldb = D * 2; IT.dst = ws + WS_WOUT + ((size_t)n0 * D + k0) * 2; } \
        else { r_ -= I_O; \
        if (r_ < I_SG) { const int kb = r_ / (DEXP / 32), n0 = (r_ % (DEXP / 32)) * 32, k0 = 64 * kb; IT.src = a.in[IN_SG] + (size_t)k0 * DEXP + n0; IT.N = DEXP; IT.fp8 = 1; IT.ldb = D; IT.dst = ws + WS_WSH + (size_t)n0 * D + k0; } \
        else { r_ -= I_SG; \
        if (r_ < I_SG) { const int kb = r_ / (DEXP / 32), n0 = (r_ % (DEXP / 32)) * 32, k0 = 64 * kb; IT.src = a.in[IN_SU] + (size_t)k0 * DEXP + n0; IT.N = DEXP; IT.fp8 = 1; IT.ldb = D; IT.dst = ws + WS_WSH + 2 * MiB + (size_t)n0 * D + k0; } \
        else { r_ -= I_SG; const int kb = r_ / (D / 32), n0 = (r_ % (D / 32)) * 32, k0 = 64 * kb; IT.src = a.in[IN_SD] + (size_t)k0 * D + n0; IT.N = D; IT.fp8 = 1; IT.ldb = DEXP; IT.dst = ws + WS_WSH + 4 * MiB + (size_t)n0 * DEXP + k0; } } } } } } } while (0)
    for (int it = gw; it < NITEMS; it += 2 * NGW) {
        TrItem A_, B_; const bool hasB = (it + NGW < NITEMS);
        PREP_DECODE(A_, it); if (hasB) PREP_DECODE(B_, it + NGW); else B_ = A_;
        TR_PAIR(A_, hasB, B_, lane, scr);
    }
#undef PREP_DECODE
    { bf16* RH = (bf16*)(ws + WS_RWT_HI); bf16* RL = (bf16*)(ws + WS_RWT_LO); const float* rw = a.in[IN_RW];
      for (int i = (F.vcu * NWAVES + wid) * 64 + lane; i < 64 * D; i += F.G * NTHREADS) { const int e = i & 63, k = i >> 6; const float w = rw[i];
          const unsigned hb = f2bf(w); RH[e * D + k] = (bf16)hb; RL[e * D + k] = (bf16)f2bf(w - bf2f(hb)); } }
}
__device__ __forceinline__ void phase_hrows(Frame& F, const Args& a) {
    PHASE_IDS();
    const int gw = F.vcu * NWAVES + wid, NGW = F.G * NWAVES;
    unsigned char* ws = F.ws;
    const float* mod = (const float*)(F.ctl + CW_MOD);
    for (int m = gw; m < T; m += NGW) { const int b = m / SEQ;
        norm_mod_row(a.in[IN_X] + (size_t)m * D, a.in[IN_N1G], mod + b * 12288, mod + b * 12288 + 2048, (bf16*)(ws + WS_H) + (size_t)m * D, ws + WS_H8 + (size_t)m * D, lane); }
}

struct DenseGemm : pg8::DenseOrder {
    static constexpr bool GATHER = false;
    const char* A; const char* Bt; unsigned lda2, ldb2; int nt;
    __device__ __forceinline__ const char* aptr(const pg8::Unit& u) const { return A + (size_t)(u.pm * 256) * lda2; }
    __device__ __forceinline__ void aoffs(const pg8::Unit&, int, unsigned (&)[2][2]) const {}
    __device__ __forceinline__ void bptrs(const pg8::Unit& u, const char*& b0, const char*& b1) const { b0 = Bt + (size_t)(u.pn * 256) * ldb2; b1 = b0 + (size_t)128 * ldb2; }
};

template <int PART>
struct EpiInProj {
    static constexpr bool PERM = true, MIDK = false;
    unsigned char* ws;
    __device__ __forceinline__ void operator()(const f32x4 (&acc)[2][2][4][2], const pg8::Unit& u, int wr, int wc, int fr, int fq) const {
        bf16* base; int ldc, colt;
        if (PART == 0) { const int idx = u.pn >> 2, slot = idx < 3 ? idx : idx + 1; base = (bf16*)(ws + WS_PROJ + (size_t)slot * 32 * MiB); ldc = 1024; colt = (u.pn & 3) * 256; }
        else if (u.pn < 4) { base = (bf16*)(ws + WS_HG); ldc = 1024; colt = u.pn * 256; }
        else { const int q = u.pn - 4; base = (bf16*)(ws + WS_GA + (size_t)(q >> 3) * 64 * MiB); ldc = 2048; colt = (q & 7) * 256; }
        const LaneT lt(fr, fq);
        const int row0 = u.pm * 256 + wr * 64 + lt.r2, col0 = colt + wc * 32 + 8 * lt.c2;
#pragma unroll
        for (int ai = 0; ai < 2; ++ai)
#pragma unroll
            for (int m = 0; m < 4; ++m) { bf16* rowp = base + (size_t)(row0 + ai * 128 + m * 16) * ldc + col0;
#pragma unroll
                for (int bj = 0; bj < 2; ++bj) { const f32x4 v0 = acc[ai][bj][m][0], v1 = acc[ai][bj][m][1];
                    v4u w; w.x = pg8::cvt_pk_bf16(v0[0], v0[1]); w.y = pg8::cvt_pk_bf16(v0[2], v0[3]); w.z = pg8::cvt_pk_bf16(v1[0], v1[1]); w.w = pg8::cvt_pk_bf16(v1[2], v1[3]);
                    *(GAS v4u*)(rowp + bj * 128) = lt.t4(w); } }
    }
};


constexpr int H1_TS = 272, H1_TS2 = 144;
constexpr int H1_QD = 0, H1_KD = 17408, H1_KI = 34816, H1_KBT = 60928, H1_VT = 79360, H1_AT = 97792, H1_TOT = 107008;
__device__ __forceinline__ void phase_h1(Frame& F) {
    unsigned char* ws = F.ws;
    const bf16* HQ = (const bf16*)(ws + WS_HQ); bf16* QT = (bf16*)(ws + WS_QT); const bf16* HF = (const bf16*)(ws + WS_HF); const bf16* HI = (const bf16*)(ws + WS_HI);
    bf16* STg = (bf16*)(ws + WS_ST); float* DEC = (float*)(ws + WS_DEC); float* OI = (float*)(ws + WS_OI);
    LAS unsigned char* L = F.lds;
    LAS float* TOT = (LAS float*)(L + H1_TOT);
    PHASE_IDS();
    const int kp = lane, seg = wid, qd = wid >> 1, r = lane & 15, g = lane >> 4;
    unsigned nq[8], nf[8], ni[8];
#define H1_LOAD(uu_) do { const int bh_ = (uu_) >> 6, n_ = (uu_) & 63; const size_t r0_ = (size_t)(bh_ >> 3) * SEQ + (size_t)n_ * 64 + 8 * seg; const int c_ = (bh_ & 7) * 128 + 2 * kp; \
        _Pragma("unroll") for (int i_ = 0; i_ < 8; ++i_) { const size_t idx_ = (r0_ + i_) * 1024 + c_; nq[i_] = *(const GAS unsigned*)(HQ + idx_); nf[i_] = *(const GAS unsigned*)(HF + idx_); ni[i_] = *(const GAS unsigned*)(HI + idx_); } } while (0)
    if (F.vcu < NCH_UNITS) H1_LOAD(F.vcu);
    for (int u = F.vcu; u < NCH_UNITS; u += F.G) {
        const int bh = u >> 6, n = u & 63, b = bh >> 3, h = bh & 7;
        const size_t row0 = (size_t)b * SEQ + (size_t)n * 64;
        const int col = h * 128 + 2 * kp;
        float cs0[8], cs1[8], kk0[8], kk1[8], qs0[8], qs1[8]; unsigned vv[8];
        const float lb0 = F.vec[VW_LB + col], lb1 = F.vec[VW_LB + col + 1];
        {
            float run0 = 0.f, run1 = 0.f;
#pragma unroll
            for (int uu = 0; uu < 8; ++uu) {
                const float q0 = bflo(nq[uu]), q1 = bfhi(nq[uu]), f0 = bflo(nf[uu]), f1 = bfhi(nf[uu]); vv[uu] = ni[uu];
                const float fg0 = lb0 + (1.f - lb0) * fsigmoid(f0), fg1 = lb1 + (1.f - lb1) * fsigmoid(f1);
                run0 += __logf(fg0); run1 += __logf(fg1); cs0[uu] = run0; cs1[uu] = run1; kk0[uu] = 1.f - fg0; kk1[uu] = 1.f - fg1;
                qs0[uu] = q0 * fsigmoid(q0) * 0.08838834764831845f; qs1[uu] = q1 * fsigmoid(q1) * 0.08838834764831845f;
            }
            *(LAS f32x2*)(TOT + seg * 128 + 2 * kp) = (f32x2){run0, run1};
        }
        __syncthreads();
        {
            float P0[9], P1[9]; P0[0] = 0.f; P1[0] = 0.f;
#pragma unroll
            for (int s = 0; s < 8; ++s) { const f32x2 tt = *(const LAS f32x2*)(TOT + s * 128 + 2 * kp); P0[s + 1] = P0[s] + tt.x; P1[s + 1] = P1[s] + tt.y; }
            float rq0 = 0.f, rq1 = 0.f, rs0 = 0.f, rs1 = 0.f;
#pragma unroll
            for (int s = 1; s < 8; ++s) if (seg == s) { rq0 = P0[s]; rq1 = P1[s]; rs0 = P0[s & ~1]; rs1 = P1[s & ~1]; }
            const float a0 = __expf(rq0 - rs0), a1 = __expf(rq1 - rs1), ai0 = __expf(fminf(rs0 - rq0, 40.f)), ai1 = __expf(fminf(rs1 - rq1, 40.f));
            const float e10 = __expf(P0[2] - rq0), e11 = __expf(P1[2] - rq1), e20 = __expf(P0[4] - rq0), e21 = __expf(P1[4] - rq1), e30 = __expf(P0[6] - rq0), e31 = __expf(P1[6] - rq1);
            const float eb0 = __expf(P0[8] - rq0), eb1 = __expf(P1[8] - rq1), eq0 = __expf(rq0), eq1 = __expf(rq1);
            float kb0[8], kb1[8];
#pragma unroll
            for (int uu = 0; uu < 8; ++uu) {
                const int t = 8 * seg + uu;
                const float qE0 = qs0[uu] * __expf(cs0[uu]), qE1 = qs1[uu] * __expf(cs1[uu]);
                const float kE0 = kk0[uu] * __expf(fminf(-cs0[uu], 40.f)), kE1 = kk1[uu] * __expf(fminf(-cs1[uu], 40.f));
                *(LAS unsigned*)(L + H1_QD + t * H1_TS + 4 * kp) = pg8::cvt_pk_bf16(qE0 * a0, qE1 * a1);
                *(LAS unsigned*)(L + H1_KD + t * H1_TS + 4 * kp) = pg8::cvt_pk_bf16(kE0 * ai0, kE1 * ai1);
                if (qd < 1) *(LAS unsigned*)(L + H1_KI + (0 + t) * H1_TS + 4 * kp) = pg8::cvt_pk_bf16(kE0 * e10, kE1 * e11);
                if (qd < 2) *(LAS unsigned*)(L + H1_KI + (16 + t) * H1_TS + 4 * kp) = pg8::cvt_pk_bf16(kE0 * e20, kE1 * e21);
                if (qd < 3) *(LAS unsigned*)(L + H1_KI + (48 + t) * H1_TS + 4 * kp) = pg8::cvt_pk_bf16(kE0 * e30, kE1 * e31);
                kb0[uu] = kE0 * eb0; kb1[uu] = kE1 * eb1;
                *(GAS unsigned*)(QT + (row0 + t) * 1024 + col) = pg8::cvt_pk_bf16(qE0 * eq0, qE1 * eq1);
            }
            *(LAS v4u*)(L + H1_KBT + (2 * kp) * H1_TS2 + 16 * seg) = (v4u){pg8::cvt_pk_bf16(kb0[0], kb0[1]), pg8::cvt_pk_bf16(kb0[2], kb0[3]), pg8::cvt_pk_bf16(kb0[4], kb0[5]), pg8::cvt_pk_bf16(kb0[6], kb0[7])};
            *(LAS v4u*)(L + H1_KBT + (2 * kp + 1) * H1_TS2 + 16 * seg) = (v4u){pg8::cvt_pk_bf16(kb1[0], kb1[1]), pg8::cvt_pk_bf16(kb1[2], kb1[3]), pg8::cvt_pk_bf16(kb1[4], kb1[5]), pg8::cvt_pk_bf16(kb1[6], kb1[7])};
            *(LAS v4u*)(L + H1_VT + (2 * kp) * H1_TS2 + 16 * seg) = (v4u){(vv[0] & 0xffffu) | (vv[1] << 16), (vv[2] & 0xffffu) | (vv[3] << 16), (vv[4] & 0xffffu) | (vv[5] << 16), (vv[6] & 0xffffu) | (vv[7] << 16)};
            *(LAS v4u*)(L + H1_VT + (2 * kp + 1) * H1_TS2 + 16 * seg) = (v4u){(vv[0] >> 16) | (vv[1] & 0xffff0000u), (vv[2] >> 16) | (vv[3] & 0xffff0000u), (vv[4] >> 16) | (vv[5] & 0xffff0000u), (vv[6] >> 16) | (vv[7] & 0xffff0000u)};
            if (seg == 0) *(GAS f32x2*)(DEC + (size_t)u * 128 + 2 * kp) = (f32x2){__expf(P0[8]), __expf(P1[8])};
        }
        __syncthreads();
        if (u + F.G < NCH_UNITS) H1_LOAD(u + F.G);
        for (int blk = wid; blk < 10; blk += 8) {
            const int i = blk >= 6 ? 3 : (blk >= 3 ? 2 : (blk >= 1 ? 1 : 0)), j = blk - (i * (i + 1)) / 2;
            const int kib = (i == 2) ? 16 : (i == 3 ? 48 : 0);
            const int krow_off = (j == i) ? (H1_KD + (16 * j + r) * H1_TS) : (H1_KI + (kib + 16 * j + r) * H1_TS);
            f32x4 acc = (f32x4){0.f, 0.f, 0.f, 0.f};
#pragma unroll
            for (int ks = 0; ks < 4; ++ks) {
                const bf16x8 af = *(const LAS bf16x8*)(L + H1_QD + (16 * i + r) * H1_TS + (32 * ks + 8 * g) * 2);
                const bf16x8 bfv = *(const LAS bf16x8*)(L + krow_off + (32 * ks + 8 * g) * 2);
                acc = __builtin_amdgcn_mfma_f32_16x16x32_bf16(af, bfv, acc, 0, 0, 0);
            }
#pragma unroll
            for (int rg = 0; rg < 4; ++rg) {
                const int tl = 4 * g + rg; float v = acc[rg];
                if (j == i && r > tl) v = 0.f;
                *(LAS bf16*)(L + H1_AT + (16 * i + tl) * H1_TS2 + (16 * j + r) * 2) = (bf16)f2bf(v);
            }
        }
        if (wid >= 2) {
            const int zb = wid - 2, zi = zb < 3 ? 0 : (zb < 5 ? 1 : 2), zj = zb < 3 ? zb + 1 : (zb < 5 ? zb - 1 : 3);
#pragma unroll
            for (int rg = 0; rg < 4; ++rg) *(LAS bf16*)(L + H1_AT + (16 * zi + 4 * g + rg) * H1_TS2 + (16 * zj + r) * 2) = (bf16)0;
        }
        __syncthreads();
        {
            bf16x8 vf[2];
#pragma unroll
            for (int ks = 0; ks < 2; ++ks) vf[ks] = *(const LAS bf16x8*)(L + H1_VT + (16 * wid + r) * H1_TS2 + (32 * ks + 8 * g) * 2);
#pragma unroll
            for (int rb = 0; rb < 4; ++rb) {
                f32x4 acc = (f32x4){0.f, 0.f, 0.f, 0.f};
#pragma unroll
                for (int ks = 0; ks < 2; ++ks) { const bf16x8 af = *(const LAS bf16x8*)(L + H1_AT + (16 * rb + r) * H1_TS2 + (32 * ks + 8 * g) * 2);
                    acc = __builtin_amdgcn_mfma_f32_16x16x32_bf16(vf[ks], af, acc, 0, 0, 0); }
                *(GAS f32x4*)(OI + (row0 + 16 * rb + r) * 1024 + h * 128 + 16 * wid + 4 * g) = acc;
            }
#pragma unroll
            for (int rb = 0; rb < 8; ++rb) {
                f32x4 acc = (f32x4){0.f, 0.f, 0.f, 0.f};
#pragma unroll
                for (int ks = 0; ks < 2; ++ks) { const bf16x8 af = *(const LAS bf16x8*)(L + H1_KBT + (16 * rb + r) * H1_TS2 + (32 * ks + 8 * g) * 2);
                    acc = __builtin_amdgcn_mfma_f32_16x16x32_bf16(af, vf[ks], acc, 0, 0, 0); }
                v2u o; o.x = pk2(acc[0], acc[1]); o.y = pk2(acc[2], acc[3]);
                *(GAS v2u*)(STg + (size_t)u * 16384 + (16 * wid + r) * 128 + 16 * rb + 4 * g) = o;
            }
        }
        __syncthreads();
    }
#undef H1_LOAD
}

__device__ __forceinline__ void phase_qkprep(Frame& F, const Args& a) {
    PHASE_IDS();
    const int gw = F.vcu * NWAVES + wid, NGW = F.G * NWAVES;
    float gq[16], gk[16];
#pragma unroll
    for (int e = 0; e < 16; ++e) { gq[e] = a.in[IN_QNG][16 * (lane & 3) + e] * (0.125f * LOG2E); gk[e] = a.in[IN_KNG][16 * (lane & 3) + e]; }
    for (int m = gw; m < T; m += NGW) {
#pragma unroll
        for (int which = 0; which < 2; ++which) {
            const bf16* p = (const bf16*)(F.ws + (which ? WS_DK : WS_DQ)) + (size_t)m * 1024 + 16 * lane;
            bf16* po = (bf16*)(F.ws + (which ? WS_DKN : WS_DQN)) + (size_t)m * 1024 + 16 * lane;
            const v4u w0 = *(const GAS v4u*)p, w1 = *(const GAS v4u*)(p + 8);
            float x[16];
            x[0] = bflo(w0.x); x[1] = bfhi(w0.x); x[2] = bflo(w0.y); x[3] = bfhi(w0.y); x[4] = bflo(w0.z); x[5] = bfhi(w0.z); x[6] = bflo(w0.w); x[7] = bfhi(w0.w);
            x[8] = bflo(w1.x); x[9] = bfhi(w1.x); x[10] = bflo(w1.y); x[11] = bfhi(w1.y); x[12] = bflo(w1.z); x[13] = bfhi(w1.z); x[14] = bflo(w1.w); x[15] = bfhi(w1.w);
            float ss = 0.f;
#pragma unroll
            for (int e = 0; e < 16; ++e) ss += x[e] * x[e];
            ss += __shfl_xor(ss, 1); ss += __shfl_xor(ss, 2);
            const float rstd = 1.f / sqrtf(ss * (1.f / 64.f) + EPS);
#pragma unroll
            for (int e = 0; e < 16; ++e) x[e] = x[e] * rstd * (which ? gk[e] : gq[e]);
            v4u o0, o1;
            o0.x = pk2(x[0], x[1]); o0.y = pk2(x[2], x[3]); o0.z = pk2(x[4], x[5]); o0.w = pk2(x[6], x[7]);
            o1.x = pk2(x[8], x[9]); o1.y = pk2(x[10], x[11]); o1.z = pk2(x[12], x[13]); o1.w = pk2(x[14], x[15]);
            *(GAS v4u*)po = o0; *(GAS v4u*)(po + 8) = o1;
        }
    }
}

__device__ __forceinline__ void phase_h2(Frame& F) {
    bf16* STg = (bf16*)(F.ws + WS_ST); const float* DEC = (const float*)(F.ws + WS_DEC);
    const int NIT = 32 * 128 * 32;
    PHASE_IDS();
    for (int it = F.vcu * NTHREADS + tid; it < NIT; it += F.G * NTHREADS) {
        const int bh = it >> 12, v = (it >> 5) & 127, kg = it & 31;
        float run0 = 0.f, run1 = 0.f, run2 = 0.f, run3 = 0.f;
        for (int n0 = 0; n0 < NCHUNK; n0 += 4) {
            v2u loc[4]; f32x4 dc[4];
#pragma unroll
            for (int j = 0; j < 4; ++j) { const size_t un = (size_t)bh * 64 + n0 + j;
                loc[j] = *(const GAS v2u*)(STg + un * 16384 + v * 128 + kg * 4); dc[j] = *(const GAS f32x4*)(DEC + un * 128 + kg * 4); }
#pragma unroll
            for (int j = 0; j < 4; ++j) { const size_t un = (size_t)bh * 64 + n0 + j;
                v2u o; o.x = pk2(run0, run1); o.y = pk2(run2, run3);
                *(GAS v2u*)(STg + un * 16384 + v * 128 + kg * 4) = o;
                run0 = dc[j].x * run0 + bflo(loc[j].x); run1 = dc[j].y * run1 + bfhi(loc[j].x); run2 = dc[j].z * run2 + bflo(loc[j].y); run3 = dc[j].w * run3 + bfhi(loc[j].y); }
        }
    }
}

__device__ __forceinline__ void phase_h3(Frame& F, const Args& a) {
    const bf16* HQ = (const bf16*)(F.ws + WS_QT); const bf16* HG = (const bf16*)(F.ws + WS_HG); const bf16* STg = (const bf16*)(F.ws + WS_ST);
    const float* OI = (const float*)(F.ws + WS_OI); bf16* BR = (bf16*)(F.ws + WS_BR);
    PHASE_IDS();
    const int r = lane & 15, g = lane >> 4, sub = wid >> 2, rb = wid & 3;
    f32x4 gn[8];
#pragma unroll
    for (int cb = 0; cb < 8; ++cb) gn[cb] = *(const GAS f32x4*)(a.in[IN_HGNG] + 16 * cb + 4 * g);
    for (int up = F.vcu; up < NCH_UNITS / 2; up += F.G) {
        const int u = up * 2 + sub, bh = u >> 6, n = u & 63, b = bh >> 3, h = bh & 7;
        const size_t m0 = (size_t)b * SEQ + (size_t)n * 64 + 16 * rb;
        bf16x8 af[4];
#pragma unroll
        for (int ks = 0; ks < 4; ++ks) af[ks] = *(const GAS bf16x8*)(HQ + (m0 + r) * 1024 + h * 128 + 32 * ks + 8 * g);
        f32x4 acc[8];
#pragma unroll
        for (int cb = 0; cb < 8; ++cb) {
            acc[cb] = (f32x4){0.f, 0.f, 0.f, 0.f};
#pragma unroll
            for (int ks = 0; ks < 4; ++ks) { const bf16x8 bfv = *(const GAS bf16x8*)(STg + (size_t)u * 16384 + (16 * cb + r) * 128 + 32 * ks + 8 * g);
                acc[cb] = __builtin_amdgcn_mfma_f32_16x16x32_bf16(bfv, af[ks], acc[cb], 0, 0, 0); }
        }
        float ss = 0.f;
#pragma unroll
        for (int cb = 0; cb < 8; ++cb) {
            const f32x4 o4 = *(const GAS f32x4*)(OI + (m0 + r) * 1024 + h * 128 + 16 * cb + 4 * g);
#pragma unroll
            for (int rg = 0; rg < 4; ++rg) { const float o = acc[cb][rg] + o4[rg]; acc[cb][rg] = o; ss += o * o; }
        }
        ss += __shfl_xor(ss, 16); ss += __shfl_xor(ss, 32);
        const float rstd = 1.f / sqrtf(ss * (1.f / 128.f) + EPS);
#pragma unroll
        for (int cb = 0; cb < 8; ++cb) {
            const v2u hg = *(const GAS v2u*)(HG + (m0 + r) * 1024 + h * 128 + 16 * cb + 4 * g);
            const float g0 = bflo(hg.x), g1 = bfhi(hg.x), g2 = bflo(hg.y), g3 = bfhi(hg.y);
            v2u o;
            o.x = pg8::cvt_pk_bf16(acc[cb][0] * rstd * gn[cb][0] * (g0 * fsigmoid(g0)), acc[cb][1] * rstd * gn[cb][1] * (g1 * fsigmoid(g1)));
            o.y = pg8::cvt_pk_bf16(acc[cb][2] * rstd * gn[cb][2] * (g2 * fsigmoid(g2)), acc[cb][3] * rstd * gn[cb][3] * (g3 * fsigmoid(g3)));
            *(GAS v2u*)(BR + (m0 + r) * 2048 + h * 128 + 16 * cb + 4 * g) = o;
        }
    }
}

__device__ __forceinline__ void phase_convert_experts(Frame& F, const Args& a) {
    PHASE_IDS();
    LAS float* scr = (LAS float*)(F.lds + wid * 16384);
    const int gw = F.vcu * NWAVES + wid, NGW = F.G * NWAVES;
    constexpr int IPM = 256, NITEMS = NEXP * 3 * IPM;
    for (int it = gw; it < NITEMS; it += NGW) {
        const int e = it / (3 * IPM), r = it % (3 * IPM), which = r / IPM, item = r % IPM;
        TrItem A_, B_; A_.fp8 = 1;
        if (which < 2) { const int kb2 = item / (DEXP / 32), n0 = (item % (DEXP / 32)) * 32, k0 = 128 * kb2;
            A_.src = a.in[which ? IN_EU : IN_EG] + (size_t)e * D * DEXP + (size_t)k0 * DEXP + n0; A_.N = DEXP; A_.ldb = D; A_.dst = F.ws + (which ? WS_WU : WS_WG) + (size_t)e * DEXP * D + (size_t)n0 * D + k0; }
        else { const int kb2 = item / (D / 32), n0 = (item % (D / 32)) * 32, k0 = 128 * kb2;
            A_.src = a.in[IN_ED] + (size_t)e * DEXP * D + (size_t)k0 * D + n0; A_.N = D; A_.ldb = DEXP; A_.dst = F.ws + WS_WDOWN + (size_t)e * D * DEXP + (size_t)n0 * DEXP + k0; }
        B_ = A_; B_.src = A_.src + (size_t)64 * A_.N; B_.dst = A_.dst + 64;
        TR_PAIR(A_, true, B_, lane, scr);
    }
}

constexpr int AT_KCH = 1040, AT_VDB = 4160, AT_STAGE = 33280, AT_TBL = 66560, AT_WSF = 67584, AT_QF = 68608;
__device__ __forceinline__ int crow(int r, int hi) { return (r & 3) + 8 * (r >> 2) + 4 * hi; }
__device__ __forceinline__ void phase_attn(Frame& F, const Args& a, const int pi_lo, const int pi_hi) {
    const bf16* DQ = (const bf16*)(F.ws + WS_DQN); const bf16* DK = (const bf16*)(F.ws + WS_DKN); const bf16* DV = (const bf16*)(F.ws + WS_DV);
    bf16* BR = (bf16*)(F.ws + WS_BR);
    LAS unsigned char* L = F.lds;
    LAS float* TBL = (LAS float*)(L + AT_TBL); LAS float* WSF = (LAS float*)(L + AT_WSF); LAS float* XB = (LAS float*)L;
    PHASE_IDS();
    const int c = wid >> 2, qblk = wid & 3, r32 = lane & 31, hi = lane >> 5;
    const float lam = F.vec[VW_LAM], M2 = F.vec[VW_M2];
    const int lrow0 = tid >> 4, lch = tid & 15, lrow1 = lrow0 + 32;
    const int kdst0 = lch * AT_KCH + lrow0 * 16, kdst1 = lch * AT_KCH + lrow1 * 16;
    const int vdst0 = 16640 + (lch >> 2) * AT_VDB + (lrow0 >> 4) * 1024 + (lrow0 & 15) * 64 + (lch & 3) * 16;
    const int vdst1 = 16640 + (lch >> 2) * AT_VDB + (lrow1 >> 4) * 1024 + (lrow1 & 15) * 64 + (lch & 3) * 16;
    const int vlane = 16640 + ((lane >> 4) & 1) * 32 + (lane & 3) * 8 + (4 * hi + ((lane & 15) >> 2)) * 64;
    float dg[4];
#pragma unroll
    for (int d0 = 0; d0 < 4; ++d0) dg[d0] = a.in[IN_DANG][32 * d0 + r32] * (1.0f - LAMBDA_INIT);
    for (int pi = pi_lo; pi < pi_hi; ++pi) {
        if (pi == (F.vcu & 3)) { phase_convert_experts(F, a); __syncthreads(); }
        const int pp = F.vcu * 2 + (pi >> 1);
        if (pp >= 512) break;
        const int bh = pp >> 4, s = pp & 15, qb = (pi & 1) ? 31 - s : s, b = bh >> 3, h = bh & 7;
        const int q0 = qb * 128, NT = 2 * qb + 2;
        const size_t rowb = (size_t)b * SEQ;
        if (tid < 256) TBL[tid] = F.vec[VW_TBL + h * 256 + tid];
        const int qfo = AT_QF + wid * 4096 + lane * 16;
#pragma unroll
        for (int d0 = 0; d0 < 4; ++d0) *(LAS bf16x8*)(L + qfo + d0 * 1024) = *(const GAS bf16x8*)(DQ + (rowb + q0 + 32 * qblk + r32) * 1024 + h * 128 + c * 64 + 16 * d0 + 8 * hi);
        const bf16* ksrc0 = DK + (rowb + lrow0) * 1024 + h * 128 + lch * 8; const bf16* ksrc1 = ksrc0 + (size_t)32 * 1024;
        const bf16* vsrc0 = DV + (rowb + lrow0) * 1024 + h * 128 + lch * 8; const bf16* vsrc1 = vsrc0 + (size_t)32 * 1024;
        v4u kr0, kr1, vr0, vr1;
        kr0 = *(const GAS v4u*)ksrc0; kr1 = *(const GAS v4u*)ksrc1; vr0 = *(const GAS v4u*)vsrc0; vr1 = *(const GAS v4u*)vsrc1;
        *(LAS v4u*)(L + kdst0) = kr0; *(LAS v4u*)(L + kdst1) = kr1; *(LAS v4u*)(L + vdst0) = vr0; *(LAS v4u*)(L + vdst1) = vr1;
        __syncthreads();
        const float tb31 = TBL[255];
        f32x16 o[4];
#pragma unroll
        for (int d0 = 0; d0 < 4; ++d0)
#pragma unroll
            for (int rr = 0; rr < 16; ++rr) o[d0][rr] = 0.f;
        float lsum = 0.f;
        const int qpos = q0 + 32 * qblk + r32;
        for (int j = 0; j < NT; ++j) {
            const int st = (j & 1) * AT_STAGE, sn = ((j + 1) & 1) * AT_STAGE;
            const bool more = (j + 1 < NT);
            if (more) { const size_t go = (size_t)(j + 1) * 64 * 1024;
                kr0 = *(const GAS v4u*)(ksrc0 + go); kr1 = *(const GAS v4u*)(ksrc1 + go); vr0 = *(const GAS v4u*)(vsrc0 + go); vr1 = *(const GAS v4u*)(vsrc1 + go); }
            const bool far = (j < NT - 4);
            const float cinit = far ? (tb31 - M2) : (-M2);
            f32x16 p0, p1;
#pragma unroll
            for (int rr = 0; rr < 16; ++rr) { p0[rr] = cinit; p1[rr] = cinit; }
#pragma unroll
            for (int d0 = 0; d0 < 4; ++d0) {
                const bf16x8 k0 = *(const LAS bf16x8*)(L + st + (8 * c + 2 * d0 + hi) * AT_KCH + r32 * 16);
                const bf16x8 k1 = *(const LAS bf16x8*)(L + st + (8 * c + 2 * d0 + hi) * AT_KCH + r32 * 16 + 512);
                const bf16x8 qf = *(const LAS bf16x8*)(L + qfo + d0 * 1024);
                p0 = __builtin_amdgcn_mfma_f32_32x32x16_bf16(k0, qf, p0, 0, 0, 0);
                p1 = __builtin_amdgcn_mfma_f32_32x32x16_bf16(k1, qf, p1, 0, 0, 0);
            }
            if (!far) {
                float tb0[16], tb1[16];
#pragma unroll
                for (int rr = 0; rr < 16; ++rr) { const int d0v = qpos - (64 * j + crow(rr, hi)), d1v = d0v - 32;
                    tb0[rr] = TBL[d0v < 0 ? 0 : (d0v > 255 ? 255 : d0v)]; tb1[rr] = TBL[d1v < 0 ? 0 : (d1v > 255 ? 255 : d1v)]; }
                asm volatile("s_waitcnt lgkmcnt(0)" ::: "memory");
#pragma unroll
                for (int rr = 0; rr < 16; ++rr) { const int d0v = qpos - (64 * j + crow(rr, hi)), d1v = d0v - 32;
                    p0[rr] = d0v >= 0 ? p0[rr] + tb0[rr] : -INFINITY; p1[rr] = d1v >= 0 ? p1[rr] + tb1[rr] : -INFINITY; }
            }
            float sacc = 0.f;
#pragma unroll
            for (int rr = 0; rr < 16; ++rr) { p0[rr] = __builtin_amdgcn_exp2f(p0[rr]); p1[rr] = __builtin_amdgcn_exp2f(p1[rr]); sacc += p0[rr] + p1[rr]; }
            lsum += sacc;
#define AT_VLD(dst, ks) do { _Pragma("unroll") for (int _d = 0; _d < 4; ++_d) { \
                const s16x4 _lo = __builtin_bit_cast(s16x4, __builtin_amdgcn_ds_read_tr16_b64_v4i16((LAS s16x4*)(L + st + vlane + _d * AT_VDB + (ks) * 1024))); \
                const s16x4 _hh = __builtin_bit_cast(s16x4, __builtin_amdgcn_ds_read_tr16_b64_v4i16((LAS s16x4*)(L + st + vlane + _d * AT_VDB + (ks) * 1024 + 512))); \
                dst[_d] = (bf16x8){_lo[0], _lo[1], _lo[2], _lo[3], _hh[0], _hh[1], _hh[2], _hh[3]}; } } while (0)
#define AT_PV(src, ks) do { v4u _w; if ((ks) < 2) { _w.x = pg8::cvt_pk_bf16(p0[8 * (ks) + 0], p0[8 * (ks) + 1]); _w.y = pg8::cvt_pk_bf16(p0[8 * (ks) + 2], p0[8 * (ks) + 3]); _w.z = pg8::cvt_pk_bf16(p0[8 * (ks) + 4], p0[8 * (ks) + 5]); _w.w = pg8::cvt_pk_bf16(p0[8 * (ks) + 6], p0[8 * (ks) + 7]); } \
                else { _w.x = pg8::cvt_pk_bf16(p1[8 * (ks) - 16], p1[8 * (ks) - 15]); _w.y = pg8::cvt_pk_bf16(p1[8 * (ks) - 14], p1[8 * (ks) - 13]); _w.z = pg8::cvt_pk_bf16(p1[8 * (ks) - 12], p1[8 * (ks) - 11]); _w.w = pg8::cvt_pk_bf16(p1[8 * (ks) - 10], p1[8 * (ks) - 9]); } \
                const bf16x8 _pa = __builtin_bit_cast(bf16x8, _w); \
                _Pragma("unroll") for (int _d = 0; _d < 4; ++_d) o[_d] = __builtin_amdgcn_mfma_f32_32x32x16_bf16(_pa, src[_d], o[_d], 0, 0, 0); } while (0)
            bf16x8 vfa[4], vfb[4];
            AT_VLD(vfa, 0);
            AT_VLD(vfb, 1); AT_PV(vfa, 0);
            AT_VLD(vfa, 2); AT_PV(vfb, 1);
            AT_VLD(vfb, 3); AT_PV(vfa, 2);
            AT_PV(vfb, 3);
#undef AT_VLD
#undef AT_PV
            if (more) { *(LAS v4u*)(L + sn + kdst0) = kr0; *(LAS v4u*)(L + sn + kdst1) = kr1; *(LAS v4u*)(L + sn + vdst0) = vr0; *(LAS v4u*)(L + sn + vdst1) = vr1; }
            __syncthreads();
        }
        lsum += __shfl_xor(lsum, 32);
        if (hi == 0) WSF[wid * 32 + r32] = lsum;
        LDS_WAIT();
        float rli[16];
#pragma unroll
        for (int rr = 0; rr < 16; ++rr) rli[rr] = 1.0f / WSF[wid * 32 + crow(rr, hi)];
        if (c == 1) {
#pragma unroll
            for (int d0 = 0; d0 < 4; ++d0)
#pragma unroll
                for (int rr = 0; rr < 16; ++rr) XB[(qblk * 32 + crow(rr, hi)) * 128 + 32 * d0 + r32] = o[d0][rr] * rli[rr] * lam;
        }
        __syncthreads();
        if (c == 0) {
            float ss[16];
#pragma unroll
            for (int rr = 0; rr < 16; ++rr) ss[rr] = 0.f;
#pragma unroll
            for (int d0 = 0; d0 < 4; ++d0)
#pragma unroll
                for (int rr = 0; rr < 16; ++rr) { const float df = o[d0][rr] * rli[rr] - XB[(qblk * 32 + crow(rr, hi)) * 128 + 32 * d0 + r32]; o[d0][rr] = df; ss[rr] += df * df; }
#pragma unroll
            for (int rr = 0; rr < 16; ++rr) { float s2 = ss[rr]; s2 += __shfl_xor(s2, 1); s2 += __shfl_xor(s2, 2); s2 += __shfl_xor(s2, 4); s2 += __shfl_xor(s2, 8); s2 += __shfl_xor(s2, 16);
                ss[rr] = 1.f / sqrtf(s2 * (1.f / 128.f) + EPS); }
#pragma unroll
            for (int d0 = 0; d0 < 4; ++d0)
#pragma unroll
                for (int rr = 0; rr < 16; ++rr)
                    BR[(rowb + q0 + 32 * qblk + crow(rr, hi)) * 2048 + 1024 + h * 128 + 32 * d0 + r32] = (bf16)f2bf_sw(o[d0][rr] * ss[rr] * dg[d0]);
        }
        __syncthreads();
    }
}

__device__ __forceinline__ void unpack8(const v4u w, float (&x)[8]) { x[0] = bflo(w.x); x[1] = bfhi(w.x); x[2] = bflo(w.y); x[3] = bfhi(w.y); x[4] = bflo(w.z); x[5] = bfhi(w.z); x[6] = bflo(w.w); x[7] = bfhi(w.w); }
struct EpiMergeF {
    static constexpr bool PERM = true, MIDK = true;
    unsigned char* ws;
    __device__ __forceinline__ void mid(f32x4 (&acc)[2][2][4][2], const pg8::Unit& u, int wr, int wc, int fr_, int fq_) const {
        int fr = fr_, fq = fq_; OPAQUE_V(fr); OPAQUE_V(fq);
        const bf16* GAp = (const bf16*)(ws + WS_GA); const bf16* GBp = (const bf16*)(ws + WS_GB);
        const int row0 = u.pm * 256 + wr * 64 + fr, col0 = u.pn * 256 + wc * 32 + 8 * fq;
#pragma unroll
        for (int ai = 0; ai < 2; ++ai)
#pragma unroll
            for (int m = 0; m < 4; ++m)
#pragma unroll
                for (int bj = 0; bj < 2; ++bj) {
                    const size_t off = (size_t)(row0 + ai * 128 + m * 16) * 2048 + col0 + bj * 128;
                    float ga[8], gb[8]; unpack8(*(const GAS v4u*)(GAp + off), ga); unpack8(*(const GAS v4u*)(GBp + off), gb);
#pragma unroll
                    for (int j = 0; j < 4; ++j) {
                        acc[ai][bj][m][0][j] *= (1.0f + __expf(-gb[j])) * __builtin_amdgcn_rcpf(1.0f + __expf(-ga[j]));
                        acc[ai][bj][m][1][j] *= (1.0f + __expf(-gb[4 + j])) * __builtin_amdgcn_rcpf(1.0f + __expf(-ga[4 + j])); }
                }
    }
    __device__ __forceinline__ void operator()(const f32x4 (&acc)[2][2][4][2], const pg8::Unit& u, int wr, int wc, int fr_, int fq_) const {
        int fr = fr_, fq = fq_; OPAQUE_V(fr); OPAQUE_V(fq);
        const bf16* GBp = (const bf16*)(ws + WS_GB); bf16* O = (bf16*)(ws + WS_MERGED);
        const LaneT lt(fr, fq);
        const int row0 = u.pm * 256 + wr * 64 + fr, col0 = u.pn * 256 + wc * 32 + 8 * fq, rowt = u.pm * 256 + wr * 64 + lt.r2, colt = u.pn * 256 + wc * 32 + 8 * lt.c2;
#pragma unroll
        for (int ai = 0; ai < 2; ++ai)
#pragma unroll
            for (int m = 0; m < 4; ++m)
#pragma unroll
                for (int bj = 0; bj < 2; ++bj) {
                    const size_t off = (size_t)(row0 + ai * 128 + m * 16) * 2048 + col0 + bj * 128;
                    float gb[8], y[8]; unpack8(*(const GAS v4u*)(GBp + off), gb);
                    const f32x4 v0 = acc[ai][bj][m][0], v1 = acc[ai][bj][m][1];
#pragma unroll
                    for (int j = 0; j < 4; ++j) { y[j] = v0[j] * fsigmoid(gb[j]); y[4 + j] = v1[j] * fsigmoid(gb[4 + j]); }
                    v4u w; w.x = pk2(y[0], y[1]); w.y = pk2(y[2], y[3]); w.z = pk2(y[4], y[5]); w.w = pk2(y[6], y[7]);
                    *(GAS v4u*)(O + (size_t)(rowt + ai * 128 + m * 16) * 2048 + colt + bj * 128) = lt.t4(w);
                }
    }
};
struct EpiOutProj {
    static constexpr bool PERM = true, MIDK = false;
    const float* x; bf16* x1b; const float* mod;
    __device__ __forceinline__ void operator()(const f32x4 (&acc)[2][2][4][2], const pg8::Unit& u, int wr, int wc, int fr_, int fq_) const {
        int fr = fr_, fq = fq_; OPAQUE_V(fr); OPAQUE_V(fq);
        const LaneT lt(fr, fq);
        const int row0 = u.pm * 256 + wr * 64 + fr, col0 = u.pn * 256 + wc * 32 + 8 * fq, rowt = u.pm * 256 + wr * 64 + lt.r2, colt = u.pn * 256 + wc * 32 + 8 * lt.c2;
        const int b = (u.pm * 256) / SEQ;
#pragma unroll
        for (int ai = 0; ai < 2; ++ai)
#pragma unroll
            for (int m = 0; m < 4; ++m) { const size_t ro = (size_t)(row0 + ai * 128 + m * 16) * D + col0;
#pragma unroll
                for (int bj = 0; bj < 2; ++bj) {
                    const f32x4 x0 = *(const GAS f32x4*)(x + ro + bj * 128), x4 = *(const GAS f32x4*)(x + ro + bj * 128 + 4);
                    const f32x4 g0 = *(const GAS f32x4*)(mod + b * 12288 + 4096 + col0 + bj * 128), g4 = *(const GAS f32x4*)(mod + b * 12288 + 4096 + col0 + bj * 128 + 4);
                    const f32x4 y0 = x0 + g0 * acc[ai][bj][m][0], y1 = x4 + g4 * acc[ai][bj][m][1];
                    v4u w; w.x = pk2(y0[0], y0[1]); w.y = pk2(y0[2], y0[3]); w.z = pk2(y1[0], y1[1]); w.w = pk2(y1[2], y1[3]);
                    *(GAS v4u*)(x1b + (size_t)(rowt + ai * 128 + m * 16) * D + colt + bj * 128) = lt.t4(w); } }
    }
};


constexpr int RT_XSLD = 2056;
constexpr int RT_XS = 0, RT_PART = 65792;
constexpr int RT_LCNT = 98560, RT_STOK = 98816, RT_SW = 107008;
constexpr int MOE_TB = MISC_OFF + 1024;
__device__ __forceinline__ void phase_router(Frame& F, const Args& a) {
    PHASE_IDS();
    LAS unsigned char* L = F.lds;
    LAS bf16* XS = (LAS bf16*)(L + RT_XS); LAS float* PART = (LAS float*)(L + RT_PART);
    const bf16* x1 = (const bf16*)(F.ws + WS_X1B); const float* mod = (const float*)(F.ctl + CW_MOD);
    unsigned char* H2 = F.ws + WS_H2;
    int* LTOK = (int*)(F.ws + WS_LTOK); float* LW = (float*)(F.ws + WS_LW);
    const float rbias = a.in[IN_RB][lane];
    if (tid < 64) ((LAS unsigned*)(L + RT_LCNT))[tid] = 0u;
    __syncthreads();
    int rounds = 0, round_row0 = 0;
    const bf16* RH = (const bf16*)(F.ws + WS_RWT_HI);
    const int r = lane & 15, g = lane >> 4;
    v2u xw0[8], xw1[8];
#define RT_LOADX(g_) do { const GAS v2u* xr_ = (const GAS v2u*)(x1 + (size_t)((g_) * 16 + 2 * wid) * D) + lane; \
        _Pragma("unroll") for (int j_ = 0; j_ < 8; ++j_) { xw0[j_] = xr_[64 * j_]; xw1[j_] = xr_[64 * j_ + 512]; } } while (0)
#define RT_LOADW(dst, ks_) do { _Pragma("unroll") for (int cb_ = 0; cb_ < 4; ++cb_) dst[cb_] = *(const GAS bf16x8*)(RH + (16 * cb_ + r) * D + 256 * wid + 32 * (ks_) + 8 * g); } while (0)
#define RT_STEP(src, ks_) do { const bf16x8 xf_ = *(const LAS bf16x8*)(XS + r * RT_XSLD + 256 * wid + 32 * (ks_) + 8 * g); \
        _Pragma("unroll") for (int cb_ = 0; cb_ < 4; ++cb_) acc[cb_] = __builtin_amdgcn_mfma_f32_16x16x32_bf16(xf_, src[cb_], acc[cb_], 0, 0, 0); } while (0)
#define RT_FENCE() asm volatile("" ::: "memory")
    const int RPW = (T / 16) / F.G, bq = (F.vcu * RPW * 16) / SEQ;
    f32x4 ga[8], sh[8];
#pragma unroll
    for (int j = 0; j < 8; ++j) { const int d = 4 * lane + 256 * j;
        const f32x4 gg = *(const f32x4*)(a.in[IN_N2G] + d), sc = *(const GAS f32x4*)(mod + bq * 12288 + 8192 + d); sh[j] = *(const GAS f32x4*)(mod + bq * 12288 + 6144 + d); ga[j] = gg * (sc + 1.0f); }
    RT_LOADX(F.vcu * RPW);
    for (int gi = 0; gi < RPW; ++gi) {
        const int grp = F.vcu * RPW + gi;
        if (rounds == 0) round_row0 = grp * 16;
#pragma unroll
        for (int rr2 = 0; rr2 < 2; ++rr2) {
            const int rloc = 2 * wid + rr2, m = grp * 16 + rloc;
            f32x4 v[8]; float s = 0.f;
#pragma unroll
            for (int j = 0; j < 8; ++j) { const v2u w = rr2 ? xw1[j] : xw0[j]; v[j] = (f32x4){bflo(w.x), bfhi(w.x), bflo(w.y), bfhi(w.y)}; s += (v[j].x * v[j].x + v[j].y * v[j].y) + (v[j].z * v[j].z + v[j].w * v[j].w); }
            const float rstd = 1.f / sqrtf(wave_sum(s) * (1.f / D) + EPS);
            GAS unsigned* o8 = (GAS unsigned*)(H2 + (size_t)m * D) + lane;
#pragma unroll
            for (int j = 0; j < 8; ++j) {
                const int d = 4 * lane + 256 * j;
                const f32x4 y = v[j] * rstd * ga[j] + sh[j];
                o8[64 * j] = pk4_fp8(y.x, y.y, y.z, y.w);
                v2u xb; xb.x = pk2(y.x, y.y); xb.y = pk2(y.z, y.w);
                *(LAS v2u*)(XS + rloc * RT_XSLD + d) = xb;
            }
        }
        {
            f32x4 acc[4];
#pragma unroll
            for (int cb = 0; cb < 4; ++cb) acc[cb] = (f32x4){0.f, 0.f, 0.f, 0.f};
            bf16x8 w0[4], w1[4], w2[4], w3[4];
            RT_LOADW(w0, 0); RT_LOADW(w1, 1); RT_LOADW(w2, 2); RT_LOADW(w3, 3);
            RT_FENCE();
            __syncthreads();
            RT_STEP(w0, 0); RT_LOADW(w0, 4); RT_FENCE();
            RT_STEP(w1, 1); RT_LOADW(w1, 5); RT_FENCE();
            RT_STEP(w2, 2); RT_LOADW(w2, 6); RT_FENCE();
            RT_STEP(w3, 3); RT_LOADW(w3, 7); RT_FENCE();
            if (gi + 1 < RPW) RT_LOADX(grp + 1);
            RT_FENCE();
            RT_STEP(w0, 4); RT_STEP(w1, 5); RT_STEP(w2, 6); RT_STEP(w3, 7);
#pragma unroll
            for (int cb = 0; cb < 4; ++cb)
#pragma unroll
                for (int rg = 0; rg < 4; ++rg) PART[(wid * 16 + 4 * g + rg) * 64 + 16 * cb + r] = acc[cb][rg];
        }
        __syncthreads();
#pragma unroll
        for (int rr2 = 0; rr2 < 2; ++rr2) {
            const int rloc = 2 * wid + rr2, m = grp * 16 + rloc;
            float logit = 0.f;
#pragma unroll
            for (int w2 = 0; w2 < 8; ++w2) logit += PART[(w2 * 16 + rloc) * 64 + lane];
            const float score = 1.0f / (1.0f + expf(-logit)), sel = score + rbias;
            const int eg = lane >> 3;
            float m1 = sel; m1 = fmaxf(m1, __shfl_xor(m1, 1)); m1 = fmaxf(m1, __shfl_xor(m1, 2)); m1 = fmaxf(m1, __shfl_xor(m1, 4));
            const unsigned long long bm = __ballot(sel == m1);
            const int first = __builtin_ctz((unsigned)((bm >> (8 * eg)) & 0xffull)) + 8 * eg;
            float m2 = (lane == first) ? -INFINITY : sel; m2 = fmaxf(m2, __shfl_xor(m2, 1)); m2 = fmaxf(m2, __shfl_xor(m2, 2)); m2 = fmaxf(m2, __shfl_xor(m2, 4));
            const float gs = m1 + m2;
            int grank = 0;
#pragma unroll
            for (int g2 = 0; g2 < 8; ++g2) { const float o = __shfl(gs, 8 * g2); grank += (o > gs || (o == gs && g2 < eg)) ? 1 : 0; }
            const float masked = grank < 4 ? sel : -INFINITY;
            int rank = 0;
#pragma unroll 8
            for (int e2 = 0; e2 < 64; ++e2) { const float o = __shfl(masked, e2); rank += (o > masked || (o == masked && e2 < lane)) ? 1 : 0; }
            const bool selected = rank < 8;
            const float ssum = wave_sum(selected ? score : 0.f);
            if (selected) {
                const unsigned pos = __hip_atomic_fetch_add((LAS unsigned*)(L + RT_LCNT) + lane, 1u, __ATOMIC_RELAXED, __HIP_MEMORY_SCOPE_WORKGROUP);
                ((LAS unsigned short*)(L + RT_STOK))[lane * 64 + pos] = (unsigned short)((rounds * 16 + rloc) * 8 + rank); ((LAS float*)(L + RT_SW))[lane * 64 + pos] = score / ssum * 2.5f;
            }
        }
        __syncthreads();
        ++rounds;
        if (rounds == 4 || gi + 1 == RPW) {
            const int e = tid >> 3, sub = tid & 7;
            const unsigned n = ((LAS unsigned*)(L + RT_LCNT))[e];
            unsigned base = 0u;
            if (sub == 0 && n) base = atomicAdd(F.ctl + CW_CNT + 64 * e, n);
            base = __shfl(base, lane & ~7);
            for (unsigned i = sub; i < n; i += 8) { const int sv = (int)((LAS unsigned short*)(L + RT_STOK))[e * 64 + i]; LTOK[e * 16384 + base + i] = (round_row0 + (sv >> 7) * 16 + ((sv >> 3) & 15)) * 8 + (sv & 7); LW[e * 16384 + base + i] = ((LAS float*)(L + RT_SW))[e * 64 + i]; }
            __syncthreads();
            if (tid < 64) ((LAS unsigned*)(L + RT_LCNT))[tid] = 0u;
            rounds = 0;
            __syncthreads();
        }
    }
}
#undef RT_LOADX
#undef RT_LOADW
#undef RT_STEP
#undef RT_FENCE
__device__ __forceinline__ void moe_build_table(Frame& F) {
    PHASE_IDS();
    LAS int* tb = (LAS int*)(F.lds + MOE_TB); LAS int* cn = tb + 68; LAS int* ab = cn + 68;
    if (tid == 0) {
        int t = 0, r = 0;
        for (int e = 0; e < NEXP; ++e) { const int c = (int)__hip_atomic_load(F.ctl + CW_CNT + 64 * e, RLX_AGENT); tb[e] = t; cn[e] = c; ab[e] = r; t += (c + 255) >> 8; r += c; }
        tb[64] = t; cn[64] = T; ab[64] = r;
    }
    __syncthreads();
}
template <int NP>
struct MoeOrder {
    LAS int* tb; int G, c;
    __device__ bool next(int i, pg8::Unit& u) const {
        const int ntr = tb[64]; const long L = (long)i * G + c;
        if (L >= (long)(64 + ntr) * NP) return false;
        int tt = (int)(L / NP); u.pn = (int)(L % NP);
        if (tt < 64) { u.e = 64; u.pm = tt; u.cnt = 256; return true; }
        tt -= 64;
        int lo = 0, hi = 64;
        while (hi - lo > 1) { const int mid = (lo + hi) >> 1; if (tb[mid] <= tt) lo = mid; else hi = mid; }
        u.e = lo; u.pm = tt - tb[lo]; const int rem = tb[68 + lo] - 256 * u.pm; u.cnt = rem < 256 ? rem : 256; return true;
    }
};
struct MoeGemm1 : MoeOrder<4> {
    static constexpr bool GATHER = true;
    unsigned char* ws; unsigned lda2, ldb2; int nt;
    __device__ __forceinline__ const char* aptr(const pg8::Unit&) const { return (const char*)(ws + WS_H2); }
    __device__ __forceinline__ void aoffs(const pg8::Unit& u, int tid, unsigned (&o)[2][2]) const {
        const int* LTOK = (const int*)(ws + WS_LTOK);
        OPAQUE_V(tid);
        int R0, C0, R1, C1; pg8::stage_rc(tid * 16, R0, C0); pg8::stage_rc(tid * 16 + 8192, R1, C1);
#pragma unroll
        for (int h = 0; h < 2; ++h) {
            const int p0 = h * 128 + R0, p1 = h * 128 + R1; int t0, t1;
            if (u.e == 64) { t0 = u.pm * 256 + p0; t1 = u.pm * 256 + p1; }
            else { t0 = p0 < u.cnt ? (LTOK[u.e * 16384 + u.pm * 256 + p0] >> 3) : 0; t1 = p1 < u.cnt ? (LTOK[u.e * 16384 + u.pm * 256 + p1] >> 3) : 0; }
            o[h][0] = (unsigned)t0 * 2048u + (unsigned)C0 * 2u; o[h][1] = (unsigned)t1 * 2048u + (unsigned)C1 * 2u;
        }
    }
    __device__ __forceinline__ void bptrs(const pg8::Unit& u, const char*& b0, const char*& b1) const {
        const char* g = (u.e == 64) ? (const char*)(ws + WS_WSH) : (const char*)(ws + WS_WG) + (size_t)u.e * DEXP * D;
        const char* up = (u.e == 64) ? (const char*)(ws + WS_WSH + 2 * MiB) : (const char*)(ws + WS_WU) + (size_t)u.e * DEXP * D;
        b0 = g + (size_t)(u.pn * 128) * 2048; b1 = up + (size_t)(u.pn * 128) * 2048;
    }
};
struct EpiSwiglu {
    static constexpr bool PERM = true, MIDK = false;
    unsigned char* ws; LAS int* tb;
    __device__ __forceinline__ void operator()(const f32x4 (&acc)[2][2][4][2], const pg8::Unit& u, int wr, int wc, int fr_, int fq_) const {
        int fr = fr_, fq = fq_; OPAQUE_V(fr); OPAQUE_V(fq);
        unsigned char* ACT = ws + WS_ACT;
        const LaneT lt(fr, fq);
        const int rbase = tb[136 + u.e] + u.pm * 256, col0 = u.pn * 128 + wc * 32 + 8 * lt.c2;
#pragma unroll
        for (int ai = 0; ai < 2; ++ai)
#pragma unroll
            for (int m = 0; m < 4; ++m) {
                const int rt = ai * 128 + wr * 64 + m * 16 + lt.r2;
                float y[8];
#pragma unroll
                for (int n = 0; n < 2; ++n)
#pragma unroll
                    for (int j = 0; j < 4; ++j) { const float gt = acc[ai][0][m][n][j], upv = acc[ai][1][m][n][j]; y[4 * n + j] = fminf(fmaxf(gt * fsigmoid(gt) * upv, -448.f), 448.f); }
                v2u w; w.x = pk4_fp8(y[0], y[1], y[2], y[3]); w.y = pk4_fp8(y[4], y[5], y[6], y[7]);
                w = lt.t2(w);
                if (rt < u.cnt) *(GAS v2u*)(ACT + (size_t)(rbase + rt) * DEXP + col0) = w;
            }
    }
};
struct MoeGemm2 : MoeOrder<8> {
    static constexpr bool GATHER = false;
    unsigned char* ws; unsigned lda2, ldb2; int nt;
    __device__ __forceinline__ const char* aptr(const pg8::Unit& u) const { return (const char*)(ws + WS_ACT) + (size_t)(tb[136 + u.e] + u.pm * 256) * 512; }
    __device__ __forceinline__ void aoffs(const pg8::Unit&, int, unsigned (&)[2][2]) const {}
    __device__ __forceinline__ void bptrs(const pg8::Unit& u, const char*& b0, const char*& b1) const {
        const char* dn = (u.e == 64) ? (const char*)(ws + WS_WSH + 4 * MiB) : (const char*)(ws + WS_WDOWN) + (size_t)u.e * D * DEXP;
        b0 = dn + (size_t)(u.pn * 256) * 512; b1 = b0 + (size_t)128 * 512;
    }
};
struct EpiDown {
    static constexpr bool PERM = true, MIDK = false;
    unsigned char* ws; float* out; const float* mod;
    __device__ __forceinline__ void operator()(const f32x4 (&acc)[2][2][4][2], const pg8::Unit& u, int wr, int wc, int fr_, int fq_) const {
        int fr = fr_, fq = fq_; OPAQUE_V(fr); OPAQUE_V(fq);
        const int* LTOK = (const int*)(ws + WS_LTOK); const float* LW = (const float*)(ws + WS_LW); unsigned char* Y = ws + WS_Y;
        const int col0 = u.pn * 256 + wc * 32 + 8 * fq;
        if (u.e == 64) {
            bf16* YSH = (bf16*)(ws + WS_YSH); const LaneT lt(fr, fq);
#pragma unroll
            for (int ai = 0; ai < 2; ++ai)
#pragma unroll
                for (int m = 0; m < 4; ++m) {
                    const int rt = ai * 128 + wr * 64 + m * 16 + lt.r2, t = u.pm * 256 + rt;
#pragma unroll
                    for (int bj = 0; bj < 2; ++bj) { const f32x4 v0 = acc[ai][bj][m][0], v1 = acc[ai][bj][m][1];
                        v4u pw; pw.x = pk2(v0[0], v0[1]); pw.y = pk2(v0[2], v0[3]); pw.z = pk2(v1[0], v1[1]); pw.w = pk2(v1[2], v1[3]);
                        *(GAS v4u*)(YSH + (size_t)t * D + u.pn * 256 + wc * 32 + 8 * lt.c2 + bj * 128) = lt.t4(pw); }
                }
        } else {
            const int r2 = (fr + 16 * fq) >> 2, c2 = fr & 3, bsrc = ((c2 << 4) | r2) << 2;
            int tk[8]; float w8[8];
            const int pbase = u.e * 16384 + u.pm * 256, lastr = u.cnt - 1;
#pragma unroll
            for (int i = 0; i < 8; ++i) { const int rb = (i >> 2) * 128 + wr * 64 + (i & 3) * 16, ro = rb + fr, rn = rb + r2;
                w8[i] = *(const GAS float*)(LW + pbase + (ro < lastr ? ro : lastr)) * Y8_SCALE; tk[i] = *(const GAS int*)(LTOK + pbase + (rn < lastr ? rn : lastr)); }
            const int colw = u.pn * 256 + wc * 32 + 8 * c2;
#pragma unroll
            for (int ai = 0; ai < 2; ++ai)
#pragma unroll
                for (int m = 0; m < 4; ++m) {
                    const int rn = ai * 128 + wr * 64 + m * 16 + r2; const float w = w8[ai * 4 + m];
#pragma unroll
                    for (int bj = 0; bj < 2; ++bj) { f32x4 v0 = acc[ai][bj][m][0] * w, v1 = acc[ai][bj][m][1] * w;
#pragma unroll
                        for (int j = 0; j < 4; ++j) { v0[j] = fminf(fmaxf(v0[j], -448.f), 448.f); v1[j] = fminf(fmaxf(v1[j], -448.f), 448.f); }
                        v2u pw; pw.x = (unsigned)__builtin_amdgcn_ds_bpermute(bsrc, (int)pk4_fp8(v0[0], v0[1], v0[2], v0[3])); pw.y = (unsigned)__builtin_amdgcn_ds_bpermute(bsrc, (int)pk4_fp8(v1[0], v1[1], v1[2], v1[3]));
                        if (rn < u.cnt) *(GAS v2u*)(Y + (size_t)tk[ai * 4 + m] * D + colw + bj * 128) = pw; }
                }
        }
    }
};
__device__ __forceinline__ void phase_combine(Frame& F, const Args& a) {
    PHASE_IDS();
    const unsigned char* Y = F.ws + WS_Y; const float* mod = (const float*)(F.ctl + CW_MOD); float* out = a.out;
    const int NIT = T * (D / 8);
    const bool bad = xb_ld(F.ctl + CW_BAR + XB_TMO) != 0u;
    for (int it = F.vcu * NTHREADS + tid; it < NIT; it += F.G * NTHREADS) {
        const int t = it >> 8, c8 = (it & 255) * 8, b = t / SEQ;
        float s[8];
#pragma unroll
        for (int j = 0; j < 8; ++j) s[j] = 0.f;
#pragma unroll
        for (int k = 0; k < 8; ++k) { const v2u w = *(const GAS v2u*)(Y + ((size_t)t * 8 + k) * D + c8);
            const auto f0 = __builtin_amdgcn_cvt_pk_f32_fp8((int)w.x, false), f1 = __builtin_amdgcn_cvt_pk_f32_fp8((int)w.x, true), f2 = __builtin_amdgcn_cvt_pk_f32_fp8((int)w.y, false), f3 = __builtin_amdgcn_cvt_pk_f32_fp8((int)w.y, true);
            s[0] += f0[0]; s[1] += f0[1]; s[2] += f1[0]; s[3] += f1[1]; s[4] += f2[0]; s[5] += f2[1]; s[6] += f3[0]; s[7] += f3[1]; }
#pragma unroll
        for (int j = 0; j < 8; ++j) s[j] *= (1.0f / Y8_SCALE);
        const f32x4 g0 = *(const GAS f32x4*)(mod + b * 12288 + 10240 + c8), g1 = *(const GAS f32x4*)(mod + b * 12288 + 10240 + c8 + 4);
        GAS f32x4* o = (GAS f32x4*)(out + (size_t)t * D + c8);
        float xv[8], sh[8]; unpack8(*(const GAS v4u*)((const bf16*)(F.ws + WS_X1B) + (size_t)t * D + c8), xv); unpack8(*(const GAS v4u*)((const bf16*)(F.ws + WS_YSH) + (size_t)t * D + c8), sh);
#pragma unroll
        for (int j = 0; j < 8; ++j) s[j] += sh[j];
        const f32x4 o0 = (f32x4){xv[0], xv[1], xv[2], xv[3]}, o1 = (f32x4){xv[4], xv[5], xv[6], xv[7]};
        f32x4 r0 = o0 + g0 * (f32x4){s[0], s[1], s[2], s[3]}; const f32x4 r1 = o1 + g1 * (f32x4){s[4], s[5], s[6], s[7]};
        if (bad) r0.x = __builtin_nanf("");
        o[0] = r0; o[1] = r1;
    }
}

__global__ void __launch_bounds__(NTHREADS, 2) fwd_kernel(Args args) {
    extern __shared__ __attribute__((aligned(16))) unsigned char lds[];
    Frame F;
    F.lds = (LAS unsigned char*)lds;
    F.MISC = (volatile LAS unsigned*)(F.lds + MISC_OFF);
    F.tid = threadIdx.x; F.lane = F.tid & 63; F.wave = __builtin_amdgcn_readfirstlane(F.tid >> 6);
    F.G = gridDim.x; { const int bx = blockIdx.x; F.vcu = (F.G % 8 == 0) ? (bx % 8) * (F.G / 8) + bx / 8 : bx; }
    F.ws = args.ws; F.ctl = (unsigned*)(args.ws + WS_CTL); F.vec = (float*)(args.ws + WS_VEC);
    for (int u = F.tid; u < 256; u += NTHREADS) ((LAS unsigned*)(F.lds + MISC_OFF))[u] = 0u;
    __syncthreads();
    XcdBarrier bar = xcd_barrier_post(F.ctl + CW_BAR, F.MISC + 8);
    unsigned char* ws = args.ws;

#define PH_MOD()   do { phase_mod(F, args); } while (0)
#define PH_PREP1() do { phase_prep1(F, args); } while (0)
#define PH_HROWS() do { phase_hrows(F, args); } while (0)
#define PH_INPROJ() do { { DenseGemm g; g.init(T, 6144, F.G, (int)blockIdx.x); g.A = (const char*)(ws + WS_H); g.Bt = (const char*)(ws + WS_WIN); g.lda2 = D * 2; g.ldb2 = D * 2; g.nt = D / 64; \
          EpiInProj<0> E{ws}; pg8::gemm_phase<DenseGemm, EpiInProj<0>>(F.lds, g, E); } \
        { DenseGemm g; g.init(T, 5120, F.G, (int)blockIdx.x); g.A = (const char*)(ws + WS_H8); g.Bt = (const char*)(ws + WS_WIN8); g.lda2 = D; g.ldb2 = D; g.nt = D / 128; \
          EpiInProj<1> E{ws}; pg8::gemm_phase<DenseGemm, EpiInProj<1>, true>(F.lds, g, E); } } while (0)
#define PH_H1()    do { phase_h1(F); } while (0)
#define PH_QKP()   do { phase_qkprep(F, args); } while (0)
#define PH_H2()    do { phase_h2(F); } while (0)
#define PH_H3()    do { phase_h3(F, args); } while (0)
#define PH_ATTN()  do { phase_attn(F, args, 0, 4); } while (0)
#define PH_MERGE() do { DenseGemm g; g.init(T, D, F.G, (int)blockIdx.x); g.A = (const char*)(ws + WS_BR); g.Bt = (const char*)(ws + WS_WA); g.lda2 = D * 2; g.ldb2 = D * 2; g.nt = D / 64; \
        EpiMergeF E{ws}; pg8::gemm_phase<DenseGemm, EpiMergeF>(F.lds, g, E); } while (0)
#define PH_OUTPROJ() do { DenseGemm g; g.init(T, D, F.G, (int)blockIdx.x); g.A = (const char*)(ws + WS_MERGED); g.Bt = (const char*)(ws + WS_WOUT); g.lda2 = D * 2; g.ldb2 = D * 2; g.nt = D / 64; \
        EpiOutProj E{args.in[IN_X], (bf16*)(ws + WS_X1B), (const float*)(F.ctl + CW_MOD)}; pg8::gemm_phase<DenseGemm, EpiOutProj>(F.lds, g, E); } while (0)
#define PH_ROUTER() do { phase_router(F, args); } while (0)
#define PH_CONVX()  do { phase_convert_experts(F, args); } while (0)
#define PH_MOE1()  do { MoeGemm1 g; g.tb = (LAS int*)(F.lds + MOE_TB); g.G = F.G; g.c = F.vcu; g.ws = ws; g.lda2 = D; g.ldb2 = D; g.nt = D / 128; \
        EpiSwiglu E{ws, (LAS int*)(F.lds + MOE_TB)}; pg8::gemm_phase<MoeGemm1, EpiSwiglu, true>(F.lds, g, E); } while (0)
#define PH_MOE2()  do { MoeGemm2 g; g.tb = (LAS int*)(F.lds + MOE_TB); g.G = F.G; g.c = F.vcu; g.ws = ws; g.lda2 = DEXP; g.ldb2 = DEXP; g.nt = DEXP / 128; \
        EpiDown E{ws, args.out, (const float*)(F.ctl + CW_MOD)}; pg8::gemm_phase<MoeGemm2, EpiDown, true>(F.lds, g, E); } while (0)
#define PH_COMBINE() do { phase_combine(F, args); } while (0)
#ifndef REPEAT_PHASE
#define REPEAT_PHASE -1
#endif
#define RUN(k, X) do { X; if (REPEAT_PHASE == (k)) { xcd_barrier(bar); X; } } while (0)
    if (F.vcu & 1) { PH_PREP1(); __syncthreads(); PH_MOD(); } else { PH_MOD(); __syncthreads(); PH_PREP1(); }
    xcd_barrier(bar);
    RUN(1, PH_HROWS());    xcd_barrier(bar);
    RUN(2, PH_INPROJ());   xcd_barrier(bar);
    if (F.vcu & 1) { PH_QKP(); PH_H1(); } else { PH_H1(); PH_QKP(); }
    xcd_barrier(bar);
    PH_H2();
    xcd_barrier(bar);
    PH_H3(); phase_attn(F, args, 0, 4);
    xcd_barrier(bar);
    RUN(8, PH_MERGE());    xcd_barrier(bar);
    RUN(9, PH_OUTPROJ());  xcd_barrier(bar);
    PH_ROUTER();           xcd_barrier(bar);
    moe_build_table(F);
    RUN(11, PH_MOE1());    xcd_barrier(bar);
    PH_MOE2();             xcd_barrier(bar);
    PH_COMBINE();
}

extern "C" void kernel_launch(void* const* d_in, const int* in_sizes, int n_in, void* d_out, int out_size, void* d_ws, size_t ws_size, hipStream_t stream) {
    static int grid = 0;
    if (grid == 0) {
        int dev = 0, cus = 0;
        if (n_in != 28 || ws_size < WS_NEED || out_size != T * D) { fprintf(stderr, "kernel_launch: unexpected n_in %d / ws %zu / out %d\n", n_in, ws_size, out_size); grid = -1; return; }
        if (hipGetDevice(&dev) != hipSuccess || hipDeviceGetAttribute(&cus, hipDeviceAttributeMultiprocessorCount, dev) != hipSuccess) { grid = -1; return; }
        if (hipFuncSetAttribute((const void*)fwd_kernel, hipFuncAttributeMaxDynamicSharedMemorySize, LDS_BYTES) != hipSuccess) { grid = -1; return; }
        int per_cu = 0;
        (void)hipOccupancyMaxActiveBlocksPerMultiprocessor(&per_cu, (const void*)fwd_kernel, NTHREADS, LDS_BYTES);
        (void)hipGetLastError();
        grid = cus;
        if (cus != 256) { fprintf(stderr, "kernel_launch: built for a 256-CU MI355X (static work split), found %d CUs; nothing launched\n", cus); grid = -1; return; }
    }
    if (grid < 0) return;
    if (hipMemsetAsync((char*)d_ws + WS_CTL, 0, CTL_ZERO_BYTES, stream) != hipSuccess) return;
    Args a{};
    for (int i = 0; i < 28; ++i) a.in[i] = (const float*)d_in[i];
    a.out = (float*)d_out; a.ws = (unsigned char*)d_ws; a.ph_lo = 0; a.ph_hi = 100;
    hipLaunchKernelGGL(fwd_kernel, dim3(grid), dim3(NTHREADS), LDS_BYTES, stream, a);
}
```

```cpp
#include <hip/hip_runtime.h>
#include <cstdio>
#include <cstdint>

#define GAS __attribute__((address_space(1)))
#define LAS __attribute__((address_space(3)))
typedef unsigned short bf16;
typedef unsigned v4u __attribute__((ext_vector_type(4)));
typedef unsigned v2u __attribute__((ext_vector_type(2)));
typedef float f32x4 __attribute__((ext_vector_type(4)));
typedef float f32x2 __attribute__((ext_vector_type(2)));
typedef float f32x16 __attribute__((ext_vector_type(16)));
typedef short bf16x8 __attribute__((ext_vector_type(8)));
typedef short s16x4 __attribute__((ext_vector_type(4)));
typedef int i32x4 __attribute__((ext_vector_type(4)));
typedef int i32x8 __attribute__((ext_vector_type(8)));

#ifndef STAGE_MAX
#define STAGE_MAX 99
#endif

constexpr int D = 2048, BATCH = 4, SEQ = 4096, T = BATCH * SEQ;
constexpr int HGH = 8, HGD = 128, CHUNK = 64, NCHUNK = SEQ / CHUNK;
constexpr int NCH_UNITS = BATCH * HGH * NCHUNK;
constexpr int DAH = 8, DADH = 64, DADV = 128;
constexpr int INCOLS = 11264;
constexpr int NEXP = 64, TOPK = 8, DEXP = 512;
constexpr float EPS = 1e-6f;
constexpr float LOG2E = 1.4426950408889634f;
constexpr float LAMBDA_INIT = 0.2f;
constexpr int NWAVES = 8, NTHREADS = NWAVES * 64;
constexpr int LDS_BYTES = 147456;
constexpr int MISC_OFF = 131072;

constexpr size_t MiB = 1u << 20;
constexpr size_t WS_CTL = 0, CTL_ZERO_BYTES = 64 * 1024;
constexpr size_t WS_VEC = 1 * MiB;
constexpr size_t WS_LTOK = 2 * MiB, WS_LW = 6 * MiB;
constexpr size_t WS_WSH = 10 * MiB;
constexpr size_t WS_WIN = 16 * MiB;
constexpr size_t WS_WIN8 = 40 * MiB;
constexpr size_t WS_H8 = 848 * MiB;
constexpr size_t WS_WA = 60 * MiB, WS_WB = 64 * MiB;
constexpr size_t WS_WOUT = 68 * MiB;
constexpr size_t WS_H = 76 * MiB;
constexpr size_t WS_PROJ = 140 * MiB;
constexpr size_t WS_HQ = WS_PROJ, WS_HF = WS_PROJ + 32 * MiB, WS_HI = WS_PROJ + 64 * MiB, WS_HG = WS_PROJ + 96 * MiB;
constexpr size_t WS_DQ = WS_PROJ + 128 * MiB, WS_DK = WS_PROJ + 160 * MiB, WS_DV = WS_PROJ + 192 * MiB;
constexpr size_t WS_GA = WS_PROJ + 224 * MiB, WS_GB = WS_PROJ + 288 * MiB;
constexpr size_t WS_ST = 492 * MiB;
constexpr size_t WS_DEC = 556 * MiB;
constexpr size_t WS_OI = 560 * MiB;
constexpr size_t WS_BR = 624 * MiB;
constexpr size_t WS_MERGED = 688 * MiB;
constexpr size_t WS_QT = 752 * MiB;
constexpr size_t WS_DQN = 784 * MiB, WS_DKN = 816 * MiB;
constexpr size_t WS_WDOWN = 882 * MiB;
constexpr size_t WS_ACT = 144 * MiB;
constexpr size_t WS_WG = 946 * MiB, WS_WU = 1010 * MiB;
constexpr size_t WS_H2 = 546 * MiB;
constexpr size_t WS_Y = 290 * MiB;
constexpr float Y8_SCALE = 32.0f;
constexpr size_t WS_X1B = WS_H;
constexpr size_t WS_YSH = WS_BR;
constexpr size_t WS_NEED = 1074 * MiB;

constexpr int CW_BAR = 4096;
constexpr int CW_CNT = 8192;
constexpr int CW_MOD = 16384;
constexpr int VW_LB = 0;
constexpr int VW_LAM = 1024, VW_M2 = 1025;
constexpr int VW_TBL = 2048;
constexpr size_t WS_RWT_HI = WS_VEC + 65536, WS_RWT_LO = WS_VEC + 65536 + 262144;

#define RLX_AGENT __ATOMIC_RELAXED, __HIP_MEMORY_SCOPE_AGENT
#define LDS_WAIT() asm volatile("s_waitcnt lgkmcnt(0)" ::: "memory")
#define VM_WAIT() asm volatile("s_waitcnt vmcnt(0)" ::: "memory")
__device__ __forceinline__ unsigned f2bf_sw(float f) { unsigned u = __builtin_bit_cast(unsigned, f); return (u + 0x7fffu + ((u >> 16) & 1u)) >> 16; }
typedef __bf16 bf16x2v __attribute__((ext_vector_type(2)));
__device__ __forceinline__ unsigned pk2(float lo, float hi) { const f32x2 v = {lo, hi}; return __builtin_bit_cast(unsigned, __builtin_convertvector(v, bf16x2v)); }
__device__ __forceinline__ unsigned f2bf(float f) { return (unsigned)__builtin_bit_cast(unsigned short, (__bf16)f); }
__device__ __forceinline__ float bf2f(unsigned b) { return __builtin_bit_cast(float, b << 16); }
__device__ __forceinline__ float bflo(unsigned w) { return __builtin_bit_cast(float, w << 16); }
__device__ __forceinline__ float bfhi(unsigned w) { return __builtin_bit_cast(float, w & 0xffff0000u); }
__device__ __forceinline__ float fsigmoid(float x) { return __builtin_amdgcn_rcpf(1.0f + __expf(-x)); }
__device__ __forceinline__ void unpack8(const v4u w, float (&x)[8]) { x[0] = bflo(w.x); x[1] = bfhi(w.x); x[2] = bflo(w.y); x[3] = bfhi(w.y); x[4] = bflo(w.z); x[5] = bfhi(w.z); x[6] = bflo(w.w); x[7] = bfhi(w.w); }
__device__ __forceinline__ void unpack8_fp8(unsigned w0, unsigned w1, float (&x)[8]) {
    const auto a = __builtin_amdgcn_cvt_pk_f32_fp8((int)w0, false), b = __builtin_amdgcn_cvt_pk_f32_fp8((int)w0, true), c = __builtin_amdgcn_cvt_pk_f32_fp8((int)w1, false), d = __builtin_amdgcn_cvt_pk_f32_fp8((int)w1, true);
    x[0] = a[0]; x[1] = a[1]; x[2] = b[0]; x[3] = b[1]; x[4] = c[0]; x[5] = c[1]; x[6] = d[0]; x[7] = d[1]; }
__device__ __forceinline__ float wave_sum(float v) {
#pragma unroll
    for (int o = 1; o < 64; o <<= 1) v += __shfl_xor(v, o);
    return v;
}

template <int CTRL> __device__ __forceinline__ float dppf(float v) { return __builtin_bit_cast(float, __builtin_amdgcn_update_dpp(0, __builtin_bit_cast(int, v), CTRL, 0xF, 0xF, true)); }
__device__ __forceinline__ float rlf(float v, int l) { return __builtin_bit_cast(float, __builtin_amdgcn_readlane(__builtin_bit_cast(int, v), l)); }
__device__ __forceinline__ float max8_dpp(float v) { v = fmaxf(v, dppf<0xB1>(v)); v = fmaxf(v, dppf<0x4E>(v)); return fmaxf(v, dppf<0x141>(v)); }
__device__ __forceinline__ float wave_sum_dpp(float v) { v += dppf<0xB1>(v); v += dppf<0x4E>(v); v += dppf<0x141>(v); v += dppf<0x140>(v); return (rlf(v, 0) + rlf(v, 16)) + (rlf(v, 32) + rlf(v, 48)); }

#define XB_TMO      128
#define XB_XCNT(j)  (256  + 64 * (j))
#define XB_XSUB(j)  (1280 + 64 * (j))
#define XB_XGEN(j)  (2304 + 64 * (j))
#define XB_TOP      3328
#define XB_TOPGEN   3392
#define XCD_BAR_WORDS 3456
#define XB_SPIN_CAP (1u << 18)
__device__ __forceinline__ unsigned xb_ld(unsigned* p)              { return __hip_atomic_load(p, __ATOMIC_RELAXED, __HIP_MEMORY_SCOPE_AGENT); }
__device__ __forceinline__ unsigned xb_add(unsigned* p, unsigned v) { return __hip_atomic_fetch_add(p, v, __ATOMIC_RELAXED, __HIP_MEMORY_SCOPE_AGENT); }
__device__ __forceinline__ unsigned xb_xcc_id() { return (unsigned)__builtin_amdgcn_s_getreg((3 << 11) | 20) & 0xFu; }
#define XB_SPIN(cond, bar) do { unsigned _sp = 0; while (cond) { __builtin_amdgcn_s_sleep(1); \
    if ((++_sp & 255u) == 0u) { if (xb_ld(&(bar)[XB_TMO])) break; if (_sp > XB_SPIN_CAP) { atomicAdd(&(bar)[XB_TMO], 1u); break; } } } } while (0)
struct XcdBarrier { unsigned* bar; unsigned x; volatile LAS unsigned* st; };
__device__ __forceinline__ XcdBarrier xcd_barrier_post(unsigned* bar, volatile LAS unsigned* st) {
    XcdBarrier b; b.bar = bar; b.x = xb_xcc_id(); b.st = st;
    if (threadIdx.x == 0) (void)xb_add(&bar[XB_XCNT(b.x)], 1u);
    return b;
}
__device__ __forceinline__ void xcd_barrier_complete(unsigned* bar, unsigned x, unsigned& nloc, unsigned& nx) {
    const unsigned G = gridDim.x * gridDim.y * gridDim.z;
    unsigned sum, cnt, mine, sp = 0u;
    for (;;) {
        sum = 0u; cnt = 0u; mine = 0u;
#pragma unroll
        for (unsigned j = 0; j < 16; ++j) { const unsigned c = xb_ld(&bar[XB_XCNT(j)]); sum += c; cnt += (c > 0u) ? 1u : 0u; mine = (j == x) ? c : mine; }
        if (sum == G) break;
        __builtin_amdgcn_s_sleep(1);
        if ((++sp & 255u) == 0u) { if (xb_ld(&bar[XB_TMO])) break; if (sp > XB_SPIN_CAP) { atomicAdd(&bar[XB_TMO], 1u); break; } }
    }
    nloc = mine > 0u ? mine : 1u; nx = cnt > 0u ? cnt : 1u;
}
__device__ __forceinline__ void xcd_barrier(const XcdBarrier& b) {
    asm volatile("s_waitcnt vmcnt(0)" ::: "memory");
    __syncthreads();
    if (threadIdx.x == 0) {
        unsigned* bar = b.bar;
        __builtin_amdgcn_s_waitcnt(0);
        unsigned nloc = b.st[0], nx = b.st[1];
        if (nloc == 0u) { xcd_barrier_complete(bar, b.x, nloc, nx); b.st[0] = nloc; b.st[1] = nx; }
        const unsigned old = xb_add(&bar[XB_XSUB(b.x)], 1u);
        const unsigned gen = old / nloc;
        if (old + 1u == (gen + 1u) * nloc) {
            __builtin_amdgcn_fence(__ATOMIC_RELEASE, "agent");
            asm volatile("s_waitcnt vmcnt(0)" ::: "memory");
            const unsigned og = xb_add(&bar[XB_TOP], 1u);
            const unsigned tg = og / nx;
            if (og + 1u == (tg + 1u) * nx) xb_add(&bar[XB_TOPGEN], 1u);
            else XB_SPIN(xb_ld(&bar[XB_TOPGEN]) == tg, bar);
            __builtin_amdgcn_fence(__ATOMIC_ACQUIRE, "agent");
            xb_add(&bar[XB_XGEN(b.x)], 1u);
            asm volatile("s_waitcnt vmcnt(0)" ::: "memory");
        } else {
            XB_SPIN(xb_ld(&bar[XB_XGEN(b.x)]) == gen, bar);
            __builtin_amdgcn_fence(__ATOMIC_ACQUIRE, "agent");
            asm volatile("s_waitcnt vmcnt(0)" ::: "memory");
        }
    }
    __syncthreads();
}

namespace pg8 {
constexpr int BM = 256, BK = 64, HALF = 128, HTB = HALF * BK * 2, STAGE_BYTES = 8 * HTB, NXCD = 8, WGM = 8;
__host__ __device__ __forceinline__ int lds_byte(int r, int c) { const int st = (r >> 4) * 2 + (c >> 5), rr = r & 15, cc = c & 31, ob = rr * 64 + cc * 2; return st * 1024 + (ob ^ (((ob >> 9) & 1) << 5)); }
__host__ __device__ __forceinline__ void stage_rc(int b, int& R, int& C) { const int st = b / 1024, sb = b % 1024, swz = sb ^ (((sb >> 9) & 1) << 5); R = (st >> 1) * 16 + swz / 64; C = (st & 1) * 32 + (swz % 64) / 2; }
__host__ __device__ __forceinline__ int perm32(int rho) { const int n = rho >> 4, i = rho & 15; return 8 * (i >> 2) + 4 * n + (i & 3); }
__device__ __forceinline__ unsigned cvt_pk_bf16(float lo, float hi) { unsigned r; asm volatile("v_cvt_pk_bf16_f32 %0, %1, %2" : "=v"(r) : "v"(lo), "v"(hi)); return r; }

struct Unit { int pm, pn, e, cnt; };

struct DenseOrder {
    int nM, nN, nwg, G, c;
    __device__ void init(int M, int N, int G_, int c_) { nM = M / BM; nN = N / BM; nwg = nM * nN; G = G_; c = c_; }
    __device__ bool next(int i, Unit& u) const {
        const long L = (long)i * G + c; if (L >= nwg) return false;
        int wgid = (int)L; { const int q = nwg / NXCD, r = nwg % NXCD, xcd = wgid % NXCD, off = wgid / NXCD; wgid = (xcd < r ? xcd * (q + 1) : r * (q + 1) + (xcd - r) * q) + off; }
        const int nig = WGM * nN, gid = wgid / nig, fm = gid * WGM, gsz = (nM - fm) < WGM ? (nM - fm) : WGM;
        u.pm = fm + ((wgid % nig) % gsz); u.pn = (wgid % nig) / gsz; u.e = 0; u.cnt = 256; return true;
    }
};

template <class P, class Epi, bool FP8 = false>
__device__ __forceinline__ void gemm_phase(LAS unsigned char* lds, const P& S, const Epi& E) {
    int tid_ = threadIdx.x; asm volatile("" : "+v"(tid_));
    const int tid = tid_, wid = __builtin_amdgcn_readfirstlane(tid >> 6), lane = tid & 63, wr = wid >> 2, wc = wid & 3, fr = lane & 15, fq = lane >> 4;
    const int nt = S.nt;
    unsigned voffA[2], voffB[2];
    { int R0, C0, R1, C1; stage_rc(tid * 16, R0, C0); stage_rc(tid * 16 + 8192, R1, C1);
      const int Rb0 = Epi::PERM ? ((R0 & ~31) + perm32(R0 & 31)) : R0, Rb1 = Epi::PERM ? ((R1 & ~31) + perm32(R1 & 31)) : R1;
      voffB[0] = (unsigned)Rb0 * S.ldb2 + (unsigned)C0 * 2u; voffB[1] = (unsigned)Rb1 * S.ldb2 + (unsigned)C1 * 2u;
      if constexpr (!P::GATHER) { voffA[0] = (unsigned)R0 * S.lda2 + (unsigned)C0 * 2u; voffA[1] = (unsigned)R1 * S.lda2 + (unsigned)C1 * 2u; } else { voffA[0] = 0u; voffA[1] = 0u; } }
    const unsigned ldsw = (unsigned)wid * 1024u;
    const int aoff = lds_byte(wr * 64 + fr, fq * 8), boff = lds_byte(wc * 32 + fr, fq * 8);
#define PG8_SA(b, h) (((b) * 2 + (h)) * HTB)
#define PG8_SB(b, h) ((4 + (b) * 2 + (h)) * HTB)
#define PG8_STAGE_A(bufoff, aptr, koff, h) do { _Pragma("unroll") for (int _i = 0; _i < 2; ++_i) { \
        const char* _src; if constexpr (P::GATHER) _src = (aptr) + (size_t)ga[h][_i] + (size_t)(koff); else _src = (aptr) + (size_t)(h) * hstepA + (size_t)voffA[_i] + (size_t)(koff); \
        __builtin_amdgcn_global_load_lds((const unsigned*)_src, (LAS unsigned*)(lds + (bufoff) + ldsw + _i * 8192), 16, 0, 0); } } while (0)
#define PG8_STAGE_B(bufoff, bptr) do { _Pragma("unroll") for (int _i = 0; _i < 2; ++_i) \
        __builtin_amdgcn_global_load_lds((const unsigned*)((bptr) + voffB[_i]), (LAS unsigned*)(lds + (bufoff) + ldsw + _i * 8192), 16, 0, 0); } while (0)
#define PG8_LD16(off) (*(const LAS i32x4*)(lds + (off)))
#define PG8_LDA(dst, b, h) do { _Pragma("unroll") for (int m = 0; m < 4; ++m) { \
        if constexpr (FP8) { const i32x4 _l = PG8_LD16(PG8_SA(b, h) + aoff + m * 2048), _h = PG8_LD16(PG8_SA(b, h) + aoff + m * 2048 + 1024); dst[m] = __builtin_shufflevector(_l, _h, 0, 1, 2, 3, 4, 5, 6, 7); } \
        else { dst##16[m][0] = *(const LAS bf16x8*)(lds + PG8_SA(b, h) + aoff + m * 2048); dst##16[m][1] = *(const LAS bf16x8*)(lds + PG8_SA(b, h) + aoff + m * 2048 + 1024); } } } while (0)
#define PG8_LDB(dst, b, h) do { _Pragma("unroll") for (int n = 0; n < 2; ++n) { \
        if constexpr (FP8) { const i32x4 _l = PG8_LD16(PG8_SB(b, h) + boff + n * 2048), _h = PG8_LD16(PG8_SB(b, h) + boff + n * 2048 + 1024); dst[n] = __builtin_shufflevector(_l, _h, 0, 1, 2, 3, 4, 5, 6, 7); } \
        else { dst##16[n][0] = *(const LAS bf16x8*)(lds + PG8_SB(b, h) + boff + n * 2048); dst##16[n][1] = *(const LAS bf16x8*)(lds + PG8_SB(b, h) + boff + n * 2048 + 1024); } } } while (0)
#define PG8_MMA(ai, bj, At, Bt) do { __builtin_amdgcn_s_setprio(1); _Pragma("unroll") for (int m = 0; m < 4; ++m) _Pragma("unroll") for (int n = 0; n < 2; ++n) { \
        if constexpr (FP8) {   \
            asm volatile("v_mfma_scale_f32_16x16x128_f8f6f4 %0, %1, %2, %0, %3, %4 op_sel_hi:[0,0,0]" : "+v"(acc[ai][bj][m][n]) : "v"(Bt[n]), "v"(At[m]), "v"(scw), "v"(scx)); \
        } else { _Pragma("unroll") for (int k = 0; k < 2; ++k) \
            acc[ai][bj][m][n] = __builtin_amdgcn_mfma_f32_16x16x32_bf16(Bt##16[n][k], At##16[m][k], acc[ai][bj][m][n], 0, 0, 0); } } \
        __builtin_amdgcn_s_setprio(0); } while (0)
#define PG8_WAIT_V(n) asm volatile("s_waitcnt vmcnt(" #n ")" ::: "memory")
#define PG8_WAIT_L(n) asm volatile("s_waitcnt lgkmcnt(" #n ")" ::: "memory")
#define PG8_BAR __builtin_amdgcn_s_barrier()
#define PG8_SCHED __builtin_amdgcn_sched_barrier(0)
    Unit cur, nxt; int ui = 0;
    if (!S.next(0, cur)) return;
    f32x4 acc[2][2][4][2];
#pragma unroll
    for (int a = 0; a < 2; ++a)
#pragma unroll
        for (int b = 0; b < 2; ++b)
#pragma unroll
            for (int m = 0; m < 4; ++m)
#pragma unroll
                for (int n = 0; n < 2; ++n) acc[a][b][m][n] = (f32x4){0.f, 0.f, 0.f, 0.f};
    const int scw = 0x7a7a7a7a, scx = 0x7f7f7f7f;
    i32x8 At[4], B0[2], B1[2]; bf16x8 At16[4][2], B016[2][2], B116[2][2];
    unsigned ga[2][2] = {{0u, 0u}, {0u, 0u}};
    const size_t hstepA = P::GATHER ? (size_t)0 : (size_t)128 * S.lda2;
    const char *cA, *nA, *cB0, *cB1, *nB0, *nB1;
    cA = S.aptr(cur); if constexpr (P::GATHER) S.aoffs(cur, tid, ga);
    S.bptrs(cur, cB0, cB1);
    const size_t kstep = (size_t)(BK * 2);
    PG8_STAGE_B(PG8_SB(0, 0), cB0); PG8_STAGE_B(PG8_SB(0, 1), cB1); PG8_STAGE_A(PG8_SA(0, 0), cA, 0, 0); PG8_STAGE_A(PG8_SA(0, 1), cA, 0, 1);
    if (wr == 1) PG8_BAR;
    PG8_WAIT_V(2); PG8_BAR;
    PG8_STAGE_B(PG8_SB(1, 0), cB0 + kstep); PG8_STAGE_A(PG8_SA(1, 0), cA, kstep, 0); PG8_STAGE_B(PG8_SB(1, 1), cB1 + kstep);
    PG8_WAIT_V(6); PG8_BAR;
    for (;;) {
        const bool has_next = S.next(ui + 1, nxt);
        if (has_next) { nA = S.aptr(nxt); S.bptrs(nxt, nB0, nB1); } else { nxt = cur; nA = cA; nB0 = cB0; nB1 = cB1; }
        if constexpr (P::GATHER) { if (has_next) S.prefetch_rows(nxt, lds, wid, lane, (ui + 1) & 1); }
        for (int t = 0; t < nt; t += 2) {
            if constexpr (Epi::MIDK) { if (t == (nt >> 1)) E.mid(acc, cur, wr, wc, fr, fq); }
            const bool last = (t == nt - 2);
            const size_t k1 = (size_t)(t + 1) * kstep;
            const size_t k2 = last ? (size_t)0 : (size_t)(t + 2) * kstep, k3 = k2 + kstep;
            const char* a2 = last ? nA : cA;
            const char* b20 = (last ? nB0 : cB0) + k2; const char* b21 = (last ? nB1 : cB1) + k2;
            const char* b30 = b20 + kstep; const char* b31 = b21 + kstep;
            PG8_LDB(B0, 0, 0); PG8_LDB(B1, 0, 1); PG8_SCHED; PG8_LDA(At, 0, 0); PG8_STAGE_A(PG8_SA(1, 1), cA, k1, 1);
            if constexpr (P::GATHER) { if (last && has_next) S.aoffs_mb(nxt, tid, ga, lds, (ui + 1) & 1); }
            PG8_WAIT_V(8); PG8_WAIT_L(0); PG8_BAR; PG8_MMA(0, 0, At, B0); PG8_MMA(0, 1, At, B1); PG8_BAR; PG8_SCHED;
            PG8_LDA(At, 0, 1); PG8_STAGE_B(PG8_SB(0, 0), b20); PG8_STAGE_B(PG8_SB(0, 1), b21); PG8_STAGE_A(PG8_SA(0, 0), a2, k2, 0);
            PG8_WAIT_V(8); PG8_WAIT_L(0); PG8_BAR; PG8_MMA(1, 0, At, B0); PG8_MMA(1, 1, At, B1); PG8_BAR; PG8_SCHED;
            PG8_LDB(B0, 1, 0); PG8_LDB(B1, 1, 1); PG8_SCHED; PG8_LDA(At, 1, 0); PG8_STAGE_A(PG8_SA(0, 1), a2, k2, 1);
            PG8_WAIT_V(8); PG8_WAIT_L(0); PG8_BAR; PG8_MMA(0, 0, At, B0); PG8_MMA(0, 1, At, B1); PG8_BAR; PG8_SCHED;
            PG8_LDA(At, 1, 1); PG8_STAGE_B(PG8_SB(1, 0), b30); PG8_STAGE_B(PG8_SB(1, 1), b31); PG8_STAGE_A(PG8_SA(1, 0), a2, k3, 0);
            PG8_WAIT_V(8); PG8_WAIT_L(0); PG8_BAR; PG8_MMA(1, 0, At, B0); PG8_MMA(1, 1, At, B1); PG8_BAR; PG8_SCHED;
        }
        if (wr == 0) PG8_BAR;
        if constexpr (FP8) asm volatile("s_nop 15\n\ts_nop 15" ::: "memory");
        E(acc, cur, wr, wc, fr, fq);
        if (!has_next) break;
#pragma unroll
        for (int a = 0; a < 2; ++a)
#pragma unroll
            for (int b = 0; b < 2; ++b)
#pragma unroll
                for (int m = 0; m < 4; ++m)
#pragma unroll
                    for (int n = 0; n < 2; ++n) acc[a][b][m][n] = (f32x4){0.f, 0.f, 0.f, 0.f};
        cur = nxt; cA = nA; cB0 = nB0; cB1 = nB1; ++ui;
        if (wr == 1) PG8_BAR;
    }
    PG8_WAIT_V(0);
    PG8_BAR;
#undef PG8_SA
#undef PG8_SB
#undef PG8_STAGE_A
#undef PG8_STAGE_B
#undef PG8_LD16
#undef PG8_LDA
#undef PG8_LDB
#undef PG8_MMA
#undef PG8_WAIT_V
#undef PG8_WAIT_L
#undef PG8_BAR
#undef PG8_SCHED
}
}

struct Args { const float* in[28]; float* out; unsigned char* ws; int ph_lo, ph_hi; };
enum { IN_X = 0, IN_C, IN_ADAW, IN_ADAB, IN_N1G, IN_WIN, IN_LBL, IN_HGNG, IN_QNG, IN_KNG, IN_LQ1, IN_LK1, IN_LQ2, IN_LK2, IN_DANG, IN_RELB, IN_WA, IN_WB, IN_WOUT,
       IN_N2G, IN_RW, IN_RB, IN_EG, IN_EU, IN_ED, IN_SG, IN_SU, IN_SD };

struct Frame {
    LAS unsigned char* lds;
    volatile LAS unsigned* MISC;
    unsigned* ctl; float* vec;
    int tid, lane, wave, vcu, G;
    unsigned char* ws;
};


__device__ __forceinline__ unsigned pk4_fp8(float a, float b, float c, float d) { int p = 0; p = __builtin_amdgcn_cvt_pk_fp8_f32(a, b, p, false); p = __builtin_amdgcn_cvt_pk_fp8_f32(c, d, p, true); return (unsigned)p; }
constexpr float W8_SCALE = 32.0f;
#define OPAQUE_V(x) asm volatile("" : "+v"(x))
struct LaneT { int r2, c2, bsrc;
    __device__ __forceinline__ LaneT(int fr, int fq) { const int L = fr + 16 * fq; r2 = L >> 2; c2 = L & 3; bsrc = ((c2 << 4) | r2) << 2; }
    __device__ __forceinline__ unsigned t1(unsigned w) const { return (unsigned)__builtin_amdgcn_ds_bpermute(bsrc, (int)w); }
    __device__ __forceinline__ v2u t2(const v2u w) const { v2u r; r.x = t1(w.x); r.y = t1(w.y); return r; }
    __device__ __forceinline__ v4u t4(const v4u w) const { v4u r; r.x = t1(w.x); r.y = t1(w.y); r.z = t1(w.z); r.w = t1(w.w); return r; }
};
#define PHASE_IDS() int tid_ = threadIdx.x; asm volatile("" : "+v"(tid_)); const int tid = tid_, lane = tid & 63, wid = __builtin_amdgcn_readfirstlane(tid >> 6); (void)lane; (void)wid
struct TrItem { const float* src; int N; unsigned char* dst; int ldb; int fp8; };
__device__ __forceinline__ void tr_load(const TrItem& it, int lane, f32x4 (&v)[8]) {
#pragma unroll
    for (int i = 0; i < 8; ++i) v[i] = *(const GAS f32x4*)(it.src + (size_t)(8 * i + (lane >> 3)) * it.N + 4 * (lane & 7));
}
__device__ __forceinline__ void tr_finish(const TrItem& it, int lane, LAS float* scr, const f32x4 (&v)[8]) {
    const int q = lane & 7;
#pragma unroll
    for (int i = 0; i < 8; ++i) { const int kk = 8 * i + (lane >> 3);
        scr[(4 * q + 0) * 68 + kk] = v[i].x; scr[(4 * q + 1) * 68 + kk] = v[i].y; scr[(4 * q + 2) * 68 + kk] = v[i].z; scr[(4 * q + 3) * 68 + kk] = v[i].w; }
    LDS_WAIT(); asm volatile("" ::: "memory");
    if (it.fp8) {
        const int n2 = lane >> 2, kq = lane & 3;
#pragma unroll
        for (int hf = 0; hf < 2; ++hf) { const int n = n2 + 16 * hf; const LAS float* s = scr + n * 68 + 16 * kq;
            f32x4 x[4];
#pragma unroll
            for (int j = 0; j < 4; ++j) x[j] = *(const LAS f32x4*)(s + 4 * j);
            v4u o;
            o.x = pk4_fp8(x[0].x * W8_SCALE, x[0].y * W8_SCALE, x[0].z * W8_SCALE, x[0].w * W8_SCALE); o.y = pk4_fp8(x[1].x * W8_SCALE, x[1].y * W8_SCALE, x[1].z * W8_SCALE, x[1].w * W8_SCALE);
            o.z = pk4_fp8(x[2].x * W8_SCALE, x[2].y * W8_SCALE, x[2].z * W8_SCALE, x[2].w * W8_SCALE); o.w = pk4_fp8(x[3].x * W8_SCALE, x[3].y * W8_SCALE, x[3].z * W8_SCALE, x[3].w * W8_SCALE);
            *(GAS v4u*)(it.dst + (size_t)n * it.ldb + 16 * kq) = o; }
    } else {
        const int n2 = lane >> 3, kq = lane & 7;
#pragma unroll
        for (int j = 0; j < 4; ++j) { const int n = n2 + 8 * j; const LAS float* s = scr + n * 68 + 8 * kq;
            const f32x4 x0 = *(const LAS f32x4*)s, x1 = *(const LAS f32x4*)(s + 4);
            *(GAS v4u*)(it.dst + (size_t)n * it.ldb + 16 * kq) = (v4u){pk2(x0.x, x0.y), pk2(x0.z, x0.w), pk2(x1.x, x1.y), pk2(x1.z, x1.w)}; }
    }
    LDS_WAIT(); asm volatile("" ::: "memory");
}
#define TR_PAIR(itA, hasB, itB, lane, scr) do { f32x4 _va[8], _vb[8]; tr_load(itA, lane, _va); if (hasB) tr_load(itB, lane, _vb); tr_finish(itA, lane, scr, _va); if (hasB) tr_finish(itB, lane, scr, _vb); } while (0)

__device__ __forceinline__ void transpose_item(const float* W, int N, bf16* WT, int ldt, int koff, int row_off, LAS float* scr, int item, int lane) {
    const int nblk = N / 32, kb = item / nblk, nb = item % nblk, k0 = 64 * kb, n0 = 32 * nb;
#pragma unroll 8
    for (int i = 0; i < 32; ++i) { const int kk = 2 * i + (lane >> 5); scr[kk * 33 + (lane & 31)] = W[(size_t)(k0 + kk) * N + n0 + (lane & 31)]; }
    LDS_WAIT(); asm volatile("" ::: "memory");
    const int c = lane & 7;
#pragma unroll
    for (int j = 0; j < 4; ++j) { const int n = (lane >> 3) + 8 * j; const LAS float* s = scr + (8 * c) * 33 + n;
        v4u o; o.x = pk2(s[0 * 33], s[1 * 33]); o.y = pk2(s[2 * 33], s[3 * 33]); o.z = pk2(s[4 * 33], s[5 * 33]); o.w = pk2(s[6 * 33], s[7 * 33]);
        *(GAS v4u*)(WT + (size_t)(row_off + n0 + n) * ldt + koff + k0 + 8 * c) = o; }
    LDS_WAIT(); asm volatile("" ::: "memory");
}

__device__ __forceinline__ void transpose_item_fp8(const float* W, int N, unsigned char* WT, int ldt, LAS float* scr, int kb, int nb, int lane) {
    const int k0 = 64 * kb, n0 = 32 * nb;
#pragma unroll 8
    for (int i = 0; i < 32; ++i) { const int kk = 2 * i + (lane >> 5); scr[kk * 33 + (lane & 31)] = W[(size_t)(k0 + kk) * N + n0 + (lane & 31)]; }
    LDS_WAIT(); asm volatile("" ::: "memory");
    const int n = lane >> 1, kh = lane & 1; const LAS float* s = scr + (32 * kh) * 33 + n;
    unsigned o[8];
#pragma unroll
    for (int q = 0; q < 8; ++q) o[q] = pk4_fp8(s[(4 * q) * 33] * W8_SCALE, s[(4 * q + 1) * 33] * W8_SCALE, s[(4 * q + 2) * 33] * W8_SCALE, s[(4 * q + 3) * 33] * W8_SCALE);
    GAS v4u* dst = (GAS v4u*)(WT + (size_t)(n0 + n) * ldt + k0 + 32 * kh);
    dst[0] = (v4u){o[0], o[1], o[2], o[3]}; dst[1] = (v4u){o[4], o[5], o[6], o[7]};
    LDS_WAIT(); asm volatile("" ::: "memory");
}

__device__ __forceinline__ void phase_mod(Frame& F, const Args& a) {
    const float* c = a.in[IN_C]; const float* W = a.in[IN_ADAW]; const float* bia = a.in[IN_ADAB];
    PHASE_IDS();
    LAS float* cact = (LAS float*)F.lds;
    {
        float cv_[4 * D / NTHREADS];
#pragma unroll
        for (int j = 0; j < 4 * D / NTHREADS; ++j) cv_[j] = c[tid + NTHREADS * j];
#pragma unroll
        for (int j = 0; j < 4 * D / NTHREADS; ++j) cact[tid + NTHREADS * j] = cv_[j] * fsigmoid(cv_[j]);
    }
    __syncthreads();
    float* mod = (float*)(F.ctl + CW_MOD);
    LAS float* RED = (LAS float*)(F.lds + 32768);
    for (int cg = blockIdx.x; cg < 256; cg += F.G) {
        const int cq = tid % 12, dg = tid / 12, n = cg * 48 + cq * 4;
        if (dg < 42) {
            f32x4 acc[4];
#pragma unroll
            for (int b = 0; b < 4; ++b) acc[b] = (f32x4){0.f, 0.f, 0.f, 0.f};
#define MOD_LD(w_, i0_) do { _Pragma("unroll") for (int j = 0; j < 7; ++j) { const int d = dg + 42 * ((i0_) + j), dd = d < D ? d : D - 1; w_[j] = *(const GAS f32x4*)(W + (size_t)dd * 12288 + n); } } while (0)
#define MOD_FMA(w_, i0_) do { _Pragma("unroll") for (int j = 0; j < 7; ++j) { const int d = dg + 42 * ((i0_) + j); const bool ok = d < D; const int dd = ok ? d : D - 1; \
                _Pragma("unroll") for (int b = 0; b < 4; ++b) { const float cv = ok ? cact[b * D + dd] : 0.f; acc[b] += w_[j] * cv; } } } while (0)
            f32x4 wA[7], wB[7];
            MOD_LD(wA, 0);
#pragma unroll 1
            for (int i0 = 0; i0 < 42; i0 += 14) { MOD_LD(wB, i0 + 7); MOD_FMA(wA, i0); MOD_LD(wA, i0 + 14); MOD_FMA(wB, i0 + 7); }
            MOD_FMA(wA, 42);
#undef MOD_LD
#undef MOD_FMA
#pragma unroll
            for (int b = 0; b < 4; ++b) *(LAS f32x4*)(RED + (dg * 4 + b) * 48 + cq * 4) = acc[b];
        }
        __syncthreads();
        if (tid < 192) {
            const int b = tid / 48, cc = tid % 48;
            float s = bia[cg * 48 + cc];
            for (int g2 = 0; g2 < 42; ++g2) s += RED[(g2 * 4 + b) * 48 + cc];
            mod[b * 12288 + cg * 48 + cc] = s;
        }
        __syncthreads();
    }
    if (blockIdx.x == 0) {
        const float* lbl = a.in[IN_LBL];
        for (int k = tid; k < 1024; k += NTHREADS) { const float l0 = lbl[k], l1 = lbl[1024 + k]; const float m = fmaxf(l0, l1); const float e0 = __expf(l0 - m), e1 = __expf(l1 - m); F.vec[VW_LB + k] = e0 / (e0 + e1); }
        if (tid < 64) {
            const int l = tid;
            float s1 = a.in[IN_LQ1][l] * a.in[IN_LK1][l], s2 = a.in[IN_LQ2][l] * a.in[IN_LK2][l];
            s1 = wave_sum(s1); s2 = wave_sum(s2);
            float qg = fabsf(a.in[IN_QNG][l]), kg = fabsf(a.in[IN_KNG][l]);
#pragma unroll
            for (int o = 1; o < 64; o <<= 1) { qg = fmaxf(qg, __shfl_xor(qg, o)); kg = fmaxf(kg, __shfl_xor(kg, o)); }
            float mb = -1e30f;
            for (int i = l; i < 256; i += 64) mb = fmaxf(mb, a.in[IN_RELB][i]);
#pragma unroll
            for (int o = 1; o < 64; o <<= 1) mb = fmaxf(mb, __shfl_xor(mb, o));
            if (l == 0) { F.vec[VW_LAM] = __expf(s1) - __expf(s2) + LAMBDA_INIT; F.vec[VW_M2] = (8.0f * qg * kg * 1.01f + fmaxf(mb, 0.f)) * LOG2E; }
        }
        for (int i = tid; i < 8 * 256; i += NTHREADS) {
            const int h = i >> 8, dist = i & 255;
            int bucket;
            if (dist < 16) bucket = dist; else { const double v = log((double)dist / 16.0) / log(8.0) * 16.0; int lg = 16 + (int)v; bucket = lg < 31 ? lg : 31; }
            F.vec[VW_TBL + i] = a.in[IN_RELB][bucket * 8 + h] * LOG2E;
        }
    }
}

__device__ __forceinline__ void norm_mod_row(const float* xrow, const float* g, const float* shift, const float* scale, bf16* orow, unsigned char* orow8, int lane) {
    const GAS f32x4* xr = (const GAS f32x4*)xrow + lane;
    f32x4 v[8]; float s = 0.f;
#pragma unroll
    for (int j = 0; j < 8; ++j) { v[j] = xr[64 * j]; s += (v[j].x * v[j].x + v[j].y * v[j].y) + (v[j].z * v[j].z + v[j].w * v[j].w); }
    const float rstd = 1.f / sqrtf(wave_sum(s) * (1.f / D) + EPS);
    GAS v2u* o8 = (GAS v2u*)orow + lane;
#pragma unroll
    for (int j = 0; j < 8; ++j) {
        const int d = 4 * lane + 256 * j;
        const f32x4 gg = *(const f32x4*)(g + d), sh = *(const f32x4*)(shift + d), sc = *(const f32x4*)(scale + d);
        const f32x4 y = v[j] * rstd * gg * (sc + 1.0f) + sh;
        v2u o; o.x = pk2(y.x, y.y); o.y = pk2(y.z, y.w); o8[64 * j] = o;
        ((GAS unsigned*)orow8)[lane + 64 * j] = pk4_fp8(y.x, y.y, y.z, y.w);
    }
}
__device__ __forceinline__ void phase_prep1(Frame& F, const Args& a) {
    PHASE_IDS();
    LAS float* scr = (LAS float*)(F.lds + wid * 16384);
    const int gw = F.vcu * NWAVES + wid, NGW = F.G * NWAVES;
    constexpr int I_IN = (D / 64) * (INCOLS / 32), I_A = (1024 / 64) * (D / 32), I_O = (D / 64) * (D / 32), I_SG = (D / 64) * (DEXP / 32), I_SD = (DEXP / 64) * (D / 32);
    constexpr int NITEMS = I_IN + 2 * I_A + I_O + 2 * I_SG + I_SD;
    unsigned char* ws = F.ws;
#define PREP_DECODE(IT, idx) do { int r_ = (idx); \
        if (r_ < I_IN) { const int nblk = INCOLS / 32, kb = r_ / nblk, n0 = (r_ % nblk) * 32, k0 = 64 * kb; IT.src = a.in[IN_WIN] + (size_t)k0 * INCOLS + n0; IT.N = INCOLS; \
            if (n0 < 2048)      { IT.fp8 = 0; IT.ldb = D * 2; IT.dst = ws + WS_WIN + ((size_t)n0 * D + k0) * 2; }                         \
            else if (n0 < 4096) { IT.fp8 = 1; IT.ldb = D;     IT.dst = ws + WS_WIN8 + (size_t)(n0 - 2048) * D + k0; }                       \
            else if (n0 < 6144) { IT.fp8 = 0; IT.ldb = D * 2; IT.dst = ws + WS_WIN + ((size_t)(n0 - 2048) * D + k0) * 2; }                  \
            else                { IT.fp8 = 1; IT.ldb = D;     IT.dst = ws + WS_WIN8 + (size_t)(n0 - 6144 + 2048) * D + k0; } }              \
        else { r_ -= I_IN; \
        if (r_ < I_A) { const int kb = r_ / (D / 32), n0 = (r_ % (D / 32)) * 32, k0 = 64 * kb; IT.src = a.in[IN_WA] + (size_t)k0 * D + n0; IT.N = D; IT.fp8 = 0; IT.ldb = D * 2; IT.dst = ws + WS_WA + ((size_t)n0 * D + k0) * 2; } \
        else { r_ -= I_A; \
        if (r_ < I_A) { const int kb = r_ / (D / 32), n0 = (r_ % (D / 32)) * 32, k0 = 64 * kb; IT.src = a.in[IN_WB] + (size_t)k0 * D + n0; IT.N = D; IT.fp8 = 0; IT.ldb = D * 2; IT.dst = ws + WS_WA + ((size_t)n0 * D + 1024 + k0) * 2; } \
        else { r_ -= I_A; \
        if (r_ < I_O) { const int kb = r_ / (D / 32), n0 = (r_ % (D / 32)) * 32, k0 = 64 * kb; IT.src = a.in[IN_WOUT] + (size_t)k0 * D + n0; IT.N = D; IT.fp8 = 0; IT.ldb = D * 2; IT.dst = ws + WS_WOUT + ((size_t)n0 * D + k0) * 2; } \
        else { r_ -= I_O; \
        if (r_ < I_SG) { const int kb = r_ / (DEXP / 32), n0 = (r_ % (DEXP / 32)) * 32, k0 = 64 * kb; IT.src = a.in[IN_SG] + (size_t)k0 * DEXP + n0; IT.N = DEXP; IT.fp8 = 1; IT.ldb = D; IT.dst = ws + WS_WSH + (size_t)n0 * D + k0; } \
        else { r_ -= I_SG; \
        if (r_ < I_SG) { const int kb = r_ / (DEXP / 32), n0 = (r_ % (DEXP / 32)) * 32, k0 = 64 * kb; IT.src = a.in[IN_SU] + (size_t)k0 * DEXP + n0; IT.N = DEXP; IT.fp8 = 1; IT.ldb = D; IT.dst = ws + WS_WSH + 2 * MiB + (size_t)n0 * D + k0; } \
        else { r_ -= I_SG; const int kb = r_ / (D / 32), n0 = (r_ % (D / 32)) * 32, k0 = 64 * kb; IT.src = a.in[IN_SD] + (size_t)k0 * D + n0; IT.N = D; IT.fp8 = 1; IT.ldb = DEXP; IT.dst = ws + WS_WSH + 4 * MiB + (size_t)n0 * DEXP + k0; } } } } } } } while (0)
    {
        TrItem A0, B0, A1, B1; f32x4 va0[8], vb0[8], va1[8], vb1[8]; bool h0 = false, h1 = false;
        int it = gw;
        if (it < NITEMS) { PREP_DECODE(A0, it); h0 = (it + NGW < NITEMS); if (h0) PREP_DECODE(B0, it + NGW); else B0 = A0; tr_load(A0, lane, va0); if (h0) tr_load(B0, lane, vb0); }
        for (; it < NITEMS; it += 4 * NGW) {
            const int itn = it + 2 * NGW; const bool m1 = itn < NITEMS;
            if (m1) { PREP_DECODE(A1, itn); h1 = (itn + NGW < NITEMS); if (h1) PREP_DECODE(B1, itn + NGW); else B1 = A1; tr_load(A1, lane, va1); if (h1) tr_load(B1, lane, vb1); }
            tr_finish(A0, lane, scr, va0); if (h0) tr_finish(B0, lane, scr, vb0);
            const int itm = it + 4 * NGW; const bool m2 = itm < NITEMS;
            if (m2) { PREP_DECODE(A0, itm); h0 = (itm + NGW < NITEMS); if (h0) PREP_DECODE(B0, itm + NGW); else B0 = A0; tr_load(A0, lane, va0); if (h0) tr_load(B0, lane, vb0); }
            if (m1) { tr_finish(A1, lane, scr, va1); if (h1) tr_finish(B1, lane, scr, vb1); }
        }
    }
#undef PREP_DECODE
    { bf16* RH = (bf16*)(ws + WS_RWT_HI); bf16* RL = (bf16*)(ws + WS_RWT_LO); const float* rw = a.in[IN_RW];
      for (int i = (F.vcu * NWAVES + wid) * 64 + lane; i < 64 * D; i += F.G * NTHREADS) { const int e = i & 63, k = i >> 6; const float w = rw[i];
          const unsigned hb = f2bf(w); RH[e * D + k] = (bf16)hb; RL[e * D + k] = (bf16)f2bf(w - bf2f(hb)); } }
}
__device__ __forceinline__ void phase_hrows(Frame& F, const Args& a) {
    PHASE_IDS();
    const int gw = F.vcu * NWAVES + wid, NGW = F.G * NWAVES;
    unsigned char* ws = F.ws;
    const int RPWV = T / NGW, m0 = gw * RPWV, b = m0 / SEQ;
    const float* mod = (const float*)(F.ctl + CW_MOD) + b * 12288;
    f32x4 ga[8], sh[8], vn[8];
#pragma unroll
    for (int j = 0; j < 8; ++j) { const int d = 4 * lane + 256 * j;
        const f32x4 gg = *(const GAS f32x4*)(a.in[IN_N1G] + d), sc = *(const GAS f32x4*)(mod + 2048 + d); sh[j] = *(const GAS f32x4*)(mod + d); ga[j] = gg * (sc + 1.0f); }
    {
        const GAS f32x4* xr = (const GAS f32x4*)(a.in[IN_X] + (size_t)m0 * D) + lane;
#pragma unroll
        for (int j = 0; j < 8; ++j) vn[j] = xr[64 * j];
    }
    for (int i = 0; i < RPWV; ++i) {
        const int m = m0 + i;
        f32x4 v[8]; float s = 0.f;
#pragma unroll
        for (int j = 0; j < 8; ++j) { v[j] = vn[j]; s += (v[j].x * v[j].x + v[j].y * v[j].y) + (v[j].z * v[j].z + v[j].w * v[j].w); }
        if (i + 1 < RPWV) {
            const GAS f32x4* xr = (const GAS f32x4*)(a.in[IN_X] + (size_t)(m + 1) * D) + lane;
#pragma unroll
            for (int j = 0; j < 8; ++j) vn[j] = xr[64 * j];
        }
        const float rstd = 1.f / sqrtf(wave_sum(s) * (1.f / D) + EPS);
        GAS v2u* o16 = (GAS v2u*)((bf16*)(ws + WS_H) + (size_t)m * D) + lane;
        GAS unsigned* o8 = (GAS unsigned*)(ws + WS_H8 + (size_t)m * D) + lane;
#pragma unroll
        for (int j = 0; j < 8; ++j) {
            const f32x4 y = v[j] * rstd * ga[j] + sh[j];
            v2u o; o.x = pk2(y.x, y.y); o.y = pk2(y.z, y.w); o16[64 * j] = o;
            o8[64 * j] = pk4_fp8(y.x, y.y, y.z, y.w);
        }
    }
}

struct DenseGemm : pg8::DenseOrder {
    static constexpr bool GATHER = false;
    const char* A; const char* Bt; unsigned lda2, ldb2; int nt;
    __device__ __forceinline__ const char* aptr(const pg8::Unit& u) const { return A + (size_t)(u.pm * 256) * lda2; }
    __device__ __forceinline__ void aoffs(const pg8::Unit&, int, unsigned (&)[2][2]) const {}
    __device__ __forceinline__ void bptrs(const pg8::Unit& u, const char*& b0, const char*& b1) const { b0 = Bt + (size_t)(u.pn * 256) * ldb2; b1 = b0 + (size_t)128 * ldb2; }
};

template <int PART>
struct EpiInProj {
    static constexpr bool PERM = true, MIDK = false;
    unsigned char* ws; LAS unsigned char* lds; const float* qng; const float* kng;
    __device__ __forceinline__ void operator()(const f32x4 (&acc)[2][2][4][2], const pg8::Unit& u, int wr, int wc, int fr_, int fq_) const {
        int fr = fr_, fq = fq_; OPAQUE_V(fr); OPAQUE_V(fq);
        bf16* base; int ldc, colt;
        if (PART == 0) { const int idx = u.pn >> 2, slot = idx < 2 ? idx : idx + 2; base = (bf16*)(ws + WS_PROJ + (size_t)slot * 32 * MiB); ldc = 1024; colt = (u.pn & 3) * 256; }
        else if (u.pn < 12) { const int idx = u.pn >> 2, slot = idx < 2 ? idx + 2 : 6; base = (bf16*)(ws + WS_PROJ + (size_t)slot * 32 * MiB); ldc = 1024; colt = (u.pn & 3) * 256; }
        else { const int q = u.pn - 12; base = (bf16*)(ws + WS_GA + (size_t)(q >> 3) * 64 * MiB); ldc = 2048; colt = (q & 7) * 256; }
        const LaneT lt(fr, fq);
        if (PART == 0 && u.pn >= 8) {
            const bool isk = u.pn >= 12;
            bf16* outp = (bf16*)(ws + (isk ? WS_DKN : WS_DQN));
            const float* gsrc = isk ? kng : qng; const float gmul = isk ? 1.0f : 0.125f * LOG2E;
            LAS float* XW = (LAS float*)(lds + MISC_OFF + 2048);
            const int wid_ = wr * 4 + wc;
            float ss[2][4][2];
#pragma unroll
            for (int ai = 0; ai < 2; ++ai)
#pragma unroll
                for (int m = 0; m < 4; ++m)
#pragma unroll
                    for (int bj = 0; bj < 2; ++bj) { const f32x4 v0 = acc[ai][bj][m][0], v1 = acc[ai][bj][m][1];
                        float q = (v0[0] * v0[0] + v0[1] * v0[1]) + (v0[2] * v0[2] + v0[3] * v0[3]) + (v1[0] * v1[0] + v1[1] * v1[1]) + (v1[2] * v1[2] + v1[3] * v1[3]);
                        q += __shfl_xor(q, 16); q += __shfl_xor(q, 32); ss[ai][m][bj] = q; }
            if (fq == 0) {
#pragma unroll
                for (int ai = 0; ai < 2; ++ai)
#pragma unroll
                    for (int m = 0; m < 4; ++m)
#pragma unroll
                        for (int bj = 0; bj < 2; ++bj) XW[((wid_ * 8 + ai * 4 + m) * 2 + bj) * 16 + fr] = ss[ai][m][bj];
            }
            asm volatile("s_waitcnt lgkmcnt(0)" ::: "memory");
            __builtin_amdgcn_s_barrier();
            asm volatile("" ::: "memory");
            const int pw_ = wid_ ^ 1;
#pragma unroll
            for (int ai = 0; ai < 2; ++ai)
#pragma unroll
                for (int m = 0; m < 4; ++m)
#pragma unroll
                    for (int bj = 0; bj < 2; ++bj) { const float t = ss[ai][m][bj] + XW[((pw_ * 8 + ai * 4 + m) * 2 + bj) * 16 + fr]; ss[ai][m][bj] = 1.f / sqrtf(t * (1.f / 64.f) + EPS); }
            const int gidx = 32 * (wc & 1) + 8 * fq;
            const f32x4 g0 = *(const GAS f32x4*)(gsrc + gidx) * gmul, g1 = *(const GAS f32x4*)(gsrc + gidx + 4) * gmul;
            const int rowq = u.pm * 256 + wr * 64 + lt.r2, colq = (u.pn & 3) * 256 + wc * 32 + 8 * lt.c2;
#pragma unroll
            for (int ai = 0; ai < 2; ++ai)
#pragma unroll
                for (int m = 0; m < 4; ++m)
#pragma unroll
                    for (int bj = 0; bj < 2; ++bj) { const float rs = ss[ai][m][bj];
                        const f32x4 y0 = acc[ai][bj][m][0] * rs * g0, y1 = acc[ai][bj][m][1] * rs * g1;
                        v4u w; w.x = pk2(y0[0], y0[1]); w.y = pk2(y0[2], y0[3]); w.z = pk2(y1[0], y1[1]); w.w = pk2(y1[2], y1[3]);
                        *(GAS v4u*)(outp + (size_t)(rowq + ai * 128 + m * 16) * 1024 + colq + bj * 128) = lt.t4(w); }
            return;
        }
        if (PART == 1 && u.pn >= 12) {
            const int q = u.pn - 12; unsigned char* base8 = ws + WS_GA + (size_t)(q >> 3) * 64 * MiB;
            const int row8 = u.pm * 256 + wr * 64 + lt.r2, col8 = (q & 7) * 256 + wc * 64 + 16 * lt.c2;
#pragma unroll
            for (int ai = 0; ai < 2; ++ai)
#pragma unroll
                for (int m = 0; m < 4; ++m) {
                    v4u w;
#pragma unroll
                    for (int bj = 0; bj < 2; ++bj) { f32x4 v0 = acc[ai][bj][m][0], v1 = acc[ai][bj][m][1];
#pragma unroll
                        for (int j = 0; j < 4; ++j) { v0[j] = fminf(fmaxf(v0[j], -448.f), 448.f); v1[j] = fminf(fmaxf(v1[j], -448.f), 448.f); }
                        const unsigned a0 = lt.t1(pk4_fp8(v0[0], v0[1], v0[2], v0[3])), a1 = lt.t1(pk4_fp8(v1[0], v1[1], v1[2], v1[3]));
                        if (bj == 0) { w.x = a0; w.y = a1; } else { w.z = a0; w.w = a1; } }
                    *(GAS v4u*)(base8 + (size_t)(row8 + ai * 128 + m * 16) * 2048 + col8) = w;
                }
            return;
        }
        const int row0 = u.pm * 256 + wr * 64 + lt.r2, col0 = colt + wc * 32 + 8 * lt.c2;
#pragma unroll
        for (int ai = 0; ai < 2; ++ai)
#pragma unroll
            for (int m = 0; m < 4; ++m) { bf16* rowp = base + (size_t)(row0 + ai * 128 + m * 16) * ldc + col0;
#pragma unroll
                for (int bj = 0; bj < 2; ++bj) { const f32x4 v0 = acc[ai][bj][m][0], v1 = acc[ai][bj][m][1];
                    v4u w; w.x = pg8::cvt_pk_bf16(v0[0], v0[1]); w.y = pg8::cvt_pk_bf16(v0[2], v0[3]); w.z = pg8::cvt_pk_bf16(v1[0], v1[1]); w.w = pg8::cvt_pk_bf16(v1[2], v1[3]);
                    *(GAS v4u*)(rowp + bj * 128) = lt.t4(w); } }
    }
};


constexpr int H1_TS = 272, H1_TS2 = 144;
constexpr int H1_QD = 0, H1_KD = 17408, H1_KI = 34816, H1_KBT = 60928, H1_VT = 79360, H1_AT = 97792, H1_TOT = 107008;
__device__ __forceinline__ void phase_h1(Frame& F) {
    unsigned char* ws = F.ws;
    const bf16* HQ = (const bf16*)(ws + WS_HQ); bf16* QT = (bf16*)(ws + WS_QT); const bf16* HF = (const bf16*)(ws + WS_HF); const bf16* HI = (const bf16*)(ws + WS_HI);
    bf16* STg = (bf16*)(ws + WS_ST); float* DEC = (float*)(ws + WS_DEC); bf16* OI = (bf16*)(ws + WS_OI);
    LAS unsigned char* L = F.lds;
    LAS float* TOT = (LAS float*)(L + H1_TOT);
    PHASE_IDS();
    const int kp = lane, seg = wid, qd = wid >> 1, r = lane & 15, g = lane >> 4;
    unsigned nq[8], nf[8], ni[8];
#define H1_LOAD(uu_) do { const int bh_ = (uu_) >> 6, n_ = (uu_) & 63; const size_t r0_ = (size_t)(bh_ >> 3) * SEQ + (size_t)n_ * 64 + 8 * seg; const int c_ = (bh_ & 7) * 128 + 2 * kp; \
        _Pragma("unroll") for (int i_ = 0; i_ < 8; ++i_) { const size_t idx_ = (r0_ + i_) * 1024 + c_; nq[i_] = *(const GAS unsigned*)(HQ + idx_); nf[i_] = *(const GAS unsigned*)(HF + idx_); ni[i_] = *(const GAS unsigned*)(HI + idx_); } } while (0)
    if (F.vcu < NCH_UNITS) H1_LOAD(F.vcu);
    for (int u = F.vcu; u < NCH_UNITS; u += F.G) {
        const int bh = u >> 6, n = u & 63, b = bh >> 3, h = bh & 7;
        const size_t row0 = (size_t)b * SEQ + (size_t)n * 64;
        const int col = h * 128 + 2 * kp;
        float cs0[8], cs1[8], kk0[8], kk1[8], qs0[8], qs1[8]; unsigned vv[8];
        const float lb0 = F.vec[VW_LB + col], lb1 = F.vec[VW_LB + col + 1];
        {
            float run0 = 0.f, run1 = 0.f;
#pragma unroll
            for (int uu = 0; uu < 8; ++uu) {
                const float q0 = bflo(nq[uu]), q1 = bfhi(nq[uu]), f0 = bflo(nf[uu]), f1 = bfhi(nf[uu]); vv[uu] = ni[uu];
                const float fg0 = lb0 + (1.f - lb0) * fsigmoid(f0), fg1 = lb1 + (1.f - lb1) * fsigmoid(f1);
                run0 += __logf(fg0); run1 += __logf(fg1); cs0[uu] = run0; cs1[uu] = run1; kk0[uu] = 1.f - fg0; kk1[uu] = 1.f - fg1;
                qs0[uu] = q0 * fsigmoid(q0) * 0.08838834764831845f; qs1[uu] = q1 * fsigmoid(q1) * 0.08838834764831845f;
            }
            *(LAS f32x2*)(TOT + seg * 128 + 2 * kp) = (f32x2){run0, run1};
        }
        __syncthreads();
        {
            float P0[9], P1[9]; P0[0] = 0.f; P1[0] = 0.f;
#pragma unroll
            for (int s = 0; s < 8; ++s) { const f32x2 tt = *(const LAS f32x2*)(TOT + s * 128 + 2 * kp); P0[s + 1] = P0[s] + tt.x; P1[s + 1] = P1[s] + tt.y; }
            float rq0 = 0.f, rq1 = 0.f, rs0 = 0.f, rs1 = 0.f;
#pragma unroll
            for (int s = 1; s < 8; ++s) if (seg == s) { rq0 = P0[s]; rq1 = P1[s]; rs0 = P0[s & ~1]; rs1 = P1[s & ~1]; }
            const float a0 = __expf(rq0 - rs0), a1 = __expf(rq1 - rs1), ai0 = __expf(fminf(rs0 - rq0, 40.f)), ai1 = __expf(fminf(rs1 - rq1, 40.f));
            const float e10 = __expf(P0[2] - rq0), e11 = __expf(P1[2] - rq1), e20 = __expf(P0[4] - rq0), e21 = __expf(P1[4] - rq1), e30 = __expf(P0[6] - rq0), e31 = __expf(P1[6] - rq1);
            const float eb0 = __expf(P0[8] - rq0), eb1 = __expf(P1[8] - rq1), eq0 = __expf(rq0), eq1 = __expf(rq1);
            float kb0[8], kb1[8];
#pragma unroll
            for (int uu = 0; uu < 8; ++uu) {
                const int t = 8 * seg + uu;
                const float qE0 = qs0[uu] * __expf(cs0[uu]), qE1 = qs1[uu] * __expf(cs1[uu]);
                const float kE0 = kk0[uu] * __expf(fminf(-cs0[uu], 40.f)), kE1 = kk1[uu] * __expf(fminf(-cs1[uu], 40.f));
                *(LAS unsigned*)(L + H1_QD + t * H1_TS + 4 * kp) = pg8::cvt_pk_bf16(qE0 * a0, qE1 * a1);
                *(LAS unsigned*)(L + H1_KD + t * H1_TS + 4 * kp) = pg8::cvt_pk_bf16(kE0 * ai0, kE1 * ai1);
                if (qd < 1) *(LAS unsigned*)(L + H1_KI + (0 + t) * H1_TS + 4 * kp) = pg8::cvt_pk_bf16(kE0 * e10, kE1 * e11);
                if (qd < 2) *(LAS unsigned*)(L + H1_KI + (16 + t) * H1_TS + 4 * kp) = pg8::cvt_pk_bf16(kE0 * e20, kE1 * e21);
                if (qd < 3) *(LAS unsigned*)(L + H1_KI + (48 + t) * H1_TS + 4 * kp) = pg8::cvt_pk_bf16(kE0 * e30, kE1 * e31);
                kb0[uu] = kE0 * eb0; kb1[uu] = kE1 * eb1;
                *(GAS unsigned*)(QT + (row0 + t) * 1024 + col) = pg8::cvt_pk_bf16(qE0 * eq0, qE1 * eq1);
            }
            *(LAS v4u*)(L + H1_KBT + (2 * kp) * H1_TS2 + 16 * seg) = (v4u){pg8::cvt_pk_bf16(kb0[0], kb0[1]), pg8::cvt_pk_bf16(kb0[2], kb0[3]), pg8::cvt_pk_bf16(kb0[4], kb0[5]), pg8::cvt_pk_bf16(kb0[6], kb0[7])};
            *(LAS v4u*)(L + H1_KBT + (2 * kp + 1) * H1_TS2 + 16 * seg) = (v4u){pg8::cvt_pk_bf16(kb1[0], kb1[1]), pg8::cvt_pk_bf16(kb1[2], kb1[3]), pg8::cvt_pk_bf16(kb1[4], kb1[5]), pg8::cvt_pk_bf16(kb1[6], kb1[7])};
            *(LAS v4u*)(L + H1_VT + (2 * kp) * H1_TS2 + 16 * seg) = (v4u){(vv[0] & 0xffffu) | (vv[1] << 16), (vv[2] & 0xffffu) | (vv[3] << 16), (vv[4] & 0xffffu) | (vv[5] << 16), (vv[6] & 0xffffu) | (vv[7] << 16)};
            *(LAS v4u*)(L + H1_VT + (2 * kp + 1) * H1_TS2 + 16 * seg) = (v4u){(vv[0] >> 16) | (vv[1] & 0xffff0000u), (vv[2] >> 16) | (vv[3] & 0xffff0000u), (vv[4] >> 16) | (vv[5] & 0xffff0000u), (vv[6] >> 16) | (vv[7] & 0xffff0000u)};
            if (seg == 0) *(GAS f32x2*)(DEC + (size_t)u * 128 + 2 * kp) = (f32x2){__expf(P0[8]), __expf(P1[8])};
        }
        __syncthreads();
        if (u + F.G < NCH_UNITS) H1_LOAD(u + F.G);
        for (int blk = wid; blk < 10; blk += 8) {
            const int i = blk >= 6 ? 3 : (blk >= 3 ? 2 : (blk >= 1 ? 1 : 0)), j = blk - (i * (i + 1)) / 2;
            const int kib = (i == 2) ? 16 : (i == 3 ? 48 : 0);
            const int krow_off = (j == i) ? (H1_KD + (16 * j + r) * H1_TS) : (H1_KI + (kib + 16 * j + r) * H1_TS);
            f32x4 acc = (f32x4){0.f, 0.f, 0.f, 0.f};
#pragma unroll
            for (int ks = 0; ks < 4; ++ks) {
                const bf16x8 af = *(const LAS bf16x8*)(L + H1_QD + (16 * i + r) * H1_TS + (32 * ks + 8 * g) * 2);
                const bf16x8 bfv = *(const LAS bf16x8*)(L + krow_off + (32 * ks + 8 * g) * 2);
                acc = __builtin_amdgcn_mfma_f32_16x16x32_bf16(af, bfv, acc, 0, 0, 0);
            }
#pragma unroll
            for (int rg = 0; rg < 4; ++rg) {
                const int tl = 4 * g + rg; float v = acc[rg];
                if (j == i && r > tl) v = 0.f;
                *(LAS bf16*)(L + H1_AT + (16 * i + tl) * H1_TS2 + (16 * j + r) * 2) = (bf16)f2bf(v);
            }
        }
        if (wid >= 2) {
            const int zb = wid - 2, zi = zb < 3 ? 0 : (zb < 5 ? 1 : 2), zj = zb < 3 ? zb + 1 : (zb < 5 ? zb - 1 : 3);
#pragma unroll
            for (int rg = 0; rg < 4; ++rg) *(LAS bf16*)(L + H1_AT + (16 * zi + 4 * g + rg) * H1_TS2 + (16 * zj + r) * 2) = (bf16)0;
        }
        __syncthreads();
        {
            bf16x8 vf[2];
#pragma unroll
            for (int ks = 0; ks < 2; ++ks) vf[ks] = *(const LAS bf16x8*)(L + H1_VT + (16 * wid + r) * H1_TS2 + (32 * ks + 8 * g) * 2);
#pragma unroll
            for (int rb = 0; rb < 4; ++rb) {
                f32x4 acc = (f32x4){0.f, 0.f, 0.f, 0.f};
#pragma unroll
                for (int ks = 0; ks < 2; ++ks) { const bf16x8 af = *(const LAS bf16x8*)(L + H1_AT + (16 * rb + r) * H1_TS2 + (32 * ks + 8 * g) * 2);
                    acc = __builtin_amdgcn_mfma_f32_16x16x32_bf16(vf[ks], af, acc, 0, 0, 0); }
                { v2u ob; ob.x = pk2(acc[0], acc[1]); ob.y = pk2(acc[2], acc[3]); *(GAS v2u*)(OI + (row0 + 16 * rb + r) * 1024 + h * 128 + 16 * wid + 4 * g) = ob; }
            }
#pragma unroll
            for (int rb = 0; rb < 8; ++rb) {
                f32x4 acc = (f32x4){0.f, 0.f, 0.f, 0.f};
#pragma unroll
                for (int ks = 0; ks < 2; ++ks) { const bf16x8 af = *(const LAS bf16x8*)(L + H1_KBT + (16 * rb + r) * H1_TS2 + (32 * ks + 8 * g) * 2);
                    acc = __builtin_amdgcn_mfma_f32_16x16x32_bf16(af, vf[ks], acc, 0, 0, 0); }
                v2u o; o.x = pk2(acc[0], acc[1]); o.y = pk2(acc[2], acc[3]);
                *(GAS v2u*)(STg + (size_t)u * 16384 + (16 * wid + r) * 128 + 16 * rb + 4 * g) = o;
            }
        }
        __syncthreads();
    }
#undef H1_LOAD
}

__device__ __forceinline__ void phase_qkprep(Frame& F, const Args& a) {
    PHASE_IDS();
    const int gw = F.vcu * NWAVES + wid, NGW = F.G * NWAVES;
    const int hd = (8 * lane) & 63;
    float gq[8], gk[8];
#pragma unroll
    for (int e = 0; e < 8; ++e) { gq[e] = a.in[IN_QNG][hd + e] * (0.125f * LOG2E); gk[e] = a.in[IN_KNG][hd + e]; }
    const bf16* DQ = (const bf16*)(F.ws + WS_DQ); const bf16* DK = (const bf16*)(F.ws + WS_DK); bf16* DQN = (bf16*)(F.ws + WS_DQN); bf16* DKN = (bf16*)(F.ws + WS_DKN);
    for (int m = gw; m < T; m += 2 * NGW) {
        v4u w[2][2][2];
#pragma unroll
        for (int r = 0; r < 2; ++r) { const size_t ro = (size_t)(m + r * NGW) * 1024 + 8 * lane;
#pragma unroll
            for (int j = 0; j < 2; ++j) { w[r][0][j] = *(const GAS v4u*)(DQ + ro + 512 * j); w[r][1][j] = *(const GAS v4u*)(DK + ro + 512 * j); } }
#pragma unroll
        for (int r = 0; r < 2; ++r) { const size_t ro = (size_t)(m + r * NGW) * 1024 + 8 * lane;
#pragma unroll
            for (int which = 0; which < 2; ++which)
#pragma unroll
                for (int j = 0; j < 2; ++j) {
                    float x[8]; unpack8(w[r][which][j], x);
                    float ss = 0.f;
#pragma unroll
                    for (int e = 0; e < 8; ++e) ss += x[e] * x[e];
                    ss += dppf<0xB1>(ss); ss += dppf<0x4E>(ss); ss += dppf<0x141>(ss);
                    const float rstd = 1.f / sqrtf(ss * (1.f / 64.f) + EPS);
#pragma unroll
                    for (int e = 0; e < 8; ++e) x[e] = x[e] * rstd * (which ? gk[e] : gq[e]);
                    v4u o; o.x = pk2(x[0], x[1]); o.y = pk2(x[2], x[3]); o.z = pk2(x[4], x[5]); o.w = pk2(x[6], x[7]);
                    *(GAS v4u*)((which ? DKN : DQN) + ro + 512 * j) = o;
                }
        }
    }
}

__device__ __forceinline__ void phase_h2(Frame& F) {
    bf16* STg = (bf16*)(F.ws + WS_ST); const float* DEC = (const float*)(F.ws + WS_DEC);
    const int NIT = 32 * 128 * 32;
    PHASE_IDS();
    for (int it = F.vcu * NTHREADS + tid; it < NIT; it += F.G * NTHREADS) {
        const int bh = it >> 12, v = (it >> 5) & 127, kg = it & 31;
        float run0 = 0.f, run1 = 0.f, run2 = 0.f, run3 = 0.f;
        for (int n0 = 0; n0 < NCHUNK; n0 += 4) {
            v2u loc[4]; f32x4 dc[4];
#pragma unroll
            for (int j = 0; j < 4; ++j) { const size_t un = (size_t)bh * 64 + n0 + j;
                loc[j] = *(const GAS v2u*)(STg + un * 16384 + v * 128 + kg * 4); dc[j] = *(const GAS f32x4*)(DEC + un * 128 + kg * 4); }
#pragma unroll
            for (int j = 0; j < 4; ++j) { const size_t un = (size_t)bh * 64 + n0 + j;
                v2u o; o.x = pk2(run0, run1); o.y = pk2(run2, run3);
                *(GAS v2u*)(STg + un * 16384 + v * 128 + kg * 4) = o;
                run0 = dc[j].x * run0 + bflo(loc[j].x); run1 = dc[j].y * run1 + bfhi(loc[j].x); run2 = dc[j].z * run2 + bflo(loc[j].y); run3 = dc[j].w * run3 + bfhi(loc[j].y); }
        }
    }
}

__device__ __forceinline__ void phase_h3(Frame& F, const Args& a) {
    const bf16* HQ = (const bf16*)(F.ws + WS_QT); const bf16* HG = (const bf16*)(F.ws + WS_HG); const bf16* STg = (const bf16*)(F.ws + WS_ST);
    const bf16* OI = (const bf16*)(F.ws + WS_OI); bf16* BR = (bf16*)(F.ws + WS_BR);
    PHASE_IDS();
    const int r = lane & 15, g = lane >> 4, sub = wid >> 2, rb = wid & 3;
    f32x4 gn[8];
#pragma unroll
    for (int cb = 0; cb < 8; ++cb) gn[cb] = *(const GAS f32x4*)(a.in[IN_HGNG] + 16 * cb + 4 * g);
    for (int up = F.vcu; up < NCH_UNITS / 2; up += F.G) {
        const int u = up * 2 + sub, bh = u >> 6, n = u & 63, b = bh >> 3, h = bh & 7;
        const size_t m0 = (size_t)b * SEQ + (size_t)n * 64 + 16 * rb;
        bf16x8 af[4];
#pragma unroll
        for (int ks = 0; ks < 4; ++ks) af[ks] = *(const GAS bf16x8*)(HQ + (m0 + r) * 1024 + h * 128 + 32 * ks + 8 * g);
        f32x4 acc[8];
#pragma unroll
        for (int cb = 0; cb < 8; ++cb) {
            acc[cb] = (f32x4){0.f, 0.f, 0.f, 0.f};
#pragma unroll
            for (int ks = 0; ks < 4; ++ks) { const bf16x8 bfv = *(const GAS bf16x8*)(STg + (size_t)u * 16384 + (16 * cb + r) * 128 + 32 * ks + 8 * g);
                acc[cb] = __builtin_amdgcn_mfma_f32_16x16x32_bf16(bfv, af[ks], acc[cb], 0, 0, 0); }
        }
        float ss = 0.f;
#pragma unroll
        for (int cb = 0; cb < 8; ++cb) {
            const v2u ow = *(const GAS v2u*)(OI + (m0 + r) * 1024 + h * 128 + 16 * cb + 4 * g); const f32x4 o4 = (f32x4){bflo(ow.x), bfhi(ow.x), bflo(ow.y), bfhi(ow.y)};
#pragma unroll
            for (int rg = 0; rg < 4; ++rg) { const float o = acc[cb][rg] + o4[rg]; acc[cb][rg] = o; ss += o * o; }
        }
        ss += __shfl_xor(ss, 16); ss += __shfl_xor(ss, 32);
        const float rstd = 1.f / sqrtf(ss * (1.f / 128.f) + EPS);
#pragma unroll
        for (int cb0 = 0; cb0 < 8; cb0 += 4) {
            v2u hgv[4];
#pragma unroll
            for (int c4 = 0; c4 < 4; ++c4) hgv[c4] = *(const GAS v2u*)(HG + (m0 + r) * 1024 + h * 128 + 16 * (cb0 + c4) + 4 * g);
#pragma unroll
            for (int c4 = 0; c4 < 4; ++c4) { const int cb = cb0 + c4; const v2u hg = hgv[c4];
                const float g0 = bflo(hg.x), g1 = bfhi(hg.x), g2 = bflo(hg.y), g3 = bfhi(hg.y);
                v2u o;
                o.x = pg8::cvt_pk_bf16(acc[cb][0] * rstd * gn[cb][0] * (g0 * fsigmoid(g0)), acc[cb][1] * rstd * gn[cb][1] * (g1 * fsigmoid(g1)));
                o.y = pg8::cvt_pk_bf16(acc[cb][2] * rstd * gn[cb][2] * (g2 * fsigmoid(g2)), acc[cb][3] * rstd * gn[cb][3] * (g3 * fsigmoid(g3)));
                *(GAS v2u*)(BR + (m0 + r) * 2048 + h * 128 + 16 * cb + 4 * g) = o;
            }
        }
    }
}

__device__ __forceinline__ void phase_convert_experts(Frame& F, const Args& a) {
    PHASE_IDS();
    LAS float* scr = (LAS float*)(F.lds + wid * 16384);
    const int gw = F.vcu * NWAVES + wid, NGW = F.G * NWAVES;
    constexpr int IPM = 256, NITEMS = NEXP * 3 * IPM;
    for (int it = gw; it < NITEMS; it += NGW) {
        const int e = it / (3 * IPM), r = it % (3 * IPM), which = r / IPM, item = r % IPM;
        TrItem A_, B_; A_.fp8 = 1;
        if (which < 2) { const int kb2 = item / (DEXP / 32), n0 = (item % (DEXP / 32)) * 32, k0 = 128 * kb2;
            A_.src = a.in[which ? IN_EU : IN_EG] + (size_t)e * D * DEXP + (size_t)k0 * DEXP + n0; A_.N = DEXP; A_.ldb = D; A_.dst = F.ws + (which ? WS_WU : WS_WG) + (size_t)e * DEXP * D + (size_t)n0 * D + k0; }
        else { const int kb2 = item / (D / 32), n0 = (item % (D / 32)) * 32, k0 = 128 * kb2;
            A_.src = a.in[IN_ED] + (size_t)e * DEXP * D + (size_t)k0 * D + n0; A_.N = D; A_.ldb = DEXP; A_.dst = F.ws + WS_WDOWN + (size_t)e * D * DEXP + (size_t)n0 * DEXP + k0; }
        B_ = A_; B_.src = A_.src + (size_t)64 * A_.N; B_.dst = A_.dst + 64;
        TR_PAIR(A_, true, B_, lane, scr);
    }
}

constexpr int AT_KCH = 1040, AT_VDB = 4160, AT_STAGE = 33280, AT_TBL = 66560, AT_WSF = 67584, AT_QF = 68608;
__device__ __forceinline__ int crow(int r, int hi) { return (r & 3) + 8 * (r >> 2) + 4 * hi; }
__device__ __forceinline__ void phase_attn(Frame& F, const Args& a, const int pi_lo, const int pi_hi) {
    const bf16* DQ = (const bf16*)(F.ws + WS_DQN); const bf16* DK = (const bf16*)(F.ws + WS_DKN); const bf16* DV = (const bf16*)(F.ws + WS_DV);
    bf16* BR = (bf16*)(F.ws + WS_BR);
    LAS unsigned char* L = F.lds;
    LAS float* TBL = (LAS float*)(L + AT_TBL); LAS float* WSF = (LAS float*)(L + AT_WSF); LAS float* XB = (LAS float*)L;
    PHASE_IDS();
    const int c = wid >> 2, qblk = wid & 3, r32 = lane & 31, hi = lane >> 5;
    const float lam = F.vec[VW_LAM], M2 = F.vec[VW_M2];
    const int lrow0 = tid >> 4, lch = tid & 15, lrow1 = lrow0 + 32;
    const int kdst0 = lch * AT_KCH + lrow0 * 16, kdst1 = lch * AT_KCH + lrow1 * 16;
    const int vdst0 = 16640 + (lch >> 2) * AT_VDB + (lrow0 >> 4) * 1024 + (lrow0 & 15) * 64 + (lch & 3) * 16;
    const int vdst1 = 16640 + (lch >> 2) * AT_VDB + (lrow1 >> 4) * 1024 + (lrow1 & 15) * 64 + (lch & 3) * 16;
    const int vlane = 16640 + ((lane >> 4) & 1) * 32 + (lane & 3) * 8 + (4 * hi + ((lane & 15) >> 2)) * 64;
    float dg[4];
#pragma unroll
    for (int d0 = 0; d0 < 4; ++d0) dg[d0] = a.in[IN_DANG][32 * d0 + r32] * (1.0f - LAMBDA_INIT);
    for (int pi = pi_lo; pi < pi_hi; ++pi) {
        if (pi == (F.vcu & 3)) { phase_convert_experts(F, a); __syncthreads(); }
        const int pp = F.vcu * 2 + (pi >> 1);
        if (pp >= 512) break;
        const int bh = pp >> 4, s = pp & 15, qb = (pi & 1) ? 31 - s : s, b = bh >> 3, h = bh & 7;
        const int q0 = qb * 128, NT = 2 * qb + 2;
        const size_t rowb = (size_t)b * SEQ;
        if (tid < 256) TBL[tid] = F.vec[VW_TBL + h * 256 + tid];
        const int qfo = AT_QF + wid * 4096 + lane * 16;
#pragma unroll
        for (int d0 = 0; d0 < 4; ++d0) *(LAS bf16x8*)(L + qfo + d0 * 1024) = *(const GAS bf16x8*)(DQ + (rowb + q0 + 32 * qblk + r32) * 1024 + h * 128 + c * 64 + 16 * d0 + 8 * hi);
        const bf16* ksrc0 = DK + (rowb + lrow0) * 1024 + h * 128 + lch * 8; const bf16* ksrc1 = ksrc0 + (size_t)32 * 1024;
        const bf16* vsrc0 = DV + (rowb + lrow0) * 1024 + h * 128 + lch * 8; const bf16* vsrc1 = vsrc0 + (size_t)32 * 1024;
        v4u kr0, kr1, vr0, vr1;
        kr0 = *(const GAS v4u*)ksrc0; kr1 = *(const GAS v4u*)ksrc1; vr0 = *(const GAS v4u*)vsrc0; vr1 = *(const GAS v4u*)vsrc1;
        *(LAS v4u*)(L + kdst0) = kr0; *(LAS v4u*)(L + kdst1) = kr1; *(LAS v4u*)(L + vdst0) = vr0; *(LAS v4u*)(L + vdst1) = vr1;
        __syncthreads();
        const float tb31 = TBL[255];
        f32x16 o[4];
#pragma unroll
        for (int d0 = 0; d0 < 4; ++d0)
#pragma unroll
            for (int rr = 0; rr < 16; ++rr) o[d0][rr] = 0.f;
        float lsum = 0.f;
        const int qpos = q0 + 32 * qblk + r32;
        for (int j = 0; j < NT; ++j) {
            const int st = (j & 1) * AT_STAGE, sn = ((j + 1) & 1) * AT_STAGE;
            const bool more = (j + 1 < NT);
            if (more) { const size_t go = (size_t)(j + 1) * 64 * 1024;
                kr0 = *(const GAS v4u*)(ksrc0 + go); kr1 = *(const GAS v4u*)(ksrc1 + go); vr0 = *(const GAS v4u*)(vsrc0 + go); vr1 = *(const GAS v4u*)(vsrc1 + go); }
            const bool far = (j < NT - 4);
            const float cinit = far ? (tb31 - M2) : (-M2);
            f32x16 p0, p1;
#pragma unroll
            for (int rr = 0; rr < 16; ++rr) { p0[rr] = cinit; p1[rr] = cinit; }
#pragma unroll
            for (int d0 = 0; d0 < 4; ++d0) {
                const bf16x8 k0 = *(const LAS bf16x8*)(L + st + (8 * c + 2 * d0 + hi) * AT_KCH + r32 * 16);
                const bf16x8 k1 = *(const LAS bf16x8*)(L + st + (8 * c + 2 * d0 + hi) * AT_KCH + r32 * 16 + 512);
                const bf16x8 qf = *(const LAS bf16x8*)(L + qfo + d0 * 1024);
                p0 = __builtin_amdgcn_mfma_f32_32x32x16_bf16(k0, qf, p0, 0, 0, 0);
                p1 = __builtin_amdgcn_mfma_f32_32x32x16_bf16(k1, qf, p1, 0, 0, 0);
            }
            if (!far) {
                float tb0[16], tb1[16];
#pragma unroll
                for (int rr = 0; rr < 16; ++rr) { const int d0v = qpos - (64 * j + crow(rr, hi)), d1v = d0v - 32;
                    tb0[rr] = TBL[d0v < 0 ? 0 : (d0v > 255 ? 255 : d0v)]; tb1[rr] = TBL[d1v < 0 ? 0 : (d1v > 255 ? 255 : d1v)]; }
                asm volatile("s_waitcnt lgkmcnt(0)" ::: "memory");
#pragma unroll
                for (int rr = 0; rr < 16; ++rr) { const int d0v = qpos - (64 * j + crow(rr, hi)), d1v = d0v - 32;
                    p0[rr] = d0v >= 0 ? p0[rr] + tb0[rr] : -INFINITY; p1[rr] = d1v >= 0 ? p1[rr] + tb1[rr] : -INFINITY; }
            }
            float sacc = 0.f;
#pragma unroll
            for (int rr = 0; rr < 16; ++rr) { p0[rr] = __builtin_amdgcn_exp2f(p0[rr]); p1[rr] = __builtin_amdgcn_exp2f(p1[rr]); sacc += p0[rr] + p1[rr]; }
            lsum += sacc;
#define AT_VLD(dst, ks) do { _Pragma("unroll") for (int _d = 0; _d < 4; ++_d) { \
                const s16x4 _lo = __builtin_bit_cast(s16x4, __builtin_amdgcn_ds_read_tr16_b64_v4i16((LAS s16x4*)(L + st + vlane + _d * AT_VDB + (ks) * 1024))); \
                const s16x4 _hh = __builtin_bit_cast(s16x4, __builtin_amdgcn_ds_read_tr16_b64_v4i16((LAS s16x4*)(L + st + vlane + _d * AT_VDB + (ks) * 1024 + 512))); \
                dst[_d] = (bf16x8){_lo[0], _lo[1], _lo[2], _lo[3], _hh[0], _hh[1], _hh[2], _hh[3]}; } } while (0)
#define AT_PV(src, ks) do { v4u _w; if ((ks) < 2) { _w.x = pg8::cvt_pk_bf16(p0[8 * (ks) + 0], p0[8 * (ks) + 1]); _w.y = pg8::cvt_pk_bf16(p0[8 * (ks) + 2], p0[8 * (ks) + 3]); _w.z = pg8::cvt_pk_bf16(p0[8 * (ks) + 4], p0[8 * (ks) + 5]); _w.w = pg8::cvt_pk_bf16(p0[8 * (ks) + 6], p0[8 * (ks) + 7]); } \
                else { _w.x = pg8::cvt_pk_bf16(p1[8 * (ks) - 16], p1[8 * (ks) - 15]); _w.y = pg8::cvt_pk_bf16(p1[8 * (ks) - 14], p1[8 * (ks) - 13]); _w.z = pg8::cvt_pk_bf16(p1[8 * (ks) - 12], p1[8 * (ks) - 11]); _w.w = pg8::cvt_pk_bf16(p1[8 * (ks) - 10], p1[8 * (ks) - 9]); } \
                const bf16x8 _pa = __builtin_bit_cast(bf16x8, _w); \
                _Pragma("unroll") for (int _d = 0; _d < 4; ++_d) o[_d] = __builtin_amdgcn_mfma_f32_32x32x16_bf16(_pa, src[_d], o[_d], 0, 0, 0); } while (0)
            bf16x8 vfa[4], vfb[4];
            AT_VLD(vfa, 0);
            AT_VLD(vfb, 1); AT_PV(vfa, 0);
            AT_VLD(vfa, 2); AT_PV(vfb, 1);
            AT_VLD(vfb, 3); AT_PV(vfa, 2);
            AT_PV(vfb, 3);
#undef AT_VLD
#undef AT_PV
            if (more) { *(LAS v4u*)(L + sn + kdst0) = kr0; *(LAS v4u*)(L + sn + kdst1) = kr1; *(LAS v4u*)(L + sn + vdst0) = vr0; *(LAS v4u*)(L + sn + vdst1) = vr1; }
            __syncthreads();
        }
        lsum += __shfl_xor(lsum, 32);
        if (hi == 0) WSF[wid * 32 + r32] = lsum;
        LDS_WAIT();
        float rli[16];
#pragma unroll
        for (int rr = 0; rr < 16; ++rr) rli[rr] = 1.0f / WSF[wid * 32 + crow(rr, hi)];
        if (c == 1) {
#pragma unroll
            for (int d0 = 0; d0 < 4; ++d0)
#pragma unroll
                for (int rr = 0; rr < 16; ++rr) XB[(qblk * 32 + crow(rr, hi)) * 128 + 32 * d0 + r32] = o[d0][rr] * rli[rr] * lam;
        }
        __syncthreads();
        if (c == 0) {
            float ss[16];
#pragma unroll
            for (int rr = 0; rr < 16; ++rr) ss[rr] = 0.f;
#pragma unroll
            for (int d0 = 0; d0 < 4; ++d0)
#pragma unroll
                for (int rr = 0; rr < 16; ++rr) { const float df = o[d0][rr] * rli[rr] - XB[(qblk * 32 + crow(rr, hi)) * 128 + 32 * d0 + r32]; o[d0][rr] = df; ss[rr] += df * df; }
#pragma unroll
            for (int rr = 0; rr < 16; ++rr) { float s2 = ss[rr]; s2 += __shfl_xor(s2, 1); s2 += __shfl_xor(s2, 2); s2 += __shfl_xor(s2, 4); s2 += __shfl_xor(s2, 8); s2 += __shfl_xor(s2, 16);
                ss[rr] = 1.f / sqrtf(s2 * (1.f / 128.f) + EPS); }
#pragma unroll
            for (int d0 = 0; d0 < 4; ++d0)
#pragma unroll
                for (int rr = 0; rr < 16; ++rr)
                    BR[(rowb + q0 + 32 * qblk + crow(rr, hi)) * 2048 + 1024 + h * 128 + 32 * d0 + r32] = (bf16)f2bf_sw(o[d0][rr] * ss[rr] * dg[d0]);
        }
        __syncthreads();
    }
}

struct EpiMergeF {
    static constexpr bool PERM = true, MIDK = true;
    unsigned char* ws;
    __device__ __forceinline__ void mid(f32x4 (&acc)[2][2][4][2], const pg8::Unit& u, int wr, int wc, int fr_, int fq_) const {
        int fr = fr_, fq = fq_; OPAQUE_V(fr); OPAQUE_V(fq);
        const unsigned char* GA8 = ws + WS_GA; const unsigned char* GB8 = ws + WS_GB;
        const int row0 = u.pm * 256 + wr * 64 + fr, colp = u.pn * 256 + wc * 64 + 16 * fq;
#pragma unroll
        for (int ai = 0; ai < 2; ++ai)
#pragma unroll
            for (int m = 0; m < 4; ++m) {
                const size_t off = (size_t)(row0 + ai * 128 + m * 16) * 2048 + colp;
                const v4u wa = *(const GAS v4u*)(GA8 + off), wb = *(const GAS v4u*)(GB8 + off);
#pragma unroll
                for (int bj = 0; bj < 2; ++bj) {
                    float ga[8], gb[8]; unpack8_fp8(bj ? wa.z : wa.x, bj ? wa.w : wa.y, ga); unpack8_fp8(bj ? wb.z : wb.x, bj ? wb.w : wb.y, gb);
#pragma unroll
                    for (int j = 0; j < 4; ++j) {
                        acc[ai][bj][m][0][j] *= (1.0f + __expf(-gb[j])) * __builtin_amdgcn_rcpf(1.0f + __expf(-ga[j]));
                        acc[ai][bj][m][1][j] *= (1.0f + __expf(-gb[4 + j])) * __builtin_amdgcn_rcpf(1.0f + __expf(-ga[4 + j])); }
                }
            }
    }
    __device__ __forceinline__ void operator()(const f32x4 (&acc)[2][2][4][2], const pg8::Unit& u, int wr, int wc, int fr_, int fq_) const {
        int fr = fr_, fq = fq_; OPAQUE_V(fr); OPAQUE_V(fq);
        const unsigned char* GB8 = ws + WS_GB; bf16* O = (bf16*)(ws + WS_MERGED);
        const LaneT lt(fr, fq);
        const int row0 = u.pm * 256 + wr * 64 + fr, colp = u.pn * 256 + wc * 64 + 16 * fq, rowt = u.pm * 256 + wr * 64 + lt.r2, colt = u.pn * 256 + wc * 32 + 8 * lt.c2;
#pragma unroll
        for (int ai = 0; ai < 2; ++ai)
#pragma unroll
            for (int m = 0; m < 4; ++m) {
                const v4u wb = *(const GAS v4u*)(GB8 + (size_t)(row0 + ai * 128 + m * 16) * 2048 + colp);
#pragma unroll
                for (int bj = 0; bj < 2; ++bj) {
                    float gb[8], y[8]; unpack8_fp8(bj ? wb.z : wb.x, bj ? wb.w : wb.y, gb);
                    const f32x4 v0 = acc[ai][bj][m][0], v1 = acc[ai][bj][m][1];
#pragma unroll
                    for (int j = 0; j < 4; ++j) { y[j] = v0[j] * fsigmoid(gb[j]); y[4 + j] = v1[j] * fsigmoid(gb[4 + j]); }
                    v4u w; w.x = pk2(y[0], y[1]); w.y = pk2(y[2], y[3]); w.z = pk2(y[4], y[5]); w.w = pk2(y[6], y[7]);
                    *(GAS v4u*)(O + (size_t)(rowt + ai * 128 + m * 16) * 2048 + colt + bj * 128) = lt.t4(w);
                }
            }
    }
};
struct EpiOutProj {
    static constexpr bool PERM = true, MIDK = false;
    const float* x; bf16* x1b; const float* mod;
    __device__ __forceinline__ void operator()(const f32x4 (&acc)[2][2][4][2], const pg8::Unit& u, int wr, int wc, int fr_, int fq_) const {
        int fr = fr_, fq = fq_; OPAQUE_V(fr); OPAQUE_V(fq);
        const LaneT lt(fr, fq);
        const int row0 = u.pm * 256 + wr * 64 + fr, col0 = u.pn * 256 + wc * 32 + 8 * fq, rowt = u.pm * 256 + wr * 64 + lt.r2, colt = u.pn * 256 + wc * 32 + 8 * lt.c2;
        const int b = (u.pm * 256) / SEQ;
#pragma unroll
        for (int ai = 0; ai < 2; ++ai)
#pragma unroll
            for (int m = 0; m < 4; ++m) { const size_t ro = (size_t)(row0 + ai * 128 + m * 16) * D + col0;
#pragma unroll
                for (int bj = 0; bj < 2; ++bj) {
                    const f32x4 x0 = *(const GAS f32x4*)(x + ro + bj * 128), x4 = *(const GAS f32x4*)(x + ro + bj * 128 + 4);
                    const f32x4 g0 = *(const GAS f32x4*)(mod + b * 12288 + 4096 + col0 + bj * 128), g4 = *(const GAS f32x4*)(mod + b * 12288 + 4096 + col0 + bj * 128 + 4);
                    const f32x4 y0 = x0 + g0 * acc[ai][bj][m][0], y1 = x4 + g4 * acc[ai][bj][m][1];
                    v4u w; w.x = pk2(y0[0], y0[1]); w.y = pk2(y0[2], y0[3]); w.z = pk2(y1[0], y1[1]); w.w = pk2(y1[2], y1[3]);
                    *(GAS v4u*)(x1b + (size_t)(rowt + ai * 128 + m * 16) * D + colt + bj * 128) = lt.t4(w); } }
    }
};


constexpr int RT_XSLD = 2056;
constexpr int RT_XS = 0, RT_PART = 65792;
constexpr int RT_LCNT = 98560, RT_STOK = 98816, RT_SW = 107008;
constexpr int MOE_TB = MISC_OFF + 1024;
__device__ __forceinline__ void phase_router(Frame& F, const Args& a) {
    PHASE_IDS();
    LAS unsigned char* L = F.lds;
    LAS bf16* XS = (LAS bf16*)(L + RT_XS); LAS float* PART = (LAS float*)(L + RT_PART);
    const bf16* x1 = (const bf16*)(F.ws + WS_X1B); const float* mod = (const float*)(F.ctl + CW_MOD);
    unsigned char* H2 = F.ws + WS_H2;
    int* LTOK = (int*)(F.ws + WS_LTOK); float* LW = (float*)(F.ws + WS_LW);
    const float rbias = a.in[IN_RB][lane];
    if (tid < 64) ((LAS unsigned*)(L + RT_LCNT))[tid] = 0u;
    __syncthreads();
    int rounds = 0, round_row0 = 0;
    const bf16* RH = (const bf16*)(F.ws + WS_RWT_HI);
    const int r = lane & 15, g = lane >> 4;
    v2u xw0[8], xw1[8];
#define RT_LOADX(g_) do { const GAS v2u* xr_ = (const GAS v2u*)(x1 + (size_t)((g_) * 16 + 2 * wid) * D) + lane; \
        _Pragma("unroll") for (int j_ = 0; j_ < 8; ++j_) { xw0[j_] = xr_[64 * j_]; xw1[j_] = xr_[64 * j_ + 512]; } } while (0)
#define RT_LOADW(dst, ks_) do { _Pragma("unroll") for (int cb_ = 0; cb_ < 4; ++cb_) dst[cb_] = *(const GAS bf16x8*)(RH + (16 * cb_ + r) * D + 256 * wid + 32 * (ks_) + 8 * g); } while (0)
#define RT_STEP(src, ks_) do { const bf16x8 xf_ = *(const LAS bf16x8*)(XS + r * RT_XSLD + 256 * wid + 32 * (ks_) + 8 * g); \
        _Pragma("unroll") for (int cb_ = 0; cb_ < 4; ++cb_) acc[cb_] = __builtin_amdgcn_mfma_f32_16x16x32_bf16(xf_, src[cb_], acc[cb_], 0, 0, 0); } while (0)
#define RT_FENCE() asm volatile("" ::: "memory")
    const int RPW = (T / 16) / F.G, bq = (F.vcu * RPW * 16) / SEQ;
    f32x4 ga[8], sh[8];
#pragma unroll
    for (int j = 0; j < 8; ++j) { const int d = 4 * lane + 256 * j;
        const f32x4 gg = *(const f32x4*)(a.in[IN_N2G] + d), sc = *(const GAS f32x4*)(mod + bq * 12288 + 8192 + d); sh[j] = *(const GAS f32x4*)(mod + bq * 12288 + 6144 + d); ga[j] = gg * (sc + 1.0f); }
    RT_LOADX(F.vcu * RPW);
    for (int gi = 0; gi < RPW; ++gi) {
        const int grp = F.vcu * RPW + gi;
        if (rounds == 0) round_row0 = grp * 16;
#pragma unroll
        for (int rr2 = 0; rr2 < 2; ++rr2) {
            const int rloc = 2 * wid + rr2, m = grp * 16 + rloc;
            f32x4 v[8]; float s = 0.f;
#pragma unroll
            for (int j = 0; j < 8; ++j) { const v2u w = rr2 ? xw1[j] : xw0[j]; v[j] = (f32x4){bflo(w.x), bfhi(w.x), bflo(w.y), bfhi(w.y)}; s += (v[j].x * v[j].x + v[j].y * v[j].y) + (v[j].z * v[j].z + v[j].w * v[j].w); }
            const float rstd = 1.f / sqrtf(wave_sum_dpp(s) * (1.f / D) + EPS);
            GAS unsigned* o8 = (GAS unsigned*)(H2 + (size_t)m * D) + lane;
#pragma unroll
            for (int j = 0; j < 8; ++j) {
                const int d = 4 * lane + 256 * j;
                const f32x4 y = v[j] * rstd * ga[j] + sh[j];
                o8[64 * j] = pk4_fp8(y.x, y.y, y.z, y.w);
                v2u xb; xb.x = pk2(y.x, y.y); xb.y = pk2(y.z, y.w);
                *(LAS v2u*)(XS + rloc * RT_XSLD + d) = xb;
            }
        }
        {
            f32x4 acc[4];
#pragma unroll
            for (int cb = 0; cb < 4; ++cb) acc[cb] = (f32x4){0.f, 0.f, 0.f, 0.f};
            bf16x8 w0[4], w1[4], w2[4], w3[4];
            RT_LOADW(w0, 0); RT_LOADW(w1, 1); RT_LOADW(w2, 2); RT_LOADW(w3, 3);
            RT_FENCE();
            __syncthreads();
            RT_STEP(w0, 0); RT_LOADW(w0, 4); RT_FENCE();
            RT_STEP(w1, 1); RT_LOADW(w1, 5); RT_FENCE();
            RT_STEP(w2, 2); RT_LOADW(w2, 6); RT_FENCE();
            RT_STEP(w3, 3); RT_LOADW(w3, 7); RT_FENCE();
            RT_STEP(w0, 4); RT_STEP(w1, 5); RT_STEP(w2, 6); RT_STEP(w3, 7);
            RT_FENCE();
            if (gi + 1 < RPW) RT_LOADX(grp + 1);
            RT_FENCE();
#pragma unroll
            for (int cb = 0; cb < 4; ++cb)
#pragma unroll
                for (int rg = 0; rg < 4; ++rg) PART[(wid * 16 + 4 * g + rg) * 64 + 16 * cb + r] = acc[cb][rg];
        }
        __syncthreads();
#pragma unroll 1
        for (int rr2 = 0; rr2 < 2; ++rr2) {
            const int rloc = 2 * wid + rr2, m = grp * 16 + rloc;
            float logit = 0.f;
#pragma unroll
            for (int w2 = 0; w2 < 8; ++w2) logit += PART[(w2 * 16 + rloc) * 64 + lane];
            const float score = 1.0f / (1.0f + expf(-logit)), sel = score + rbias;
            const int eg = lane >> 3;
            const float m1 = max8_dpp(sel);
            const unsigned long long bm = __ballot(sel == m1);
            const int first = __builtin_ctz((unsigned)((bm >> (8 * eg)) & 0xffull)) + 8 * eg;
            const float m2 = max8_dpp((lane == first) ? -INFINITY : sel);
            const float gs = m1 + m2;
            int grank = 0;
#pragma unroll
            for (int g2 = 0; g2 < 8; ++g2) { const float o = rlf(gs, 8 * g2); grank += (o > gs || (o == gs && g2 < eg)) ? 1 : 0; }
            const float masked = grank < 4 ? sel : -INFINITY;
            int rank = 64; float cur = masked;
#pragma unroll
            for (int rnd = 0; rnd < 8; ++rnd) {
                float mx = cur; mx = fmaxf(mx, dppf<0xB1>(mx)); mx = fmaxf(mx, dppf<0x4E>(mx)); mx = fmaxf(mx, dppf<0x141>(mx)); mx = fmaxf(mx, dppf<0x140>(mx));
                const float wm = fmaxf(fmaxf(rlf(mx, 0), rlf(mx, 16)), fmaxf(rlf(mx, 32), rlf(mx, 48)));
                const int firstl = __builtin_ctzll(__ballot(cur == wm));
                if (lane == firstl) { rank = rnd; cur = -INFINITY; }
            }
            const bool selected = rank < 8;
            const float ssum = wave_sum_dpp(selected ? score : 0.f);
            if (selected) {
                const unsigned pos = __hip_atomic_fetch_add((LAS unsigned*)(L + RT_LCNT) + lane, 1u, __ATOMIC_RELAXED, __HIP_MEMORY_SCOPE_WORKGROUP);
                ((LAS unsigned short*)(L + RT_STOK))[lane * 64 + pos] = (unsigned short)((rounds * 16 + rloc) * 8 + rank); LW[(size_t)m * 8 + rank] = score / ssum * 2.5f;
            }
        }
        __syncthreads();
        ++rounds;
        if (rounds == 4 || gi + 1 == RPW) {
            const int e = tid >> 3, sub = tid & 7;
            const unsigned n = ((LAS unsigned*)(L + RT_LCNT))[e];
            unsigned base = 0u;
            if (sub == 0 && n) base = atomicAdd(F.ctl + CW_CNT + 64 * e, n);
            base = __shfl(base, lane & ~7);
            for (unsigned i = sub; i < n; i += 8) { const int sv = (int)((LAS unsigned short*)(L + RT_STOK))[e * 64 + i]; LTOK[e * 16384 + base + i] = (round_row0 + (sv >> 7) * 16 + ((sv >> 3) & 15)) * 8 + (sv & 7); }
            __syncthreads();
            if (tid < 64) ((LAS unsigned*)(L + RT_LCNT))[tid] = 0u;
            rounds = 0;
            __syncthreads();
        }
    }
}
#undef RT_LOADX
#undef RT_LOADW
#undef RT_STEP
#undef RT_FENCE
__device__ __forceinline__ void moe_build_table(Frame& F) {
    PHASE_IDS();
    LAS int* tb = (LAS int*)(F.lds + MOE_TB); LAS int* cn = tb + 68; LAS int* ab = cn + 68;
    if (tid < 64) {
        const int c = (int)__hip_atomic_load(F.ctl + CW_CNT + 64 * tid, RLX_AGENT), nt = (c + 255) >> 8;
        int t = nt, r = c;
#pragma unroll
        for (int o = 1; o < 64; o <<= 1) { const int tu = __shfl_up(t, o), ru = __shfl_up(r, o); if (tid >= o) { t += tu; r += ru; } }
        tb[tid] = t - nt; cn[tid] = c; ab[tid] = r - c;
        if (tid == 63) { tb[64] = t; cn[64] = T; ab[64] = r; }
    }
    __syncthreads();
}
template <int NP>
struct MoeOrder {
    LAS int* tb; int G, c;
    __device__ bool next(int i, pg8::Unit& u) const {
        const int ntr = __builtin_amdgcn_readfirstlane(tb[64]); const long L = (long)i * G + c;
        if (L >= (long)(64 + ntr) * NP) return false;
        int tt = (int)(L / NP); u.pn = (int)(L % NP);
        if (tt < 64) { u.e = 64; u.pm = tt; u.cnt = 256; return true; }
        tt -= 64;
        const unsigned long long le = __ballot(tb[threadIdx.x & 63] <= tt);
        const int lo = __builtin_amdgcn_readfirstlane(__builtin_popcountll(le) - 1);
        u.e = lo; u.pm = tt - __builtin_amdgcn_readfirstlane(tb[lo]); const int rem = __builtin_amdgcn_readfirstlane(tb[68 + lo]) - 256 * u.pm; u.cnt = rem < 256 ? rem : 256; return true;
    }
};
struct MoeGemm1 : MoeOrder<4> {
    static constexpr bool GATHER = true;
    unsigned char* ws; unsigned lda2, ldb2; int nt;
    __device__ __forceinline__ const char* aptr(const pg8::Unit&) const { return (const char*)(ws + WS_H2); }
    __device__ __forceinline__ void aoffs(const pg8::Unit& u, int tid, unsigned (&o)[2][2]) const {
        const int* LTOK = (const int*)(ws + WS_LTOK);
        OPAQUE_V(tid);
        int R0, C0, R1, C1; pg8::stage_rc(tid * 16, R0, C0); pg8::stage_rc(tid * 16 + 8192, R1, C1);
        int t00, t01, t10, t11;
        if (u.e == 64) { t00 = u.pm * 256 + R0; t01 = u.pm * 256 + R1; t10 = t00 + 128; t11 = t01 + 128; }
        else {
            const int lastr = u.cnt - 1; const GAS int* lp = (const GAS int*)(LTOK + u.e * 16384 + u.pm * 256);
            const int v00 = lp[R0 < lastr ? R0 : lastr], v01 = lp[R1 < lastr ? R1 : lastr], v10 = lp[R0 + 128 < lastr ? R0 + 128 : lastr], v11 = lp[R1 + 128 < lastr ? R1 + 128 : lastr];
            t00 = v00 >> 3; t01 = v01 >> 3; t10 = v10 >> 3; t11 = v11 >> 3; }
        o[0][0] = (unsigned)t00 * 2048u + (unsigned)C0 * 2u; o[0][1] = (unsigned)t01 * 2048u + (unsigned)C1 * 2u;
        o[1][0] = (unsigned)t10 * 2048u + (unsigned)C0 * 2u; o[1][1] = (unsigned)t11 * 2048u + (unsigned)C1 * 2u;
    }
    __device__ __forceinline__ void prefetch_rows(const pg8::Unit& u, LAS unsigned char* lds, int wid, int lane, int par) const {
        if (u.e != 64 && wid < 4) {
            const int* src = (const int*)(ws + WS_LTOK) + u.e * 16384 + u.pm * 256 + 64 * wid + lane;
            __builtin_amdgcn_global_load_lds((const unsigned*)src, (LAS unsigned*)(lds + MISC_OFF + 2048 + par * 1024 + wid * 256), 4, 0, 0);
        }
    }
    __device__ __forceinline__ void aoffs_mb(const pg8::Unit& u, int tid, unsigned (&o)[2][2], LAS unsigned char* lds, int par) const {
        OPAQUE_V(tid);
        int R0, C0, R1, C1; pg8::stage_rc(tid * 16, R0, C0); pg8::stage_rc(tid * 16 + 8192, R1, C1);
        int t00, t01, t10, t11;
        if (u.e == 64) { t00 = u.pm * 256 + R0; t01 = u.pm * 256 + R1; t10 = t00 + 128; t11 = t01 + 128; }
        else { const int lastr = u.cnt - 1; const LAS int* mb = (const LAS int*)(lds + MISC_OFF + 2048 + par * 1024);
            t00 = mb[R0 < lastr ? R0 : lastr] >> 3; t01 = mb[R1 < lastr ? R1 : lastr] >> 3; t10 = mb[R0 + 128 < lastr ? R0 + 128 : lastr] >> 3; t11 = mb[R1 + 128 < lastr ? R1 + 128 : lastr] >> 3; }
        o[0][0] = (unsigned)t00 * 2048u + (unsigned)C0 * 2u; o[0][1] = (unsigned)t01 * 2048u + (unsigned)C1 * 2u;
        o[1][0] = (unsigned)t10 * 2048u + (unsigned)C0 * 2u; o[1][1] = (unsigned)t11 * 2048u + (unsigned)C1 * 2u;
    }
    __device__ __forceinline__ void bptrs(const pg8::Unit& u, const char*& b0, const char*& b1) const {
        const char* g = (u.e == 64) ? (const char*)(ws + WS_WSH) : (const char*)(ws + WS_WG) + (size_t)u.e * DEXP * D;
        const char* up = (u.e == 64) ? (const char*)(ws + WS_WSH + 2 * MiB) : (const char*)(ws + WS_WU) + (size_t)u.e * DEXP * D;
        b0 = g + (size_t)(u.pn * 128) * 2048; b1 = up + (size_t)(u.pn * 128) * 2048;
    }
};
struct EpiSwiglu {
    static constexpr bool PERM = true, MIDK = false;
    unsigned char* ws; LAS int* tb;
    __device__ __forceinline__ void operator()(const f32x4 (&acc)[2][2][4][2], const pg8::Unit& u, int wr, int wc, int fr_, int fq_) const {
        int fr = fr_, fq = fq_; OPAQUE_V(fr); OPAQUE_V(fq);
        unsigned char* ACT = ws + WS_ACT;
        const LaneT lt(fr, fq);
        const int rbase = tb[136 + u.e] + u.pm * 256, col0 = u.pn * 128 + wc * 32 + 8 * lt.c2;
#pragma unroll
        for (int ai = 0; ai < 2; ++ai)
#pragma unroll
            for (int m = 0; m < 4; ++m) {
                const int rt = ai * 128 + wr * 64 + m * 16 + lt.r2;
                float y[8];
#pragma unroll
                for (int n = 0; n < 2; ++n)
#pragma unroll
                    for (int j = 0; j < 4; ++j) { const float gt = acc[ai][0][m][n][j], upv = acc[ai][1][m][n][j]; y[4 * n + j] = fminf(fmaxf(gt * fsigmoid(gt) * upv, -448.f), 448.f); }
                v2u w; w.x = pk4_fp8(y[0], y[1], y[2], y[3]); w.y = pk4_fp8(y[4], y[5], y[6], y[7]);
                w = lt.t2(w);
                if (rt < u.cnt) *(GAS v2u*)(ACT + (size_t)(rbase + rt) * DEXP + col0) = w;
            }
    }
};
struct MoeGemm2 : MoeOrder<8> {
    static constexpr bool GATHER = false;
    unsigned char* ws; unsigned lda2, ldb2; int nt;
    __device__ __forceinline__ const char* aptr(const pg8::Unit& u) const { return (const char*)(ws + WS_ACT) + (size_t)(tb[136 + u.e] + u.pm * 256) * 512; }
    __device__ __forceinline__ void aoffs(const pg8::Unit&, int, unsigned (&)[2][2]) const {}
    __device__ __forceinline__ void bptrs(const pg8::Unit& u, const char*& b0, const char*& b1) const {
        const char* dn = (u.e == 64) ? (const char*)(ws + WS_WSH + 4 * MiB) : (const char*)(ws + WS_WDOWN) + (size_t)u.e * D * DEXP;
        b0 = dn + (size_t)(u.pn * 256) * 512; b1 = b0 + (size_t)128 * 512;
    }
};
struct EpiDown {
    static constexpr bool PERM = true, MIDK = false;
    unsigned char* ws; float* out; const float* mod;
    __device__ __forceinline__ void operator()(const f32x4 (&acc)[2][2][4][2], const pg8::Unit& u, int wr, int wc, int fr_, int fq_) const {
        int fr = fr_, fq = fq_; OPAQUE_V(fr); OPAQUE_V(fq);
        const int* LTOK = (const int*)(ws + WS_LTOK); const float* LW = (const float*)(ws + WS_LW); unsigned char* Y = ws + WS_Y;
        const int col0 = u.pn * 256 + wc * 32 + 8 * fq;
        if (u.e == 64) {
            bf16* YSH = (bf16*)(ws + WS_YSH); const LaneT lt(fr, fq);
#pragma unroll
            for (int ai = 0; ai < 2; ++ai)
#pragma unroll
                for (int m = 0; m < 4; ++m) {
                    const int rt = ai * 128 + wr * 64 + m * 16 + lt.r2, t = u.pm * 256 + rt;
#pragma unroll
                    for (int bj = 0; bj < 2; ++bj) { const f32x4 v0 = acc[ai][bj][m][0], v1 = acc[ai][bj][m][1];
                        v4u pw; pw.x = pk2(v0[0], v0[1]); pw.y = pk2(v0[2], v0[3]); pw.z = pk2(v1[0], v1[1]); pw.w = pk2(v1[2], v1[3]);
                        *(GAS v4u*)(YSH + (size_t)t * D + u.pn * 256 + wc * 32 + 8 * lt.c2 + bj * 128) = lt.t4(pw); }
                }
        } else {
            const int r2 = (fr + 16 * fq) >> 2, c2 = fr & 3, bsrc = ((c2 << 4) | r2) << 2;
            int tk[8]; float w8[8];
            const int pbase = u.e * 16384 + u.pm * 256, lastr = u.cnt - 1;
#pragma unroll
            for (int i = 0; i < 8; ++i) { const int rb = (i >> 2) * 128 + wr * 64 + (i & 3) * 16, ro = rb + fr, rn = rb + r2;
                (void)ro; w8[i] = Y8_SCALE; tk[i] = *(const GAS int*)(LTOK + pbase + (rn < lastr ? rn : lastr)); }
            const int colw = u.pn * 256 + wc * 64 + 16 * c2;
#pragma unroll
            for (int ai = 0; ai < 2; ++ai)
#pragma unroll
                for (int m = 0; m < 4; ++m) {
                    const int rn = ai * 128 + wr * 64 + m * 16 + r2; const float w = w8[ai * 4 + m];
                    v4u pw;
#pragma unroll
                    for (int bj = 0; bj < 2; ++bj) { f32x4 v0 = acc[ai][bj][m][0] * w, v1 = acc[ai][bj][m][1] * w;
#pragma unroll
                        for (int j = 0; j < 4; ++j) { v0[j] = fminf(fmaxf(v0[j], -448.f), 448.f); v1[j] = fminf(fmaxf(v1[j], -448.f), 448.f); }
                        const unsigned a0 = (unsigned)__builtin_amdgcn_ds_bpermute(bsrc, (int)pk4_fp8(v0[0], v0[1], v0[2], v0[3])), a1 = (unsigned)__builtin_amdgcn_ds_bpermute(bsrc, (int)pk4_fp8(v1[0], v1[1], v1[2], v1[3]));
                        if (bj == 0) { pw.x = a0; pw.y = a1; } else { pw.z = a0; pw.w = a1; } }
                    if (rn < u.cnt) *(GAS v4u*)(Y + (size_t)tk[ai * 4 + m] * D + colw) = pw;
                }
        }
    }
};
__device__ __forceinline__ void phase_combine(Frame& F, const Args& a) {
    PHASE_IDS();
    const unsigned char* Y = F.ws + WS_Y; const float* WTK = (const float*)(F.ws + WS_LW); const float* mod = (const float*)(F.ctl + CW_MOD); float* out = a.out;
    const int NIT = T * (D / 8);
    const bool bad = xb_ld(F.ctl + CW_BAR + XB_TMO) != 0u;
    int gb_ = -1; f32x4 g0 = (f32x4){0.f, 0.f, 0.f, 0.f}, g1 = g0;
    for (int it = F.vcu * NTHREADS + tid; it < NIT; it += F.G * NTHREADS) {
        const int t = it >> 8, c8 = (it & 255) * 8, b = t / SEQ;
        float s[8];
#pragma unroll
        for (int j = 0; j < 8; ++j) s[j] = 0.f;
        const int cy = (c8 & ~255) | (((c8 >> 5) & 3) << 6) | (((c8 >> 3) & 3) << 4) | (((c8 >> 7) & 1) << 3);
        const f32x4 wk0 = *(const GAS f32x4*)(WTK + (size_t)t * 8), wk1 = *(const GAS f32x4*)(WTK + (size_t)t * 8 + 4);
#pragma unroll
        for (int k = 0; k < 8; ++k) { const v2u w = *(const GAS v2u*)(Y + ((size_t)t * 8 + k) * D + cy); const float wk = k < 4 ? wk0[k & 3] : wk1[k & 3];
            const auto f0 = __builtin_amdgcn_cvt_pk_f32_fp8((int)w.x, false), f1 = __builtin_amdgcn_cvt_pk_f32_fp8((int)w.x, true), f2 = __builtin_amdgcn_cvt_pk_f32_fp8((int)w.y, false), f3 = __builtin_amdgcn_cvt_pk_f32_fp8((int)w.y, true);
            s[0] += wk * f0[0]; s[1] += wk * f0[1]; s[2] += wk * f1[0]; s[3] += wk * f1[1]; s[4] += wk * f2[0]; s[5] += wk * f2[1]; s[6] += wk * f3[0]; s[7] += wk * f3[1]; }
#pragma unroll
        for (int j = 0; j < 8; ++j) s[j] *= (1.0f / Y8_SCALE);
        if (b != gb_) { gb_ = b; g0 = *(const GAS f32x4*)(mod + b * 12288 + 10240 + c8); g1 = *(const GAS f32x4*)(mod + b * 12288 + 10240 + c8 + 4); }
        GAS f32x4* o = (GAS f32x4*)(out + (size_t)t * D + c8);
        float xv[8], sh[8]; unpack8(*(const GAS v4u*)((const bf16*)(F.ws + WS_X1B) + (size_t)t * D + c8), xv); unpack8(*(const GAS v4u*)((const bf16*)(F.ws + WS_YSH) + (size_t)t * D + c8), sh);
#pragma unroll
        for (int j = 0; j < 8; ++j) s[j] += sh[j];
        const f32x4 o0 = (f32x4){xv[0], xv[1], xv[2], xv[3]}, o1 = (f32x4){xv[4], xv[5], xv[6], xv[7]};
        f32x4 r0 = o0 + g0 * (f32x4){s[0], s[1], s[2], s[3]}; const f32x4 r1 = o1 + g1 * (f32x4){s[4], s[5], s[6], s[7]};
        if (bad) r0.x = __builtin_nanf("");
        o[0] = r0; o[1] = r1;
    }
}

__global__ void __launch_bounds__(NTHREADS, 2) fwd_kernel(Args args) {
    extern __shared__ __attribute__((aligned(16))) unsigned char lds[];
    Frame F;
    F.lds = (LAS unsigned char*)lds;
    F.MISC = (volatile LAS unsigned*)(F.lds + MISC_OFF);
    F.tid = threadIdx.x; F.lane = F.tid & 63; F.wave = __builtin_amdgcn_readfirstlane(F.tid >> 6);
    F.G = gridDim.x; { const int bx = blockIdx.x; F.vcu = (F.G % 8 == 0) ? (bx % 8) * (F.G / 8) + bx / 8 : bx; }
    F.ws = args.ws; F.ctl = (unsigned*)(args.ws + WS_CTL); F.vec = (float*)(args.ws + WS_VEC);
    for (int u = F.tid; u < 256; u += NTHREADS) ((LAS unsigned*)(F.lds + MISC_OFF))[u] = 0u;
    __syncthreads();
    XcdBarrier bar = xcd_barrier_post(F.ctl + CW_BAR, F.MISC + 8);
    unsigned char* ws = args.ws;

#define PH_MOD()   do { phase_mod(F, args); } while (0)
#define PH_PREP1() do { phase_prep1(F, args); } while (0)
#define PH_HROWS() do { phase_hrows(F, args); } while (0)
#define PH_INPROJ() do { { DenseGemm g; g.init(T, 4096, F.G, (int)blockIdx.x); g.A = (const char*)(ws + WS_H); g.Bt = (const char*)(ws + WS_WIN); g.lda2 = D * 2; g.ldb2 = D * 2; g.nt = D / 64; \
          EpiInProj<0> E{ws, F.lds, args.in[IN_QNG], args.in[IN_KNG]}; pg8::gemm_phase<DenseGemm, EpiInProj<0>>(F.lds, g, E); } \
        { DenseGemm g; g.init(T, 7168, F.G, (int)blockIdx.x); g.A = (const char*)(ws + WS_H8); g.Bt = (const char*)(ws + WS_WIN8); g.lda2 = D; g.ldb2 = D; g.nt = D / 128; \
          EpiInProj<1> E{ws, F.lds, args.in[IN_QNG], args.in[IN_KNG]}; pg8::gemm_phase<DenseGemm, EpiInProj<1>, true>(F.lds, g, E); } } while (0)
#define PH_H1()    do { phase_h1(F); } while (0)
#define PH_QKP()   do { phase_qkprep(F, args); } while (0)
#define PH_H2()    do { phase_h2(F); } while (0)
#define PH_H3()    do { phase_h3(F, args); } while (0)
#define PH_ATTN()  do { phase_attn(F, args, 0, 4); } while (0)
#define PH_MERGE() do { DenseGemm g; g.init(T, D, F.G, (int)blockIdx.x); g.A = (const char*)(ws + WS_BR); g.Bt = (const char*)(ws + WS_WA); g.lda2 = D * 2; g.ldb2 = D * 2; g.nt = D / 64; \
        EpiMergeF E{ws}; pg8::gemm_phase<DenseGemm, EpiMergeF>(F.lds, g, E); } while (0)
#define PH_OUTPROJ() do { DenseGemm g; g.init(T, D, F.G, (int)blockIdx.x); g.A = (const char*)(ws + WS_MERGED); g.Bt = (const char*)(ws + WS_WOUT); g.lda2 = D * 2; g.ldb2 = D * 2; g.nt = D / 64; \
        EpiOutProj E{args.in[IN_X], (bf16*)(ws + WS_X1B), (const float*)(F.ctl + CW_MOD)}; pg8::gemm_phase<DenseGemm, EpiOutProj>(F.lds, g, E); } while (0)
#define PH_ROUTER() do { phase_router(F, args); } while (0)
#define PH_CONVX()  do { phase_convert_experts(F, args); } while (0)
#define PH_MOE1()  do { MoeGemm1 g; g.tb = (LAS int*)(F.lds + MOE_TB); g.G = F.G; g.c = F.vcu; g.ws = ws; g.lda2 = D; g.ldb2 = D; g.nt = D / 128; \
        EpiSwiglu E{ws, (LAS int*)(F.lds + MOE_TB)}; pg8::gemm_phase<MoeGemm1, EpiSwiglu, true>(F.lds, g, E); } while (0)
#define PH_MOE2()  do { MoeGemm2 g; g.tb = (LAS int*)(F.lds + MOE_TB); g.G = F.G; g.c = F.vcu; g.ws = ws; g.lda2 = DEXP; g.ldb2 = DEXP; g.nt = DEXP / 128; \
        EpiDown E{ws, args.out, (const float*)(F.ctl + CW_MOD)}; pg8::gemm_phase<MoeGemm2, EpiDown, true>(F.lds, g, E); } while (0)
#define PH_COMBINE() do { phase_combine(F, args); } while (0)
#ifndef REPEAT_PHASE
#define REPEAT_PHASE -1
#endif
#define RUN(k, X) do { X; if (REPEAT_PHASE == (k)) { xcd_barrier(bar); X; } } while (0)
    if (F.vcu & 1) { PH_PREP1(); __syncthreads(); PH_MOD(); } else { PH_MOD(); __syncthreads(); PH_PREP1(); }
    xcd_barrier(bar);
    RUN(1, PH_HROWS());    xcd_barrier(bar);
    if (F.vcu & 1) __builtin_amdgcn_s_sleep(50);
    RUN(2, PH_INPROJ());   xcd_barrier(bar);
    if (F.vcu & 1) __builtin_amdgcn_s_sleep(127);
    PH_H1();
    xcd_barrier(bar);
    PH_H2();
    xcd_barrier(bar);
    PH_H3(); phase_attn(F, args, 0, 4);
    xcd_barrier(bar);
#define STAGGER_ODD() do { if (F.vcu & 1) { __builtin_amdgcn_s_sleep(127); __builtin_amdgcn_s_sleep(127); __builtin_amdgcn_s_sleep(127); __builtin_amdgcn_s_sleep(127); } } while (0)
    STAGGER_ODD(); RUN(8, PH_MERGE());    xcd_barrier(bar);
    STAGGER_ODD(); RUN(9, PH_OUTPROJ());  xcd_barrier(bar);
    PH_ROUTER();           xcd_barrier(bar);
    moe_build_table(F);
    RUN(11, PH_MOE1());    xcd_barrier(bar);
    PH_MOE2();             xcd_barrier(bar);
    PH_COMBINE();
}

extern "C" void kernel_launch(void* const* d_in, const int* in_sizes, int n_in, void* d_out, int out_size, void* d_ws, size_t ws_size, hipStream_t stream) {
    static int grid = 0;
    if (grid == 0) {
        int dev = 0, cus = 0;
        if (n_in != 28 || ws_size < WS_NEED || out_size != T * D) { fprintf(stderr, "kernel_launch: unexpected n_in %d / ws %zu / out %d\n", n_in, ws_size, out_size); grid = -1; return; }
        if (hipGetDevice(&dev) != hipSuccess || hipDeviceGetAttribute(&cus, hipDeviceAttributeMultiprocessorCount, dev) != hipSuccess) { grid = -1; return; }
        if (hipFuncSetAttribute((const void*)fwd_kernel, hipFuncAttributeMaxDynamicSharedMemorySize, LDS_BYTES) != hipSuccess) { grid = -1; return; }
        int per_cu = 0;
        (void)hipOccupancyMaxActiveBlocksPerMultiprocessor(&per_cu, (const void*)fwd_kernel, NTHREADS, LDS_BYTES);
        (void)hipGetLastError();
        grid = cus;
        if (cus != 256) { fprintf(stderr, "kernel_launch: built for a 256-CU MI355X (static work split), found %d CUs; nothing launched\n", cus); grid = -1; return; }
    }
    if (grid < 0) return;
    if (hipMemsetAsync((char*)d_ws + WS_CTL, 0, CTL_ZERO_BYTES, stream) != hipSuccess) return;
    Args a{};
    for (int i = 0; i < 28; ++i) a.in[i] = (const float*)d_in[i];
    a.out = (float*)d_out; a.ws = (unsigned char*)d_ws; a.ph_lo = 0; a.ph_hi = 100;
    hipLaunchKernelGGL(fwd_kernel, dim3(grid), dim3(NTHREADS), LDS_BYTES, stream, a);
}
```
